# Optimizing an MI355X kernel written in HIP

```python
import jax, jax.numpy as jnp
from jax import lax
import numpy as np

D_MODEL = 1024
BATCH = 2
SEQ = 8192
DEPTH = 2

GRID_W = 64
CTX_LEN = 256
EPS = 1e-6
POS_BASE = 10000.0
ML_WIDTH = D_MODEL // 2
N_ML_HEADS = 4
ML_HEAD_DIM = ML_WIDTH // N_ML_HEADS
ML_CHUNK = 64
CONV_W = 3
N_ML_GATES = 4 * N_ML_HEADS
GLA_V_WIDTH = D_MODEL - ML_WIDTH
GLA_K_WIDTH = GLA_V_WIDTH // 2
N_GLA_HEADS = 4
GLA_KEY_DIM = GLA_K_WIDTH // N_GLA_HEADS
GLA_VAL_DIM = GLA_V_WIDTH // N_GLA_HEADS
GLA_RANK = 16
GLA_GATE_TAU = 16.0
GLA_CHUNK = 16
N_EXPERTS = 16
EC_FACTOR = 2
D_EXPERT = D_MODEL
OFF_ML_Q = 0
OFF_ML_K = OFF_ML_Q + ML_WIDTH
OFF_ML_V = OFF_ML_K + ML_WIDTH
OFF_ML_O = OFF_ML_V + ML_WIDTH
OFF_ML_G = OFF_ML_O + ML_WIDTH
OFF_GLA_Q = OFF_ML_G + N_ML_GATES
OFF_GLA_K = OFF_GLA_Q + GLA_K_WIDTH
OFF_GLA_V = OFF_GLA_K + GLA_K_WIDTH
OFF_GLA_R = OFF_GLA_V + GLA_V_WIDTH
OFF_GLA_A = OFF_GLA_R + GLA_V_WIDTH
PROJ_WIDTH = OFF_GLA_A + 2 * GLA_RANK

kernel_name = "hybrid_mlstm_gla_ec_moe_prefix_dit"


def rms_norm(x, g):
    x32 = x.astype(jnp.float32)
    y = x32 * lax.rsqrt(jnp.mean(x32 * x32, axis=-1, keepdims=True) + EPS)
    return y.astype(x.dtype) * g


def head_rms_norm(h, g, n_heads):
    b, t, w = h.shape
    return rms_norm(h.reshape(b, t, n_heads, w // n_heads), g.reshape(n_heads, w // n_heads)).reshape(b, t, w)


def modulate(h, shift, scale):
    return h * (1 + scale) + shift


def dw_conv(x, w):
    pad = CONV_W // 2
    t = x.shape[1]
    xp = jnp.pad(x, ((0, 0), (pad, pad), (0, 0)))
    return sum(xp[:, j:j + t] * w[j] for j in range(CONV_W))


def to_heads(x, n_heads):
    b, t, w = x.shape
    return x.reshape(b, t, n_heads, w // n_heads).transpose(0, 2, 1, 3).astype(jnp.float32)


def from_heads(x, dtype):
    b, h, t, d = x.shape
    return x.transpose(0, 2, 1, 3).reshape(b, t, h * d).astype(dtype)


def chunk(x, size):
    return x.reshape(x.shape[:2] + (x.shape[2] // size, size) + x.shape[3:])


def flip_time(xs):
    return tuple(None if t is None else jnp.flip(t, axis=2) for t in xs)


def mlstm_states(k, v, log_i, log_f, state):
    kc, vc = chunk(k, ML_CHUNK), chunk(v, ML_CHUNK)
    b = jnp.cumsum(chunk(log_f, ML_CHUNK), axis=-1)
    b_end = b[..., -1]
    w_end = b_end[..., None] - b + chunk(log_i, ML_CHUNK)
    m_kv = jnp.max(w_end, axis=-1)
    e = jnp.exp(w_end - m_kv[..., None])
    c_kv = jnp.einsum('bhnl,bhnlv,bhnlk->bhnvk', e, vc, kc)
    n_kv = jnp.einsum('bhnl,bhnlk->bhnk', e, kc)

    def step(carry, inp):
        c_st, n_st, m_st = carry
        be, mk, ck, nk = inp
        m_new = jnp.maximum(be + m_st, mk)
        a_old = jnp.exp(be + m_st - m_new)
        a_new = jnp.exp(mk - m_new)
        c_new = a_old[..., None, None] * c_st + a_new[..., None, None] * ck
        n_new = a_old[..., None] * n_st + a_new[..., None] * nk
        return (c_new, n_new, m_new), carry

    xs = tuple(jnp.moveaxis(t, 2, 0) for t in (b_end, m_kv, c_kv, n_kv))
    final, pre = lax.scan(step, state, xs)
    pre = tuple(jnp.moveaxis(t, 0, 2) for t in pre)
    return pre, final


def mlstm_outputs(q, k, v, log_i, log_f, pre):
    c_prev, n_prev, m_prev = pre
    bsz, nh, t, dv = v.shape
    qc = chunk(q, ML_CHUNK) * (q.shape[-1] ** -0.5)
    kc, vc = chunk(k, ML_CHUNK), chunk(v, ML_CHUNK)
    b = jnp.cumsum(chunk(log_f, ML_CHUNK), axis=-1)
    li = chunk(log_i, ML_CHUNK)
    causal = jnp.tril(jnp.ones((ML_CHUNK, ML_CHUNK), dtype=bool))
    d = jnp.where(causal, b[..., :, None] - b[..., None, :] + li[..., None, :], -jnp.inf)
    m_intra = jnp.max(d, axis=-1)
    m_inter = b + m_prev[..., None]
    m = jnp.maximum(m_inter, m_intra)
    s = jnp.einsum('bhntk,bhnsk->bhnts', qc, kc) * jnp.exp(d - m[..., None])
    a = jnp.exp(m_inter - m)
    num = jnp.einsum('bhnts,bhnsv->bhntv', s, vc) + a[..., None] * jnp.einsum('bhntk,bhnvk->bhntv', qc, c_prev)
    den = jnp.sum(s, axis=-1) + a * jnp.einsum('bhntk,bhnk->bhnt', qc, n_prev)
    h = num / jnp.maximum(jnp.abs(den), jnp.exp(-m))[..., None]
    return h.reshape(bsz, nh, t, dv)


def gla_states(k, v, log_a, state):
    kc, vc = chunk(k, GLA_CHUNK), chunk(v, GLA_CHUNK)
    b = jnp.cumsum(chunk(log_a, GLA_CHUNK), axis=3)
    b_end = b[:, :, :, -1]
    kv = jnp.einsum('bhnsk,bhnsv->bhnkv', kc * jnp.exp(b_end[:, :, :, None] - b), vc)

    def step(s_st, inp):
        be, kvc = inp
        return jnp.exp(be)[..., None] * s_st + kvc, s_st

    final, pre = lax.scan(step, state, (jnp.moveaxis(b_end, 2, 0), jnp.moveaxis(kv, 2, 0)))
    return jnp.moveaxis(pre, 0, 2), final


def gla_outputs(q, k, v, log_a, pre):
    bsz, nh, t, dv = v.shape
    qc = chunk(q, GLA_CHUNK) * (q.shape[-1] ** -0.5)
    kc, vc = chunk(k, GLA_CHUNK), chunk(v, GLA_CHUNK)
    b = jnp.cumsum(chunk(log_a, GLA_CHUNK), axis=3)
    inter = jnp.einsum('bhntk,bhnkv->bhntv', qc * jnp.exp(b), pre)
    causal = jnp.tril(jnp.ones((GLA_CHUNK, GLA_CHUNK), dtype=bool))
    diff = b[:, :, :, :, None, :] - b[:, :, :, None, :, :]
    decay = jnp.exp(jnp.where(causal[:, :, None], diff, -jnp.inf))
    att = jnp.einsum('bhntk,bhnsk,bhntsk->bhnts', qc, kc, decay)
    o = jnp.einsum('bhnts,bhnsv->bhntv', att, vc) + inter
    return o.reshape(bsz, nh, t, dv)


def bidirectional(state_fn, out_fn, ctx_f, ctx_b, lat_f, lat_b, init, ctx_out):
    cb, lb = flip_time(ctx_b), flip_time(lat_b)
    pre_cf, s_f = state_fn(*ctx_f[1:], init)
    pre_cb, s_b = state_fn(*cb[1:], init)
    pre_lf, _ = state_fn(*lat_f[1:], s_f)
    pre_lb, _ = state_fn(*lb[1:], s_b)
    y_lat = out_fn(*lat_f, pre_lf) + jnp.flip(out_fn(*lb, pre_lb), axis=2)
    y_ctx = (out_fn(*ctx_f, pre_cf) + jnp.flip(out_fn(*cb, pre_cb), axis=2)) if ctx_out else None
    return y_ctx, y_lat


def mlstm_prep(p, conv_w, b_gates, with_q):
    bsz, t, _ = p.shape
    k = to_heads(jax.nn.silu(dw_conv(p[..., OFF_ML_K:OFF_ML_V], conv_w[:, ML_WIDTH:])), N_ML_HEADS)
    q = to_heads(jax.nn.silu(dw_conv(p[..., OFF_ML_Q:OFF_ML_K], conv_w[:, :ML_WIDTH])), N_ML_HEADS) if with_q else None
    v = to_heads(p[..., OFF_ML_V:OFF_ML_O], N_ML_HEADS)
    g = (p[..., OFF_ML_G:OFF_GLA_Q] + b_gates).astype(jnp.float32)
    g = g.reshape(bsz, t, 4, N_ML_HEADS).transpose(2, 0, 3, 1)
    fwd = (q, k, v, g[0], jax.nn.log_sigmoid(g[1]))
    bwd = (q, k, v, g[2], jax.nn.log_sigmoid(g[3]))
    return fwd, bwd


def gla_prep(p, w_a2, b_a, with_q):
    q = to_heads(p[..., OFF_GLA_Q:OFF_GLA_K], N_GLA_HEADS) if with_q else None
    k = to_heads(p[..., OFF_GLA_K:OFF_GLA_V], N_GLA_HEADS)
    v = to_heads(p[..., OFF_GLA_V:OFF_GLA_R], N_GLA_HEADS)
    a_lr = p[..., OFF_GLA_A:PROJ_WIDTH]
    la_f = to_heads(jax.nn.log_sigmoid((a_lr[..., :GLA_RANK] @ w_a2[0] + b_a[0]).astype(jnp.float32)) / GLA_GATE_TAU, N_GLA_HEADS)
    la_b = to_heads(jax.nn.log_sigmoid((a_lr[..., GLA_RANK:] @ w_a2[1] + b_a[1]).astype(jnp.float32)) / GLA_GATE_TAU, N_GLA_HEADS)
    return (q, k, v, la_f), (q, k, v, la_b)


def merge_groups(h_ml, o_gla, p, g_ml, g_gla):
    y_ml = head_rms_norm(from_heads(h_ml, p.dtype), g_ml, N_ML_HEADS) * jax.nn.sigmoid(p[..., OFF_ML_O:OFF_ML_G])
    y_gla = head_rms_norm(from_heads(o_gla, p.dtype), g_gla, N_GLA_HEADS) * jax.nn.silu(p[..., OFF_GLA_R:OFF_GLA_A])
    return jnp.concatenate([y_ml, y_gla], axis=-1)


def token_mixers(hc, hl, w_in, conv_w, b_gates, w_a2, b_a, g_ml, g_gla, w_out, ctx_out):
    bsz = hl.shape[0]
    pc = hc @ w_in
    pl = hl @ w_in
    f32 = jnp.float32
    ml_init = (jnp.zeros((bsz, N_ML_HEADS, ML_HEAD_DIM, ML_HEAD_DIM), f32),
               jnp.zeros((bsz, N_ML_HEADS, ML_HEAD_DIM), f32),
               jnp.zeros((bsz, N_ML_HEADS), f32))
    gla_init = jnp.zeros((bsz, N_GLA_HEADS, GLA_KEY_DIM, GLA_VAL_DIM), f32)
    mc_f, mc_b = mlstm_prep(pc, conv_w, b_gates, ctx_out)
    ml_f, ml_b = mlstm_prep(pl, conv_w, b_gates, True)
    hm_c, hm_l = bidirectional(mlstm_states, mlstm_outputs, mc_f, mc_b, ml_f, ml_b, ml_init, ctx_out)
    gc_f, gc_b = gla_prep(pc, w_a2, b_a, ctx_out)
    gl_f, gl_b = gla_prep(pl, w_a2, b_a, True)
    go_c, go_l = bidirectional(gla_states, gla_outputs, gc_f, gc_b, gl_f, gl_b, gla_init, ctx_out)
    y_l = merge_groups(hm_l, go_l, pl, g_ml, g_gla) @ w_out
    y_c = (merge_groups(hm_c, go_c, pc, g_ml, g_gla) @ w_out) if ctx_out else None
    return y_c, y_l


def expert_choice_ffn(h, w_router, w_gate, w_up, w_down):
    n, d = h.shape[1], h.shape[2]
    cap = EC_FACTOR * n // N_EXPERTS
    aff = jax.nn.softmax(jnp.einsum('bnd,de->bne', h, w_router).astype(jnp.float32), axis=-1)
    g, idx = lax.top_k(jnp.swapaxes(aff, 1, 2), cap)
    xin = jax.vmap(lambda hb, ib: hb[ib])(h, idx)
    hid = jax.nn.silu(jnp.einsum('becd,edf->becf', xin, w_gate)) * jnp.einsum('becd,edf->becf', xin, w_up)
    y = jnp.einsum('becf,efd->becd', hid, w_down) * g[..., None].astype(h.dtype)
    return jax.vmap(lambda yb, ib: jnp.zeros((n, d), h.dtype).at[ib.reshape(-1)].add(yb.reshape(-1, d)))(y, idx)


def grid_pos_embedding(rows, d, dtype):
    r = jnp.broadcast_to(jnp.arange(rows, dtype=jnp.float32)[:, None], (rows, GRID_W)).reshape(-1)
    col = jnp.broadcast_to(jnp.arange(GRID_W, dtype=jnp.float32)[None, :], (rows, GRID_W)).reshape(-1)
    quarter = d // 4
    freq = jnp.power(POS_BASE, -jnp.arange(quarter, dtype=jnp.float32) / quarter)
    ar, ac = r[:, None] * freq, col[:, None] * freq
    return jnp.concatenate([jnp.sin(ar), jnp.cos(ar), jnp.sin(ac), jnp.cos(ac)], axis=-1).astype(dtype)


def setup_inputs(seed: int = 0) -> dict:
    key = jax.random.key(seed)
    ks = jax.random.split(key, 24)
    D, E, F = D_MODEL, N_EXPERTS, D_EXPERT

    def nrm(k, shape, scale):
        return scale * jax.random.normal(k, shape, jnp.float32)

    gate_base = jnp.repeat(jnp.array([0.0, 3.0, 0.0, 3.0], jnp.float32), N_ML_HEADS)
    return {
        "x": nrm(ks[0], (BATCH, SEQ, D), 1.0),
        "c": nrm(ks[1], (BATCH, D), 1.0),
        "ctx": nrm(ks[2], (BATCH, CTX_LEN, D), 1.0),
        "c_ctx": nrm(ks[3], (D,), 1.0),
        "w_ada": nrm(ks[4], (DEPTH, D, 6 * D), 0.5 * D ** -0.5),
        "b_ada": nrm(ks[5], (DEPTH, 6 * D), 0.02),
        "g_mix_pre": 1.0 + nrm(ks[6], (DEPTH, D), 0.05),
        "g_mix_post": 1.0 + nrm(ks[7], (DEPTH, D), 0.05),
        "g_ffn_pre": 1.0 + nrm(ks[8], (DEPTH, D), 0.05),
        "g_ffn_post": 1.0 + nrm(ks[9], (DEPTH, D), 0.05),
        "w_in": nrm(ks[10], (DEPTH, D, PROJ_WIDTH), D ** -0.5),
        "conv_qk": nrm(ks[11], (DEPTH, CONV_W, 2 * ML_WIDTH), 0.5),
        "b_ml_gates": gate_base + nrm(ks[12], (DEPTH, N_ML_GATES), 0.1),
        "w_gla_a2": nrm(ks[13], (DEPTH, 2, GLA_RANK, GLA_K_WIDTH), GLA_RANK ** -0.5),
        "b_gla_a": nrm(ks[14], (DEPTH, 2, GLA_K_WIDTH), 0.1),
        "g_ml_norm": 1.0 + nrm(ks[15], (DEPTH, ML_WIDTH), 0.05),
        "g_gla_norm": 1.0 + nrm(ks[16], (DEPTH, GLA_V_WIDTH), 0.05),
        "w_out": nrm(ks[17], (DEPTH, D, D), D ** -0.5),
        "w_router": nrm(ks[18], (DEPTH, D, E), D ** -0.5),
        "w_e_gate": nrm(ks[19], (DEPTH, E, D, F), D ** -0.5),
        "w_e_up": nrm(ks[20], (DEPTH, E, D, F), D ** -0.5),
        "w_e_down": nrm(ks[21], (DEPTH, E, F, D), F ** -0.5),
    }


def reference(x, c, ctx, c_ctx, w_ada, b_ada, g_mix_pre, g_mix_post, g_ffn_pre, g_ffn_post,
              w_in, conv_qk, b_ml_gates, w_gla_a2, b_gla_a, g_ml_norm, g_gla_norm, w_out,
              w_router, w_e_gate, w_e_up, w_e_down):
    n_tok = x.shape[1]
    rows = n_tok // GRID_W
    x = x + grid_pos_embedding(rows, x.shape[-1], x.dtype)[None]
    xc = ctx
    for l in range(DEPTH):
        last = l == DEPTH - 1
        mod = jax.nn.silu(c) @ w_ada[l] + b_ada[l]
        mod_c = jax.nn.silu(c_ctx) @ w_ada[l] + b_ada[l]
        sh1, sc1, ga1, sh2, sc2, ga2 = jnp.split(mod[:, None, :], 6, axis=-1)
        csh1, csc1, cga1, csh2, csc2, cga2 = jnp.split(mod_c, 6)
        hl = modulate(rms_norm(x, g_mix_pre[l]), sh1, sc1)
        hc = modulate(rms_norm(xc, g_mix_pre[l]), csh1, csc1)
        y_c, y_l = token_mixers(hc, hl, w_in[l], conv_qk[l], b_ml_gates[l], w_gla_a2[l], b_gla_a[l],
                                g_ml_norm[l], g_gla_norm[l], w_out[l], not last)
        x = x + ga1 * rms_norm(y_l, g_mix_post[l])
        hl2 = modulate(rms_norm(x, g_ffn_pre[l]), sh2, sc2)
        x = x + ga2 * rms_norm(expert_choice_ffn(hl2, w_router[l], w_e_gate[l], w_e_up[l], w_e_down[l]), g_ffn_post[l])
        if not last:
            xc = xc + cga1 * rms_norm(y_c, g_mix_post[l])
            hc2 = modulate(rms_norm(xc, g_ffn_pre[l]), csh2, csc2)
            xc = xc + cga2 * rms_norm(expert_choice_ffn(hc2, w_router[l], w_e_gate[l], w_e_up[l], w_e_down[l]), g_ffn_post[l])
    return x
```

```cpp
#include <hip/hip_runtime.h>
#include <math.h>

namespace {
constexpr int D = 1024, NB = 2, SEQ = 8192, CTX = 256, DEPTH = 2;
constexpr int NLAT = NB * SEQ;
constexpr int NCTX = NB * CTX;
constexpr int NROW = NLAT + NCTX;
constexpr int PW = 3632;
constexpr int OFF_ML_Q = 0, OFF_ML_K = 512, OFF_ML_V = 1024, OFF_ML_O = 1536, OFF_ML_G = 2048, OFF_GLA_Q = 2064,
              OFF_GLA_K = 2320, OFF_GLA_V = 2576, OFF_GLA_R = 3088, OFF_GLA_A = 3600;
constexpr int NE = 16;
constexpr int MZ = 2112;
constexpr float EPS = 1e-6f;

__device__ __forceinline__ float wave_sum(float v) {
#pragma unroll
    for (int o = 32; o > 0; o >>= 1) v += __shfl_xor(v, o);
    return v;
}
__device__ __forceinline__ float siluf(float x) { return x / (1.f + expf(-x)); }
__device__ __forceinline__ float sigmoidf(float x) { return 1.f / (1.f + expf(-x)); }
__device__ __forceinline__ float logsigmoidf(float x) { return fminf(x, 0.f) - log1pf(expf(-fabsf(x))); }
__device__ __forceinline__ int modrow(int row) { return row < NLAT ? row / SEQ : 2; }

__global__ void __launch_bounds__(256) k_ada(const float* c, const float* c_ctx, const float* w_ada, const float* b_ada, float* mod) {
    __shared__ float s[3][1024];
    for (int i = threadIdx.x; i < 1024; i += 256) { s[0][i] = siluf(c[i]); s[1][i] = siluf(c[1024 + i]); s[2][i] = siluf(c_ctx[i]); }
    __syncthreads();
    int gid = blockIdx.x * 256 + threadIdx.x;
    if (gid >= DEPTH * 6144) return;
    int l = gid / 6144, n = gid % 6144;
    const float* w = w_ada + (size_t)l * 1024 * 6144 + n;
    float a0 = 0, a1 = 0, a2 = 0;
    for (int k = 0; k < 1024; ++k) { float wv = w[(size_t)k * 6144]; a0 += s[0][k] * wv; a1 += s[1][k] * wv; a2 += s[2][k] * wv; }
    float bb = b_ada[l * 6144 + n];
    mod[(l * 3 + 0) * 6144 + n] = a0 + bb; mod[(l * 3 + 1) * 6144 + n] = a1 + bb; mod[(l * 3 + 2) * 6144 + n] = a2 + bb;
}

__global__ void __launch_bounds__(256) k_prep(const float* x, const float* ctx, float* xres) {
    size_t i = (size_t)blockIdx.x * 256 + threadIdx.x;
    if (i >= (size_t)NROW * 1024) return;
    int row = (int)(i / 1024), col = (int)(i % 1024);
    if (row < NLAT) {
        int t = row % SEQ, r = t / 64, cc = t % 64, q = col / 256, j = col % 256;
        float freq = powf(10000.f, -(float)j / 256.f);
        float arg = (float)(q < 2 ? r : cc) * freq;
        float e = (q & 1) ? cosf(arg) : sinf(arg);
        xres[i] = x[i] + e;
    } else xres[i] = ctx[i - (size_t)NLAT * 1024];
}

__global__ void __launch_bounds__(256) k_rowop_pre(const float* xres, const float* g, const float* modl, float* h) {
    int row = blockIdx.x * 4 + (threadIdx.x >> 6), lane = threadIdx.x & 63;
    if (row >= NROW) return;
    const float* xr = xres + (size_t)row * 1024;
    float v[16]; float ss = 0;
#pragma unroll
    for (int i = 0; i < 16; ++i) { v[i] = xr[i * 64 + lane]; ss += v[i] * v[i]; }
    ss = wave_sum(ss);
    float rstd = rsqrtf(ss * (1.f / 1024.f) + EPS);
    const float* m = modl + modrow(row) * 6144;
#pragma unroll
    for (int i = 0; i < 16; ++i) { int col = i * 64 + lane; h[(size_t)row * 1024 + col] = v[i] * rstd * g[col] * (1.f + m[1024 + col]) + m[col]; }
}

template <int MODE>
__global__ void __launch_bounds__(256) k_gemm(const float* A, int lda, const float* B0, const float* B1, int ldb, float* C, int ldc, int M, int N, int K,
                                              const int* gather, const float* gval, size_t strideA_z, size_t strideB_z, size_t strideC_z, int strideG_z) {
    __shared__ float As[16][68];
    __shared__ float Bs0[16][64];
    __shared__ float Bs1[MODE == 1 ? 16 : 1][64];
    const int z = blockIdx.z, tid = threadIdx.x, tx = tid & 15, ty = tid >> 4;
    const int m0 = blockIdx.y * 64, n0 = blockIdx.x * 64;
    A += z * strideA_z; B0 += z * strideB_z; if (MODE == 1) B1 += z * strideB_z; C += z * strideC_z;
    if (gather) gather += (size_t)z * strideG_z; if (gval) gval += (size_t)z * strideG_z;
    float acc0[4][4] = {}, acc1[4][4] = {};
    const int ar = tid >> 2, akq = (tid & 3) * 4;
    int am = m0 + ar; bool aok = am < M; int arow = aok ? (MODE == 1 ? gather[am] : am) : 0;
    const float* ap = A + (size_t)arow * lda + akq;
    const int bk = tid >> 4, bn = (tid & 15) * 4;
    bool bok = (n0 + bn) < N;
    for (int k0 = 0; k0 < K; k0 += 16) {
        float4 av = aok ? *(const float4*)(ap + k0) : make_float4(0, 0, 0, 0);
        As[akq + 0][ar] = av.x; As[akq + 1][ar] = av.y; As[akq + 2][ar] = av.z; As[akq + 3][ar] = av.w;
        float4 bv = bok ? *(const float4*)(B0 + (size_t)(k0 + bk) * ldb + n0 + bn) : make_float4(0, 0, 0, 0);
        *(float4*)&Bs0[bk][bn] = bv;
        if (MODE == 1) { float4 bu = bok ? *(const float4*)(B1 + (size_t)(k0 + bk) * ldb + n0 + bn) : make_float4(0, 0, 0, 0); *(float4*)&Bs1[bk][bn] = bu; }
        __syncthreads();
#pragma unroll
        for (int k = 0; k < 16; ++k) {
            float a[4], b[4], u[4];
#pragma unroll
            for (int i = 0; i < 4; ++i) a[i] = As[k][ty * 4 + i];
#pragma unroll
            for (int j = 0; j < 4; ++j) { b[j] = Bs0[k][tx * 4 + j]; if (MODE == 1) u[j] = Bs1[k][tx * 4 + j]; }
#pragma unroll
            for (int i = 0; i < 4; ++i)
#pragma unroll
                for (int j = 0; j < 4; ++j) { acc0[i][j] += a[i] * b[j]; if (MODE == 1) acc1[i][j] += a[i] * u[j]; }
        }
        __syncthreads();
    }
#pragma unroll
    for (int i = 0; i < 4; ++i) {
        int m = m0 + ty * 4 + i; if (m >= M) continue;
#pragma unroll
        for (int j = 0; j < 4; ++j) {
            int n = n0 + tx * 4 + j; if (n >= N) continue;
            if (MODE == 0) C[(size_t)m * ldc + n] = acc0[i][j];
            else if (MODE == 1) C[(size_t)m * ldc + n] = siluf(acc0[i][j]) * acc1[i][j];
            else atomicAdd(&C[(size_t)gather[m] * ldc + n], acc0[i][j] * gval[m]);
        }
    }
}

__global__ void __launch_bounds__(256) k_qkconv(const float* p, const float* conv  , float* qk) {
    size_t i = (size_t)blockIdx.x * 256 + threadIdx.x;
    if (i >= (size_t)NROW * 1024) return;
    int row = (int)(i / 1024), col = (int)(i % 1024);
    int seg0, seglen, t;
    if (row < NLAT) { seg0 = (row / SEQ) * SEQ; seglen = SEQ; } else { seg0 = NLAT + ((row - NLAT) / CTX) * CTX; seglen = CTX; }
    t = row - seg0;
    float a = 0;
#pragma unroll
    for (int j = 0; j < 3; ++j) { int tt = t - 1 + j; if (tt >= 0 && tt < seglen) a += p[(size_t)(seg0 + tt) * PW + col] * conv[j * 1024 + col]; }
    qk[i] = siluf(a);
}

__device__ __forceinline__ int seq_row(int b, int dir, int s) {
    if (s < CTX) { int t = dir ? (CTX - 1 - s) : s; return NLAT + b * CTX + t; }
    int t = s - CTX; if (dir) t = SEQ - 1 - t; return b * SEQ + t;
}

__global__ void __launch_bounds__(256) k_mlstm_rec(const float* p, const float* qk, const float* bg  , float* hm  , int ctx_out) {
    const int wave = blockIdx.x * 4 + (threadIdx.x >> 6), lane = threadIdx.x & 63;
    const int v = wave & 127, h = (wave >> 7) & 3, b = wave >> 9;
    const float scale = 0.08838834764831845f;
    for (int dir = 0; dir < 2; ++dir) {
        float c0 = 0, c1 = 0, n0 = 0, n1 = 0;
        const float bi = bg[(dir * 2 + 0) * 4 + h], bf = bg[(dir * 2 + 1) * 4 + h];
#pragma unroll 4
        for (int s = 0; s < CTX + SEQ; ++s) {
            const int row = seq_row(b, dir, s);
            const float* pr = p + (size_t)row * PW;
            const float* qr = qk + (size_t)row * 1024;
            const float gi = pr[OFF_ML_G + (dir * 2) * 4 + h] + bi, gf = pr[OFF_ML_G + (dir * 2 + 1) * 4 + h] + bf;
            const float ig = expf(gi), fg = sigmoidf(gf);
            const float k0 = qr[512 + h * 128 + lane], k1 = qr[512 + h * 128 + 64 + lane];
            const float vv = pr[OFF_ML_V + h * 128 + v];
            c0 = fg * c0 + ig * vv * k0; c1 = fg * c1 + ig * vv * k1;
            n0 = fg * n0 + ig * k0; n1 = fg * n1 + ig * k1;
            if (s >= CTX || ctx_out) {
                const float q0 = qr[h * 128 + lane] * scale, q1 = qr[h * 128 + 64 + lane] * scale;
                const float num = wave_sum(c0 * q0 + c1 * q1), den = wave_sum(n0 * q0 + n1 * q1);
                const float hv = num / fmaxf(fabsf(den), 1.f);
                if (lane == 0) { float* o = hm + (size_t)row * 512 + h * 128 + v; if (dir == 0) *o = hv; else *o += hv; }
            }
        }
    }
}

__global__ void __launch_bounds__(256) k_gla_rec(const float* p, const float* w_a2  , const float* b_a  , float* og  , int ctx_out) {
    const int wave = blockIdx.x * 4 + (threadIdx.x >> 6), lane = threadIdx.x & 63;
    const int v = wave & 127, h = (wave >> 7) & 3, b = wave >> 9;
    for (int dir = 0; dir < 2; ++dir) {
        float wa[16];
#pragma unroll
        for (int r = 0; r < 16; ++r) wa[r] = w_a2[(dir * 16 + r) * 256 + h * 64 + lane];
        const float ba = b_a[dir * 256 + h * 64 + lane];
        float S = 0;
#pragma unroll 4
        for (int s = 0; s < CTX + SEQ; ++s) {
            const int row = seq_row(b, dir, s);
            const float* pr = p + (size_t)row * PW;
            float x = ba;
#pragma unroll
            for (int r = 0; r < 16; ++r) x += pr[OFF_GLA_A + dir * 16 + r] * wa[r];
            const float a = expf(logsigmoidf(x) * (1.f / 16.f));
            const float kk = pr[OFF_GLA_K + h * 64 + lane], vv = pr[OFF_GLA_V + h * 128 + v];
            S = a * S + kk * vv;
            if (s >= CTX || ctx_out) {
                const float qq = pr[OFF_GLA_Q + h * 64 + lane] * 0.125f;
                const float o = wave_sum(qq * S);
                if (lane == 0) { float* op = og + (size_t)row * 512 + h * 128 + v; if (dir == 0) *op = o; else *op += o; }
            }
        }
    }
}

__global__ void __launch_bounds__(256) k_merge(const float* p, const float* hm, const float* og, const float* g_ml, const float* g_gla, float* merged, int nrows) {
    int row = blockIdx.x * 4 + (threadIdx.x >> 6), lane = threadIdx.x & 63;
    if (row >= nrows) return;
    const float* pr = p + (size_t)row * PW;
#pragma unroll
    for (int hh = 0; hh < 4; ++hh) {
        float a0 = hm[(size_t)row * 512 + hh * 128 + lane], a1 = hm[(size_t)row * 512 + hh * 128 + 64 + lane];
        float rstd = rsqrtf(wave_sum(a0 * a0 + a1 * a1) * (1.f / 128.f) + EPS);
        int c0 = hh * 128 + lane, c1 = c0 + 64;
        merged[(size_t)row * 1024 + c0] = a0 * rstd * g_ml[c0] * sigmoidf(pr[OFF_ML_O + c0]);
        merged[(size_t)row * 1024 + c1] = a1 * rstd * g_ml[c1] * sigmoidf(pr[OFF_ML_O + c1]);
    }
#pragma unroll
    for (int hh = 0; hh < 4; ++hh) {
        float a0 = og[(size_t)row * 512 + hh * 128 + lane], a1 = og[(size_t)row * 512 + hh * 128 + 64 + lane];
        float rstd = rsqrtf(wave_sum(a0 * a0 + a1 * a1) * (1.f / 128.f) + EPS);
        int c0 = hh * 128 + lane, c1 = c0 + 64;
        merged[(size_t)row * 1024 + 512 + c0] = a0 * rstd * g_gla[c0] * siluf(pr[OFF_GLA_R + c0]);
        merged[(size_t)row * 1024 + 512 + c1] = a1 * rstd * g_gla[c1] * siluf(pr[OFF_GLA_R + c1]);
    }
}

__global__ void __launch_bounds__(256) k_rowop_mid(float* xres, const float* y, const float* g_post, const float* g_pre2, const float* modl, const float* w_router  ,
                                                  float* hl2, float* aff, int nrows) {
    int row = blockIdx.x * 4 + (threadIdx.x >> 6), lane = threadIdx.x & 63;
    if (row >= nrows) return;
    const float* m = modl + modrow(row) * 6144;
    float yv[16], xv[16]; float ss = 0;
#pragma unroll
    for (int i = 0; i < 16; ++i) { yv[i] = y[(size_t)row * 1024 + i * 64 + lane]; ss += yv[i] * yv[i]; }
    float rstd = rsqrtf(wave_sum(ss) * (1.f / 1024.f) + EPS);
    ss = 0;
#pragma unroll
    for (int i = 0; i < 16; ++i) { int col = i * 64 + lane; xv[i] = xres[(size_t)row * 1024 + col] + m[2 * 1024 + col] * (yv[i] * rstd * g_post[col]); xres[(size_t)row * 1024 + col] = xv[i]; ss += xv[i] * xv[i]; }
    rstd = rsqrtf(wave_sum(ss) * (1.f / 1024.f) + EPS);
    float lg[16];
#pragma unroll
    for (int e = 0; e < 16; ++e) lg[e] = 0;
#pragma unroll
    for (int i = 0; i < 16; ++i) {
        int col = i * 64 + lane;
        float hv = xv[i] * rstd * g_pre2[col] * (1.f + m[4 * 1024 + col]) + m[3 * 1024 + col];
        hl2[(size_t)row * 1024 + col] = hv;
        const float4* wr = (const float4*)(w_router + (size_t)col * 16);
#pragma unroll
        for (int q = 0; q < 4; ++q) { float4 w = wr[q]; lg[q * 4 + 0] += hv * w.x; lg[q * 4 + 1] += hv * w.y; lg[q * 4 + 2] += hv * w.z; lg[q * 4 + 3] += hv * w.w; }
    }
    float mx = -1e30f;
#pragma unroll
    for (int e = 0; e < 16; ++e) { lg[e] = wave_sum(lg[e]); mx = fmaxf(mx, lg[e]); }
    float se = 0;
#pragma unroll
    for (int e = 0; e < 16; ++e) { lg[e] = expf(lg[e] - mx); se += lg[e]; }
    if (lane < 16) { float val = 0;
#pragma unroll
        for (int e = 0; e < 16; ++e) if (e == lane) val = lg[e];
        aff[(size_t)row * 16 + lane] = val / se; }
}

__global__ void __launch_bounds__(1024) k_topk(const float* aff, int* glist, float* gval) {
    __shared__ float vals[SEQ];
    const int list = blockIdx.x, isctx = list >= 32, b = (list & 31) >> 4, e = list & 15;
    const int n = isctx ? CTX : SEQ, cap = n / 8;
    const int row0 = isctx ? NLAT + b * CTX : b * SEQ;
    const int segoff = isctx ? 2048 + b * 32 : b * 1024;
    for (int i = threadIdx.x; i < n; i += 1024) vals[i] = aff[(size_t)(row0 + i) * 16 + e];
    __syncthreads();
    for (int i = threadIdx.x; i < n; i += 1024) {
        const float vi = vals[i]; int cnt = 0;
        for (int j = 0; j < n; ++j) { const float vj = vals[j]; cnt += (vj > vi || (vj == vi && j < i)) ? 1 : 0; }
        if (cnt < cap) { glist[e * MZ + segoff + cnt] = row0 + i; gval[e * MZ + segoff + cnt] = vi; }
    }
}

__global__ void __launch_bounds__(256) k_rowop_post(float* xres, const float* ffn, const float* g_post, const float* modl, float* out, int nrows) {
    int row = blockIdx.x * 4 + (threadIdx.x >> 6), lane = threadIdx.x & 63;
    if (row >= nrows) return;
    const float* m = modl + modrow(row) * 6144;
    float yv[16]; float ss = 0;
#pragma unroll
    for (int i = 0; i < 16; ++i) { yv[i] = ffn[(size_t)row * 1024 + i * 64 + lane]; ss += yv[i] * yv[i]; }
    float rstd = rsqrtf(wave_sum(ss) * (1.f / 1024.f) + EPS);
#pragma unroll
    for (int i = 0; i < 16; ++i) { int col = i * 64 + lane; float xv = xres[(size_t)row * 1024 + col] + m[5 * 1024 + col] * (yv[i] * rstd * g_post[col]); xres[(size_t)row * 1024 + col] = xv; if (out) out[(size_t)row * 1024 + col] = xv; }
}
}

extern "C" void kernel_launch(void* const* d_in, const int* in_sizes, int n_in, void* d_out, int out_size, void* d_ws, size_t ws_size, hipStream_t stream) {
    const float* x = (const float*)d_in[0]; const float* c = (const float*)d_in[1]; const float* ctx = (const float*)d_in[2]; const float* c_ctx = (const float*)d_in[3];
    const float* w_ada = (const float*)d_in[4]; const float* b_ada = (const float*)d_in[5];
    const float* g_mix_pre = (const float*)d_in[6]; const float* g_mix_post = (const float*)d_in[7]; const float* g_ffn_pre = (const float*)d_in[8]; const float* g_ffn_post = (const float*)d_in[9];
    const float* w_in = (const float*)d_in[10]; const float* conv_qk = (const float*)d_in[11]; const float* b_ml_gates = (const float*)d_in[12];
    const float* w_gla_a2 = (const float*)d_in[13]; const float* b_gla_a = (const float*)d_in[14]; const float* g_ml_norm = (const float*)d_in[15]; const float* g_gla_norm = (const float*)d_in[16];
    const float* w_out = (const float*)d_in[17]; const float* w_router = (const float*)d_in[18];
    const float* w_e_gate = (const float*)d_in[19]; const float* w_e_up = (const float*)d_in[20]; const float* w_e_down = (const float*)d_in[21];
    float* out = (float*)d_out;

    char* ws = (char*)d_ws; size_t off = 0;
    auto carve = [&](size_t bytes) { void* r = ws + off; off += (bytes + 255) & ~(size_t)255; return r; };
    float* xres = (float*)carve((size_t)NROW * 1024 * 4);
    float* bufA = (float*)carve((size_t)NROW * 1024 * 4);
    float* bufB = (float*)carve((size_t)NROW * 1024 * 4);
    float* pbuf = (float*)carve((size_t)NROW * PW * 4);
    float* mod = (float*)carve((size_t)DEPTH * 3 * 6144 * 4);
    float* aff = (float*)carve((size_t)NROW * 16 * 4);
    int* glist = (int*)carve((size_t)NE * MZ * 4);
    float* gval = (float*)carve((size_t)NE * MZ * 4);

    k_ada<<<(DEPTH * 6144 + 255) / 256, 256, 0, stream>>>(c, c_ctx, w_ada, b_ada, mod);
    k_prep<<<NROW * 4, 256, 0, stream>>>(x, ctx, xres);
    for (int l = 0; l < DEPTH; ++l) {
        const bool last = (l == DEPTH - 1);
        const float* modl = mod + (size_t)l * 3 * 6144;
        float* h = bufA;
        k_rowop_pre<<<NROW / 4, 256, 0, stream>>>(xres, g_mix_pre + l * 1024, modl, h);
        k_gemm<0><<<dim3((PW + 63) / 64, NROW / 64, 1), 256, 0, stream>>>(h, 1024, w_in + (size_t)l * 1024 * PW, nullptr, PW, pbuf, PW, NROW, PW, 1024, nullptr, nullptr, 0, 0, 0, 0);
        float* qk = bufB;
        k_qkconv<<<NROW * 4, 256, 0, stream>>>(pbuf, conv_qk + (size_t)l * 3 * 1024, qk);
        float* hm = bufA; float* og = bufA + (size_t)NROW * 512;
        k_mlstm_rec<<<256, 256, 0, stream>>>(pbuf, qk, b_ml_gates + l * 16, hm, last ? 0 : 1);
        k_gla_rec<<<256, 256, 0, stream>>>(pbuf, w_gla_a2 + (size_t)l * 2 * 16 * 256, b_gla_a + (size_t)l * 2 * 256, og, last ? 0 : 1);
        const int nrows = last ? NLAT : NROW;
        float* merged = bufB;
        k_merge<<<nrows / 4, 256, 0, stream>>>(pbuf, hm, og, g_ml_norm + l * 512, g_gla_norm + l * 512, merged, nrows);
        float* y = bufA;
        k_gemm<0><<<dim3(1024 / 64, nrows / 64, 1), 256, 0, stream>>>(merged, 1024, w_out + (size_t)l * 1024 * 1024, nullptr, 1024, y, 1024, nrows, 1024, 1024, nullptr, nullptr, 0, 0, 0, 0);
        float* hl2 = bufB;
        k_rowop_mid<<<nrows / 4, 256, 0, stream>>>(xres, y, g_mix_post + l * 1024, g_ffn_pre + l * 1024, modl, w_router + (size_t)l * 1024 * 16, hl2, aff, nrows);
        k_topk<<<last ? 32 : 64, 1024, 0, stream>>>(aff, glist, gval);
        const int mz = last ? 2048 : MZ;
        float* hid = pbuf; float* ffn = bufA;
        hipMemsetAsync(ffn, 0, (size_t)NROW * 1024 * 4, stream);
        k_gemm<1><<<dim3(1024 / 64, (mz + 63) / 64, NE), 256, 0, stream>>>(hl2, 1024, w_e_gate + (size_t)l * NE * 1024 * 1024, w_e_up + (size_t)l * NE * 1024 * 1024, 1024, hid, 1024, mz, 1024, 1024,
                                                                            glist, nullptr, 0, (size_t)1024 * 1024, (size_t)MZ * 1024, MZ);
        k_gemm<2><<<dim3(1024 / 64, (mz + 63) / 64, NE), 256, 0, stream>>>(hid, 1024, w_e_down + (size_t)l * NE * 1024 * 1024, nullptr, 1024, ffn, 1024, mz, 1024, 1024,
                                                                            glist, gval, (size_t)MZ * 1024, (size_t)1024 * 1024, 0, MZ);
        k_rowop_post<<<nrows / 4, 256, 0, stream>>>(xres, ffn, g_ffn_post + l * 1024, modl, last ? out : nullptr, nrows);
    }
}
```

```cpp
#include <hip/hip_runtime.h>
#include <hip/hip_cooperative_groups.h>
#include <math.h>
namespace cg = cooperative_groups;

namespace {
#define LAS __attribute__((address_space(3)))
typedef unsigned short bf16_t;
typedef short bf16x8 __attribute__((ext_vector_type(8)));
typedef float f32x4 __attribute__((ext_vector_type(4)));
typedef unsigned u32x4 __attribute__((ext_vector_type(4)));
typedef unsigned u32x2 __attribute__((ext_vector_type(2)));

constexpr int D = 1024, NB = 2, SEQ = 8192, CTX = 256, DEPTH = 2;
constexpr int NLAT = NB * SEQ;
constexpr int NCTX = NB * CTX;
constexpr int NROW = NLAT + NCTX;
constexpr int PW = 3632;
constexpr int PN = 3584;
constexpr int P_MLQ = 0, P_MLK = 512, P_MLV = 1024, P_MLO = 1536, P_GQ = 2048, P_GK = 2304, P_GV = 2560, P_GR = 3072;
constexpr int GA = 64;
constexpr int NE = 16;
constexpr int MZ = 2112;
constexpr float EPS = 1e-6f;
constexpr int NWG = 256, NTHR = 512;
constexpr int LDS_BYTES = 131072;

__device__ __forceinline__ float wave_sum(float v) {
#pragma unroll
    for (int o = 32; o > 0; o >>= 1) v += __shfl_xor(v, o);
    return v;
}
__device__ __forceinline__ float siluf(float x) { return x / (1.f + expf(-x)); }
__device__ __forceinline__ float sigmoidf(float x) { return 1.f / (1.f + expf(-x)); }
__device__ __forceinline__ float logsigmoidf(float x) { return fminf(x, 0.f) - log1pf(expf(-fabsf(x))); }
__device__ __forceinline__ int modrow(int row) { return row < NLAT ? row / SEQ : 2; }
__device__ __forceinline__ unsigned pk2(float lo, float hi) { unsigned r; asm("v_cvt_pk_bf16_f32 %0, %1, %2" : "=v"(r) : "v"(lo), "v"(hi)); return r; }
__device__ __forceinline__ float bf2f(bf16_t b) { return __uint_as_float(((unsigned)b) << 16); }
__device__ __forceinline__ float bflo(unsigned u) { return __uint_as_float(u << 16); }
__device__ __forceinline__ float bfhi(unsigned u) { return __uint_as_float(u & 0xffff0000u); }

struct Params {
    const float *x, *c, *ctx, *c_ctx, *w_ada, *b_ada, *g_mix_pre, *g_mix_post, *g_ffn_pre, *g_ffn_post, *w_in, *conv_qk, *b_ml_gates, *w_gla_a2, *b_gla_a, *g_ml_norm, *g_gla_norm,
        *w_out, *w_router, *w_e_gate, *w_e_up, *w_e_down;
    float* out;
    float* xc;
    bf16_t *WinT, *WgaT, *WoutT, *WegT, *WeuT, *WedT;
    bf16_t *abuf;
    bf16_t *p;
    float* pga;
    bf16_t *r1;
    float *hm, *og;
    float *qkf;
    float* mod;
    float* aff;
    int* glist; float* gval; int* inv;
    unsigned* bar;
    int pad_;
};

__device__ __forceinline__ float* xrow_ptr(const Params& P, int row) { return row < NLAT ? P.out + (size_t)row * 1024 : P.xc + (size_t)(row - NLAT) * 1024; }

__device__ __forceinline__ void transpose_item(const float* W, int ldw, int k0, int srccol0, int nvalid_lo, int nvalid_hi  , int special,
                                               bf16_t* WT, int dstrow0, LAS float* scr) {
    const int tid = threadIdx.x;
    {
        const int k = tid >> 3, n8 = (tid & 7) * 8;
#pragma unroll
        for (int q = 0; q < 2; ++q) {
            const int n = n8 + q * 4;
            float4 v = make_float4(0.f, 0.f, 0.f, 0.f);
            int sc;
            if (special) {
                if (n < 16) sc = 2048 + n; else if (n < 48) sc = 3600 + (n - 16); else sc = -1;
            } else sc = srccol0 + n;
            if (sc >= 0) v = *(const float4*)(W + (size_t)(k0 + k) * ldw + sc);
            scr[k * 65 + n + 0] = v.x; scr[k * 65 + n + 1] = v.y; scr[k * 65 + n + 2] = v.z; scr[k * 65 + n + 3] = v.w;
        }
    }
    __syncthreads();
    {
        const int n = tid >> 3, kc = (tid & 7) * 8;
        u32x4 o;
        o.x = pk2(scr[(kc + 0) * 65 + n], scr[(kc + 1) * 65 + n]); o.y = pk2(scr[(kc + 2) * 65 + n], scr[(kc + 3) * 65 + n]);
        o.z = pk2(scr[(kc + 4) * 65 + n], scr[(kc + 5) * 65 + n]); o.w = pk2(scr[(kc + 6) * 65 + n], scr[(kc + 7) * 65 + n]);
        *(u32x4*)(WT + (size_t)(dstrow0 + n) * 1024 + k0 + kc) = o;
    }
    __syncthreads();
}

constexpr int IT_IN = 16 * 56, IT_GA = 16, IT_OUT = 256, IT_EX = 3 * 16 * 256, IT_LAYER_SMALL = IT_IN + IT_GA + IT_OUT;
__device__ __forceinline__ void phase_prep_small(const Params& P, LAS unsigned char* lds, int wg, int nwg) {
    LAS float* scr = (LAS float*)lds;
    for (int it = wg; it < DEPTH * IT_LAYER_SMALL; it += nwg) {
        const int l = it / IT_LAYER_SMALL; int r = it % IT_LAYER_SMALL;
        if (r < IT_IN) { const int kb = r / 56, nb = r % 56, n0 = nb * 64; transpose_item(P.w_in + (size_t)l * 1024 * PW, PW, kb * 64, n0 + (n0 >= 2048 ? 16 : 0), 0, 64, 0, P.WinT + (size_t)l * PN * 1024, n0, scr); continue; }
        r -= IT_IN;
        if (r < IT_GA) { transpose_item(P.w_in + (size_t)l * 1024 * PW, PW, r * 64, 0, 0, 48, 1, P.WgaT + (size_t)l * 64 * 1024, 0, scr); continue; }
        r -= IT_GA;
        { const int kb = r / 16, nb = r % 16; transpose_item(P.w_out + (size_t)l * 1024 * 1024, 1024, kb * 64, nb * 64, 0, 64, 0, P.WoutT + (size_t)l * 1024 * 1024, nb * 64, scr); }
    }
}
__device__ __forceinline__ void phase_prep_experts(const Params& P, LAS unsigned char* lds, int l, int wg, int nwg) {
    LAS float* scr = (LAS float*)lds;
    for (int it = wg; it < IT_EX; it += nwg) {
        const int m = it / (16 * 256), e = (it / 256) % 16, r = it % 256, kb = r / 16, nb = r % 16;
        const float* src = (m == 0 ? P.w_e_gate : (m == 1 ? P.w_e_up : P.w_e_down)) + ((size_t)l * NE + e) * 1024 * 1024;
        bf16_t* dst = (m == 0 ? P.WegT : (m == 1 ? P.WeuT : P.WedT)) + (size_t)e * 1024 * 1024;
        transpose_item(src, 1024, kb * 64, nb * 64, 0, 64, 0, dst, nb * 64, scr);
    }
}

__device__ __forceinline__ void phase_ada(const Params& P, LAS unsigned char* lds, int wg, int nwg) {
    LAS float* s = (LAS float*)lds;
    for (int i = threadIdx.x; i < 1024; i += NTHR) { s[i] = siluf(P.c[i]); s[1024 + i] = siluf(P.c[1024 + i]); s[2048 + i] = siluf(P.c_ctx[i]); }
    __syncthreads();
    LAS float* red = s + 3072;
    for (int it = wg; it < DEPTH * 96; it += nwg) {
        const int l = it / 96, n = (it % 96) * 64 + (threadIdx.x & 63), ks = threadIdx.x >> 6;
        const float* w = P.w_ada + (size_t)l * 1024 * 6144 + n;
        float a0 = 0, a1 = 0, a2 = 0;
#pragma unroll 8
        for (int k = ks * 128; k < ks * 128 + 128; ++k) { const float wv = w[(size_t)k * 6144]; a0 += s[k] * wv; a1 += s[1024 + k] * wv; a2 += s[2048 + k] * wv; }
        red[(ks * 3 + 0) * 64 + (threadIdx.x & 63)] = a0; red[(ks * 3 + 1) * 64 + (threadIdx.x & 63)] = a1; red[(ks * 3 + 2) * 64 + (threadIdx.x & 63)] = a2;
        __syncthreads();
        if (threadIdx.x < 192) {
            const int r = threadIdx.x / 64, cidx = threadIdx.x & 63; float a = 0;
#pragma unroll
            for (int q = 0; q < 8; ++q) a += red[(q * 3 + r) * 64 + cidx];
            const int nn = (it % 96) * 64 + cidx;
            P.mod[((size_t)l * 3 + r) * 6144 + nn] = a + P.b_ada[l * 6144 + nn];
        }
        __syncthreads();
    }
}

__device__ __forceinline__ void phase_resid_init(const Params& P, int gw, int ngw, int lane) {
    for (int row = gw; row < NROW; row += ngw) {
        if (row < NLAT) {
            const int t = row % SEQ, r = t / 64, cc = t % 64;
#pragma unroll
            for (int j = 0; j < 4; ++j) {
                const int col = j * 256 + lane * 4;
                float4 v = *(const float4*)(P.x + (size_t)row * 1024 + col);
                float e[4];
#pragma unroll
                for (int q = 0; q < 4; ++q) { const int jj = (col + q) & 255; const float freq = powf(10000.f, -(float)jj / 256.f); const float arg = (float)(j < 2 ? r : cc) * freq; e[q] = (j & 1) ? cosf(arg) : sinf(arg); }
                v.x += e[0]; v.y += e[1]; v.z += e[2]; v.w += e[3];
                *(float4*)(P.out + (size_t)row * 1024 + col) = v;
            }
        } else {
#pragma unroll
            for (int j = 0; j < 4; ++j) { const int col = j * 256 + lane * 4; *(float4*)(P.xc + (size_t)(row - NLAT) * 1024 + col) = *(const float4*)(P.ctx + (size_t)(row - NLAT) * 1024 + col); }
        }
    }
}

__device__ __forceinline__ void store_bf16x4(bf16_t* p, float a, float b, float c, float d) { u32x2 o; o.x = pk2(a, b); o.y = pk2(c, d); *(u32x2*)p = o; }

__device__ __forceinline__ void phase_rowop_pre(const Params& P, int l, int gw, int ngw, int lane) {
    const float* g = P.g_mix_pre + l * 1024;
    for (int row = gw; row < NROW; row += ngw) {
        const float* xr = xrow_ptr(P, row);
        const float* m = P.mod + ((size_t)l * 3 + modrow(row)) * 6144;
        float4 v[4]; float ss = 0;
#pragma unroll
        for (int j = 0; j < 4; ++j) { v[j] = *(const float4*)(xr + j * 256 + lane * 4); ss += v[j].x * v[j].x + v[j].y * v[j].y + v[j].z * v[j].z + v[j].w * v[j].w; }
        const float rstd = rsqrtf(wave_sum(ss) * (1.f / 1024.f) + EPS);
#pragma unroll
        for (int j = 0; j < 4; ++j) {
            const int col = j * 256 + lane * 4;
            const float4 gg = *(const float4*)(g + col), sh = *(const float4*)(m + col), sc = *(const float4*)(m + 1024 + col);
            store_bf16x4(P.abuf + (size_t)row * 1024 + col, v[j].x * rstd * gg.x * (1.f + sc.x) + sh.x, v[j].y * rstd * gg.y * (1.f + sc.y) + sh.y,
                         v[j].z * rstd * gg.z * (1.f + sc.z) + sh.z, v[j].w * rstd * gg.w * (1.f + sc.w) + sh.w);
        }
    }
}

__device__ __forceinline__ void phase_rowop_mid(const Params& P, int l, int nrows, int gw, int ngw, int lane) {
    const float* g_post = P.g_mix_post + l * 1024; const float* g_pre2 = P.g_ffn_pre + l * 1024; const float* wr = P.w_router + (size_t)l * 1024 * 16;
    const bf16_t* y = P.r1;
    for (int row = gw; row < nrows; row += ngw) {
        float* xr = xrow_ptr(P, row);
        const float* m = P.mod + ((size_t)l * 3 + modrow(row)) * 6144;
        float yv[16], xv[16]; float ss = 0;
#pragma unroll
        for (int j = 0; j < 4; ++j) { const u32x2 u = *(const u32x2*)(y + (size_t)row * 1024 + j * 256 + lane * 4); yv[j * 4 + 0] = bflo(u.x); yv[j * 4 + 1] = bfhi(u.x); yv[j * 4 + 2] = bflo(u.y); yv[j * 4 + 3] = bfhi(u.y); }
#pragma unroll
        for (int i = 0; i < 16; ++i) ss += yv[i] * yv[i];
        float rstd = rsqrtf(wave_sum(ss) * (1.f / 1024.f) + EPS);
        ss = 0;
#pragma unroll
        for (int j = 0; j < 4; ++j) {
            const int col = j * 256 + lane * 4;
            const float4 xo = *(const float4*)(xr + col), gp = *(const float4*)(g_post + col), ga = *(const float4*)(m + 2048 + col);
            float4 xn; xn.x = xo.x + ga.x * (yv[j * 4 + 0] * rstd * gp.x); xn.y = xo.y + ga.y * (yv[j * 4 + 1] * rstd * gp.y); xn.z = xo.z + ga.z * (yv[j * 4 + 2] * rstd * gp.z); xn.w = xo.w + ga.w * (yv[j * 4 + 3] * rstd * gp.w);
            *(float4*)(xr + col) = xn;
            xv[j * 4 + 0] = xn.x; xv[j * 4 + 1] = xn.y; xv[j * 4 + 2] = xn.z; xv[j * 4 + 3] = xn.w;
            ss += xn.x * xn.x + xn.y * xn.y + xn.z * xn.z + xn.w * xn.w;
        }
        rstd = rsqrtf(wave_sum(ss) * (1.f / 1024.f) + EPS);
        float lg[16];
#pragma unroll
        for (int e = 0; e < 16; ++e) lg[e] = 0;
#pragma unroll
        for (int j = 0; j < 4; ++j) {
            const int col = j * 256 + lane * 4;
            const float4 gg = *(const float4*)(g_pre2 + col), sh = *(const float4*)(m + 3072 + col), sc = *(const float4*)(m + 4096 + col);
            float hv[4];
            hv[0] = xv[j * 4 + 0] * rstd * gg.x * (1.f + sc.x) + sh.x; hv[1] = xv[j * 4 + 1] * rstd * gg.y * (1.f + sc.y) + sh.y;
            hv[2] = xv[j * 4 + 2] * rstd * gg.z * (1.f + sc.z) + sh.z; hv[3] = xv[j * 4 + 3] * rstd * gg.w * (1.f + sc.w) + sh.w;
            store_bf16x4(P.abuf + (size_t)row * 1024 + col, hv[0], hv[1], hv[2], hv[3]);
#pragma unroll
            for (int q = 0; q < 4; ++q) {
                const float4* w4 = (const float4*)(wr + (size_t)(col + q) * 16);
#pragma unroll
                for (int e4 = 0; e4 < 4; ++e4) { const float4 w = w4[e4]; lg[e4 * 4 + 0] += hv[q] * w.x; lg[e4 * 4 + 1] += hv[q] * w.y; lg[e4 * 4 + 2] += hv[q] * w.z; lg[e4 * 4 + 3] += hv[q] * w.w; }
            }
        }
        float mx = -1e30f;
#pragma unroll
        for (int e = 0; e < 16; ++e) { lg[e] = wave_sum(lg[e]); mx = fmaxf(mx, lg[e]); }
        float se = 0;
#pragma unroll
        for (int e = 0; e < 16; ++e) { lg[e] = expf(lg[e] - mx); se += lg[e]; }
        float val = 0;
#pragma unroll
        for (int e = 0; e < 16; ++e) val = (e == lane) ? lg[e] : val;
        if (lane < 16) P.aff[(size_t)row * 16 + lane] = val / se;
    }
}

__device__ __forceinline__ void phase_rowop_post(const Params& P, int l, int nrows, int gw, int ngw, int lane) {
    const float* g_post = P.g_ffn_post + l * 1024;
    const bf16_t* yp = P.r1;
    for (int row = gw; row < nrows; row += ngw) {
        float* xr = xrow_ptr(P, row);
        const float* m = P.mod + ((size_t)l * 3 + modrow(row)) * 6144;
        float f[16];
#pragma unroll
        for (int i = 0; i < 16; ++i) f[i] = 0;
        const int myinv = P.inv[(size_t)row * 16 + (lane & 15)];
#pragma unroll 1
        for (int e = 0; e < 16; ++e) {
            const int pr = __shfl(myinv, e);
            if (pr >= 0) {
#pragma unroll
                for (int j = 0; j < 4; ++j) { const u32x2 u = *(const u32x2*)(yp + (size_t)pr * 1024 + j * 256 + lane * 4); f[j * 4 + 0] += bflo(u.x); f[j * 4 + 1] += bfhi(u.x); f[j * 4 + 2] += bflo(u.y); f[j * 4 + 3] += bfhi(u.y); }
            }
        }
        float ss = 0;
#pragma unroll
        for (int i = 0; i < 16; ++i) ss += f[i] * f[i];
        const float rstd = rsqrtf(wave_sum(ss) * (1.f / 1024.f) + EPS);
#pragma unroll
        for (int j = 0; j < 4; ++j) {
            const int col = j * 256 + lane * 4;
            const float4 xo = *(const float4*)(xr + col), gp = *(const float4*)(g_post + col), ga = *(const float4*)(m + 5120 + col);
            float4 xn; xn.x = xo.x + ga.x * (f[j * 4 + 0] * rstd * gp.x); xn.y = xo.y + ga.y * (f[j * 4 + 1] * rstd * gp.y); xn.z = xo.z + ga.z * (f[j * 4 + 2] * rstd * gp.z); xn.w = xo.w + ga.w * (f[j * 4 + 3] * rstd * gp.w);
            *(float4*)(xr + col) = xn;
        }
    }
}

constexpr int BK = 64, HALF = 128, HTB = HALF * BK * 2, GK = 1024;
__device__ __forceinline__ int lds_byte(int r, int c) { const int st = (r >> 4) * 2 + (c >> 5), rr = r & 15, cc = c & 31, ob = rr * 64 + cc * 2; return st * 1024 + (ob ^ (((ob >> 9) & 1) << 5)); }
__device__ __forceinline__ void stage_rc(int b, int& R, int& C) { const int st = b / 1024, sb = b % 1024, swz = sb ^ (((sb >> 9) & 1) << 5); R = (st >> 1) * 16 + swz / 64; C = (st & 1) * 32 + (swz % 64) / 2; }
__device__ __forceinline__ int perm32(int rho) { const int n = rho >> 4, i = rho & 15; return 8 * (i >> 2) + 4 * n + (i & 3); }

struct GUnit { int pm, pn, e, rows; };

template <class Sched, class Epi>
__device__ __forceinline__ void gemm_phase(LAS unsigned char* lds, const char* Abase, const Sched& S, const Epi& E) {
    const int tid = threadIdx.x, wid = __builtin_amdgcn_readfirstlane(tid >> 6), lane = tid & 63, wr = wid >> 2, wc = wid & 3, fr = lane & 15, fq = lane >> 4;
    constexpr int nt = GK / BK;
    int R0, C0, R1, C1; stage_rc(tid * 16, R0, C0); stage_rc(tid * 16 + 8192, R1, C1);
    const unsigned voffB0 = (unsigned)(((R0 & ~31) + perm32(R0 & 31)) * GK + C0) * 2u, voffB1 = (unsigned)(((R1 & ~31) + perm32(R1 & 31)) * GK + C1) * 2u;
    constexpr size_t kstep = (size_t)(BK * 2);
    const unsigned ldsw = (unsigned)wid * 1024u;
    const int aoff = lds_byte(wr * 64 + fr, fq * 8), boff = lds_byte(wc * 32 + fr, fq * 8);
#define G_SA(b, h) (((b) * 2 + (h)) * HTB)
#define G_SB(b, h) ((4 + (b) * 2 + (h)) * HTB)
#define G_GL(bufoff, p0, p1) do { __builtin_amdgcn_global_load_lds((const unsigned*)(p0), (LAS unsigned*)(lds + (bufoff) + ldsw), 16, 0, 0); \
        __builtin_amdgcn_global_load_lds((const unsigned*)(p1), (LAS unsigned*)(lds + (bufoff) + ldsw + 8192), 16, 0, 0); } while (0)
#define G_STA(bufoff, kptr, o0, o1) G_GL(bufoff, (kptr) + (o0), (kptr) + (o1))
#define G_STB(bufoff, bptr) G_GL(bufoff, (bptr) + voffB0, (bptr) + voffB1)
#define G_LDA(dst, b, h) do { _Pragma("unroll") for (int m = 0; m < 4; ++m) _Pragma("unroll") for (int k = 0; k < 2; ++k) dst[m][k] = *(const LAS bf16x8*)(lds + G_SA(b, h) + aoff + m * 2048 + k * 1024); } while (0)
#define G_LDB(dst, b, h) do { _Pragma("unroll") for (int n = 0; n < 2; ++n) _Pragma("unroll") for (int k = 0; k < 2; ++k) dst[n][k] = *(const LAS bf16x8*)(lds + G_SB(b, h) + boff + n * 2048 + k * 1024); } while (0)
#define G_MMA(ai, bj, At, Bt) do { __builtin_amdgcn_s_setprio(1); _Pragma("unroll") for (int m = 0; m < 4; ++m) _Pragma("unroll") for (int n = 0; n < 2; ++n) _Pragma("unroll") for (int k = 0; k < 2; ++k) \
        acc[ai][bj][m][n] = __builtin_amdgcn_mfma_f32_16x16x32_bf16(Bt[n][k], At[m][k], acc[ai][bj][m][n], 0, 0, 0); __builtin_amdgcn_s_setprio(0); } while (0)
#define G_WAIT_V(n) asm volatile("s_waitcnt vmcnt(" #n ")" ::: "memory")
#define G_WAIT_L(n) asm volatile("s_waitcnt lgkmcnt(" #n ")" ::: "memory")
#define G_BAR __builtin_amdgcn_s_barrier()
#define G_SCHED __builtin_amdgcn_sched_barrier(0)
    GUnit cur, nxt; int ui = 0;
    if (!S.next(0, cur)) return;
    f32x4 acc[2][2][4][2];
#pragma unroll
    for (int a = 0; a < 2; ++a)
#pragma unroll
        for (int b = 0; b < 2; ++b)
#pragma unroll
            for (int m = 0; m < 4; ++m)
#pragma unroll
                for (int n = 0; n < 2; ++n) acc[a][b][m][n] = (f32x4){0.f, 0.f, 0.f, 0.f};
    bf16x8 At[4][2], B0[2][2], B1[2][2];
    unsigned c00, c01, c10, c11, n00, n01, n10, n11;
    S.aoff(cur, 0, R0, C0, R1, C1, c00, c01); S.aoff(cur, 1, R0, C0, R1, C1, c10, c11);
    const char* cB0 = S.bptr(cur, 0); const char* cB1 = S.bptr(cur, 1);
    G_STB(G_SB(0, 0), cB0); G_STA(G_SA(0, 0), Abase, c00, c01); G_STB(G_SB(0, 1), cB1); G_STA(G_SA(0, 1), Abase, c10, c11);
    if (wr == 1) G_BAR;
    G_WAIT_V(4); G_BAR;
    G_STB(G_SB(1, 0), cB0 + kstep); G_STA(G_SA(1, 0), Abase + kstep, c00, c01); G_STB(G_SB(1, 1), cB1 + kstep);
    G_WAIT_V(6); G_BAR;
    for (;;) {
        const bool has_next = S.next(ui + 1, nxt);
        const char* nB0 = cB0; const char* nB1 = cB1;
        n00 = c00; n01 = c01; n10 = c10; n11 = c11;
        if (has_next) { S.aoff(nxt, 0, R0, C0, R1, C1, n00, n01); S.aoff(nxt, 1, R0, C0, R1, C1, n10, n11); nB0 = S.bptr(nxt, 0); nB1 = S.bptr(nxt, 1); }
        for (int t = 0; t < nt; t += 2) {
            const bool last = (t == nt - 2);
            const char* a1 = Abase + (size_t)(t + 1) * kstep;
            const char* a2 = last ? Abase : Abase + (size_t)(t + 2) * kstep;
            const char* b20 = last ? nB0 : cB0 + (size_t)(t + 2) * kstep; const char* b21 = last ? nB1 : cB1 + (size_t)(t + 2) * kstep;
            const char* a3 = a2 + kstep; const char* b30 = b20 + kstep; const char* b31 = b21 + kstep;
            const unsigned s00 = last ? n00 : c00, s01 = last ? n01 : c01, s10 = last ? n10 : c10, s11 = last ? n11 : c11;
            G_LDB(B0, 0, 0); G_SCHED; G_LDA(At, 0, 0); G_STA(G_SA(1, 1), a1, c10, c11);
            G_WAIT_L(8); G_BAR; G_WAIT_L(0); G_MMA(0, 0, At, B0); G_BAR; G_SCHED;
            G_LDB(B1, 0, 1); G_STB(G_SB(0, 0), b20);
            G_BAR; G_WAIT_L(0); G_MMA(0, 1, At, B1); G_BAR;
            G_LDA(At, 0, 1); G_STA(G_SA(0, 0), a2, s00, s01);
            G_BAR; G_WAIT_L(0); G_MMA(1, 0, At, B0); G_BAR; G_SCHED;
            G_STB(G_SB(0, 1), b21);
            G_WAIT_V(6); G_BAR; G_MMA(1, 1, At, B1); G_BAR;
            G_LDB(B0, 1, 0); G_SCHED; G_LDA(At, 1, 0); G_STA(G_SA(0, 1), a2, s10, s11);
            G_WAIT_L(8); G_BAR; G_WAIT_L(0); G_MMA(0, 0, At, B0); G_BAR; G_SCHED;
            G_LDB(B1, 1, 1); G_STB(G_SB(1, 0), b30);
            G_BAR; G_WAIT_L(0); G_MMA(0, 1, At, B1); G_BAR;
            G_LDA(At, 1, 1); G_STA(G_SA(1, 0), a3, s00, s01);
            G_BAR; G_WAIT_L(0); G_MMA(1, 0, At, B0); G_BAR; G_SCHED;
            G_STB(G_SB(1, 1), b31);
            G_WAIT_V(6); G_BAR; G_MMA(1, 1, At, B1); G_BAR;
        }
        E(acc, cur, wr, wc, fr, fq);
        if (!has_next) break;
#pragma unroll
        for (int a = 0; a < 2; ++a)
#pragma unroll
            for (int b = 0; b < 2; ++b)
#pragma unroll
                for (int m = 0; m < 4; ++m)
#pragma unroll
                    for (int n = 0; n < 2; ++n) acc[a][b][m][n] = (f32x4){0.f, 0.f, 0.f, 0.f};
        cur = nxt; cB0 = nB0; cB1 = nB1; c00 = n00; c01 = n01; c10 = n10; c11 = n11; ++ui;
    }
    G_WAIT_V(0);
    if (wr == 0) G_BAR;
    G_BAR;
#undef G_SA
#undef G_SB
#undef G_GL
#undef G_STA
#undef G_STB
#undef G_LDA
#undef G_LDB
#undef G_MMA
#undef G_WAIT_V
#undef G_WAIT_L
#undef G_BAR
#undef G_SCHED
}

struct SchedDense {
    int nM, nN, nwg, G, c; const char* Bt;
    __device__ __forceinline__ bool next(int i, GUnit& u) const {
        const long L = (long)i * G + c; if (L >= nwg) return false;
        int wgid = (int)L; { const int q = nwg / 8, r = nwg % 8, xcd = wgid % 8, off = wgid / 8; wgid = (xcd < r ? xcd * (q + 1) : r * (q + 1) + (xcd - r) * q) + off; }
        const int nig = 8 * nN, gid = wgid / nig, fm = gid * 8, gsz = (nM - fm) < 8 ? (nM - fm) : 8;
        u.pm = fm + ((wgid % nig) % gsz); u.pn = (wgid % nig) / gsz; u.e = 0; u.rows = 256; return true;
    }
    __device__ __forceinline__ void aoff(const GUnit& u, int h, int R0, int C0, int R1, int C1, unsigned& o0, unsigned& o1) const {
        const unsigned base = (unsigned)(u.pm * 256 + h * 128);
        o0 = ((base + R0) * GK + C0) * 2u; o1 = ((base + R1) * GK + C1) * 2u;
    }
    __device__ __forceinline__ const char* bptr(const GUnit& u, int h) const { return Bt + (size_t)(u.pn * 256 + h * 128) * GK * 2; }
};
struct SchedGateUp {
    int G, c, mtn; const int* glist; const char* Wg; const char* Wu;
    __device__ __forceinline__ bool next(int i, GUnit& u) const {
        const int x = c & 7, j = c >> 3, per = G >> 3, L = i * per + j, tot = 2 * mtn * 8;
        if (L >= tot) return false;
        const int es = L / (mtn * 8), rem = L % (mtn * 8);
        u.e = x + 8 * es; u.pm = rem >> 3; u.pn = rem & 7; u.rows = (u.pm == 8) ? 64 : 256; return true;
    }
    __device__ __forceinline__ void aoff(const GUnit& u, int h, int R0, int C0, int R1, int C1, unsigned& o0, unsigned& o1) const {
        int r0 = h * 128 + R0, r1 = h * 128 + R1;
        r0 = r0 < u.rows ? r0 : 0; r1 = r1 < u.rows ? r1 : 0;
        const int g0 = glist[u.e * MZ + u.pm * 256 + r0], g1 = glist[u.e * MZ + u.pm * 256 + r1];
        o0 = ((unsigned)g0 * GK + C0) * 2u; o1 = ((unsigned)g1 * GK + C1) * 2u;
    }
    __device__ __forceinline__ const char* bptr(const GUnit& u, int h) const { return (h ? Wu : Wg) + ((size_t)u.e * 1024 + u.pn * 128) * GK * 2; }
};
struct SchedDown {
    int G, c, mtn; const char* Wd;
    __device__ __forceinline__ bool next(int i, GUnit& u) const {
        const int x = c & 7, j = c >> 3, per = G >> 3, L = i * per + j, tot = 2 * mtn * 4;
        if (L >= tot) return false;
        const int es = L / (mtn * 4), rem = L % (mtn * 4);
        u.e = x + 8 * es; u.pm = rem >> 2; u.pn = rem & 3; u.rows = (u.pm == 8) ? 64 : 256; return true;
    }
    __device__ __forceinline__ void aoff(const GUnit& u, int h, int R0, int C0, int R1, int C1, unsigned& o0, unsigned& o1) const {
        const unsigned base = (unsigned)(u.e * MZ + u.pm * 256 + h * 128);
        o0 = ((base + R0) * GK + C0) * 2u; o1 = ((base + R1) * GK + C1) * 2u;
    }
    __device__ __forceinline__ const char* bptr(const GUnit& u, int h) const { return Wd + ((size_t)u.e * 1024 + u.pn * 256 + h * 128) * GK * 2; }
};

struct EpiStoreBf16 {
    bf16_t* O; int ldo;
    __device__ __forceinline__ void operator()(const f32x4 (&acc)[2][2][4][2], const GUnit& u, int wr, int wc, int fr, int fq) const {
#pragma unroll
        for (int ai = 0; ai < 2; ++ai)
#pragma unroll
            for (int m = 0; m < 4; ++m) {
                bf16_t* rowp = O + (size_t)(u.pm * 256 + ai * 128 + wr * 64 + m * 16 + fr) * ldo + u.pn * 256 + wc * 32 + 8 * fq;
#pragma unroll
                for (int bj = 0; bj < 2; ++bj) { const f32x4 v0 = acc[ai][bj][m][0], v1 = acc[ai][bj][m][1]; u32x4 o; o.x = pk2(v0[0], v0[1]); o.y = pk2(v0[2], v0[3]); o.z = pk2(v1[0], v1[1]); o.w = pk2(v1[2], v1[3]); *(u32x4*)(rowp + bj * 128) = o; }
            }
    }
};
struct EpiGateUp {
    bf16_t* hid;
    __device__ __forceinline__ void operator()(const f32x4 (&acc)[2][2][4][2], const GUnit& u, int wr, int wc, int fr, int fq) const {
#pragma unroll
        for (int ai = 0; ai < 2; ++ai)
#pragma unroll
            for (int m = 0; m < 4; ++m) {
                const int r = ai * 128 + wr * 64 + m * 16 + fr;
                if (r < u.rows) {
                    float h[8];
#pragma unroll
                    for (int n = 0; n < 2; ++n)
#pragma unroll
                        for (int j = 0; j < 4; ++j) { const float g = acc[ai][0][m][n][j], up = acc[ai][1][m][n][j]; h[n * 4 + j] = g * __frcp_rn(1.f + __expf(-g)) * up; }
                    u32x4 o; o.x = pk2(h[0], h[1]); o.y = pk2(h[2], h[3]); o.z = pk2(h[4], h[5]); o.w = pk2(h[6], h[7]);
                    *(u32x4*)(hid + (size_t)(u.e * MZ + u.pm * 256 + r) * 1024 + u.pn * 128 + wc * 32 + 8 * fq) = o;
                }
            }
    }
};
struct EpiDown {
    bf16_t* yp; const float* gval;
    __device__ __forceinline__ void operator()(const f32x4 (&acc)[2][2][4][2], const GUnit& u, int wr, int wc, int fr, int fq) const {
#pragma unroll
        for (int ai = 0; ai < 2; ++ai)
#pragma unroll
            for (int m = 0; m < 4; ++m) {
                const int r = ai * 128 + wr * 64 + m * 16 + fr;
                if (r < u.rows) {
                    const int pr = u.e * MZ + u.pm * 256 + r; const float g = gval[pr];
                    bf16_t* rowp = yp + (size_t)pr * 1024 + u.pn * 256 + wc * 32 + 8 * fq;
#pragma unroll
                    for (int bj = 0; bj < 2; ++bj) { const f32x4 v0 = acc[ai][bj][m][0] * g, v1 = acc[ai][bj][m][1] * g; u32x4 o; o.x = pk2(v0[0], v0[1]); o.y = pk2(v0[2], v0[3]); o.z = pk2(v1[0], v1[1]); o.w = pk2(v1[2], v1[3]); *(u32x4*)(rowp + bj * 128) = o; }
                }
            }
    }
};

__device__ __forceinline__ void phase_gates(const Params& P, int l, int gw, int ngw, int lane) {
    const int fr = lane & 15, fq = lane >> 4;
    const bf16_t* W = P.WgaT + (size_t)l * 64 * 1024;
    for (int rb = gw; rb < NROW / 16; rb += ngw) {
        f32x4 acc[4];
#pragma unroll
        for (int n = 0; n < 4; ++n) acc[n] = (f32x4){0.f, 0.f, 0.f, 0.f};
        const bf16_t* arow = P.abuf + (size_t)(rb * 16 + fr) * 1024 + fq * 8;
#pragma unroll 4
        for (int k0 = 0; k0 < 1024; k0 += 32) {
            const bf16x8 a = *(const bf16x8*)(arow + k0);
#pragma unroll
            for (int n = 0; n < 4; ++n) { const bf16x8 b = *(const bf16x8*)(W + (size_t)(n * 16 + fr) * 1024 + k0 + fq * 8); acc[n] = __builtin_amdgcn_mfma_f32_16x16x32_bf16(a, b, acc[n], 0, 0, 0); }
        }
#pragma unroll
        for (int n = 0; n < 4; ++n)
#pragma unroll
            for (int j = 0; j < 4; ++j) P.pga[(size_t)(rb * 16 + fq * 4 + j) * GA + n * 16 + fr] = acc[n][j];
    }
}

__device__ __forceinline__ int seq_row(int b, int dir, int s) {
    if (s < CTX) { int t = dir ? (CTX - 1 - s) : s; return NLAT + b * CTX + t; }
    int t = s - CTX; if (dir) t = SEQ - 1 - t; return b * SEQ + t;
}
__global__ void __launch_bounds__(256) k_qkconv(Params P, int l) {
    const float* conv = P.conv_qk + (size_t)l * 3 * 1024;
    size_t i = (size_t)blockIdx.x * 256 + threadIdx.x;
    if (i >= (size_t)NROW * 1024) return;
    int row = (int)(i / 1024), col = (int)(i % 1024);
    int seg0, seglen;
    if (row < NLAT) { seg0 = (row / SEQ) * SEQ; seglen = SEQ; } else { seg0 = NLAT + ((row - NLAT) / CTX) * CTX; seglen = CTX; }
    const int t = row - seg0;
    float a = 0;
#pragma unroll
    for (int j = 0; j < 3; ++j) { int tt = t - 1 + j; if (tt >= 0 && tt < seglen) a += bf2f(P.p[(size_t)(seg0 + tt) * PN + col]) * conv[j * 1024 + col]; }
    P.qkf[i] = siluf(a);
}
__global__ void __launch_bounds__(256) k_mlstm_rec(Params P, int l, int ctx_out) {
    const float* bg = P.b_ml_gates + l * 16;
    const int wave = blockIdx.x * 4 + (threadIdx.x >> 6), lane = threadIdx.x & 63;
    const int v = wave & 127, h = (wave >> 7) & 3, b = wave >> 9;
    const float scale = 0.08838834764831845f;
    for (int dir = 0; dir < 2; ++dir) {
        float c0 = 0, c1 = 0, n0 = 0, n1 = 0;
        const float bi = bg[(dir * 2 + 0) * 4 + h], bf = bg[(dir * 2 + 1) * 4 + h];
#pragma unroll 4
        for (int s = 0; s < CTX + SEQ; ++s) {
            const int row = seq_row(b, dir, s);
            const bf16_t* pr = P.p + (size_t)row * PN;
            const float* ga = P.pga + (size_t)row * GA;
            const float* qr = P.qkf + (size_t)row * 1024;
            const float gi = ga[(dir * 2) * 4 + h] + bi, gf = ga[(dir * 2 + 1) * 4 + h] + bf;
            const float ig = expf(gi), fg = sigmoidf(gf);
            const float k0 = qr[512 + h * 128 + lane], k1 = qr[512 + h * 128 + 64 + lane];
            const float vv = bf2f(pr[P_MLV + h * 128 + v]);
            c0 = fg * c0 + ig * vv * k0; c1 = fg * c1 + ig * vv * k1;
            n0 = fg * n0 + ig * k0; n1 = fg * n1 + ig * k1;
            if (s >= CTX || ctx_out) {
                const float q0 = qr[h * 128 + lane] * scale, q1 = qr[h * 128 + 64 + lane] * scale;
                const float num = wave_sum(c0 * q0 + c1 * q1), den = wave_sum(n0 * q0 + n1 * q1);
                const float hv = num / fmaxf(fabsf(den), 1.f);
                if (lane == 0) { float* o = P.hm + (size_t)row * 512 + h * 128 + v; if (dir == 0) *o = hv; else *o += hv; }
            }
        }
    }
}
__global__ void __launch_bounds__(256) k_gla_rec(Params P, int l, int ctx_out) {
    const float* w_a2 = P.w_gla_a2 + (size_t)l * 2 * 16 * 256; const float* b_a = P.b_gla_a + (size_t)l * 2 * 256;
    const int wave = blockIdx.x * 4 + (threadIdx.x >> 6), lane = threadIdx.x & 63;
    const int v = wave & 127, h = (wave >> 7) & 3, b = wave >> 9;
    for (int dir = 0; dir < 2; ++dir) {
        float wa[16];
#pragma unroll
        for (int r = 0; r < 16; ++r) wa[r] = w_a2[(dir * 16 + r) * 256 + h * 64 + lane];
        const float ba = b_a[dir * 256 + h * 64 + lane];
        float S = 0;
#pragma unroll 4
        for (int s = 0; s < CTX + SEQ; ++s) {
            const int row = seq_row(b, dir, s);
            const bf16_t* pr = P.p + (size_t)row * PN;
            const float* ga = P.pga + (size_t)row * GA;
            float x = ba;
#pragma unroll
            for (int r = 0; r < 16; ++r) x += ga[16 + dir * 16 + r] * wa[r];
            const float a = expf(logsigmoidf(x) * (1.f / 16.f));
            const float kk = bf2f(pr[P_GK + h * 64 + lane]), vv = bf2f(pr[P_GV + h * 128 + v]);
            S = a * S + kk * vv;
            if (s >= CTX || ctx_out) {
                const float qq = bf2f(pr[P_GQ + h * 64 + lane]) * 0.125f;
                const float o = wave_sum(qq * S);
                if (lane == 0) { float* op = P.og + (size_t)row * 512 + h * 128 + v; if (dir == 0) *op = o; else *op += o; }
            }
        }
    }
}
__global__ void __launch_bounds__(256) k_merge(Params P, int l, int nrows) {
    const float* g_ml = P.g_ml_norm + l * 512; const float* g_gla = P.g_gla_norm + l * 512;
    int row = blockIdx.x * 4 + (threadIdx.x >> 6), lane = threadIdx.x & 63;
    if (row >= nrows) return;
    const bf16_t* pr = P.p + (size_t)row * PN;
    bf16_t* mr = P.abuf + (size_t)row * 1024;
#pragma unroll
    for (int hh = 0; hh < 4; ++hh) {
        float a0 = P.hm[(size_t)row * 512 + hh * 128 + lane], a1 = P.hm[(size_t)row * 512 + hh * 128 + 64 + lane];
        float rstd = rsqrtf(wave_sum(a0 * a0 + a1 * a1) * (1.f / 128.f) + EPS);
        int c0 = hh * 128 + lane, c1 = c0 + 64;
        mr[c0] = (bf16_t)(pk2(a0 * rstd * g_ml[c0] * sigmoidf(bf2f(pr[P_MLO + c0])), 0.f) & 0xffff);
        mr[c1] = (bf16_t)(pk2(a1 * rstd * g_ml[c1] * sigmoidf(bf2f(pr[P_MLO + c1])), 0.f) & 0xffff);
    }
#pragma unroll
    for (int hh = 0; hh < 4; ++hh) {
        float a0 = P.og[(size_t)row * 512 + hh * 128 + lane], a1 = P.og[(size_t)row * 512 + hh * 128 + 64 + lane];
        float rstd = rsqrtf(wave_sum(a0 * a0 + a1 * a1) * (1.f / 128.f) + EPS);
        int c0 = hh * 128 + lane, c1 = c0 + 64;
        mr[512 + c0] = (bf16_t)(pk2(a0 * rstd * g_gla[c0] * siluf(bf2f(pr[P_GR + c0])), 0.f) & 0xffff);
        mr[512 + c1] = (bf16_t)(pk2(a1 * rstd * g_gla[c1] * siluf(bf2f(pr[P_GR + c1])), 0.f) & 0xffff);
    }
}
__global__ void __launch_bounds__(1024) k_topk(Params P) {
    __shared__ float vals[SEQ];
    const int list = blockIdx.x, isctx = list >= 32, b = (list & 31) >> 4, e = list & 15;
    const int n = isctx ? CTX : SEQ, cap = n / 8;
    const int row0 = isctx ? NLAT + b * CTX : b * SEQ;
    const int segoff = isctx ? 2048 + b * 32 : b * 1024;
    for (int i = threadIdx.x; i < n; i += 1024) vals[i] = P.aff[(size_t)(row0 + i) * 16 + e];
    __syncthreads();
    for (int i = threadIdx.x; i < n; i += 1024) {
        const float vi = vals[i]; int cnt = 0;
        for (int j = 0; j < n; ++j) { const float vj = vals[j]; cnt += (vj > vi || (vj == vi && j < i)) ? 1 : 0; }
        int pr = -1;
        if (cnt < cap) { pr = e * MZ + segoff + cnt; P.glist[pr] = row0 + i; P.gval[pr] = vi; }
        P.inv[(size_t)(row0 + i) * 16 + e] = pr;
    }
}

extern __shared__ __attribute__((aligned(16))) unsigned char smem_dyn[];
#define PH_COMMON LAS unsigned char* lds = (LAS unsigned char*)smem_dyn; const int wg = blockIdx.x, nwg = gridDim.x; const int lane = threadIdx.x & 63; const int gw = wg * 8 + (threadIdx.x >> 6), ngw = nwg * 8; (void)lds; (void)lane; (void)gw; (void)ngw;

__global__ void __launch_bounds__(512, 2) k_prep(Params P) { PH_COMMON phase_prep_small(P, lds, wg, nwg); phase_ada(P, lds, wg, nwg); phase_resid_init(P, gw, ngw, lane); }
__global__ void __launch_bounds__(512, 2) k_prep_experts(Params P, int l) { PH_COMMON phase_prep_experts(P, lds, l, wg, nwg); }
__global__ void __launch_bounds__(512, 2) k_rowop_pre(Params P, int l) { PH_COMMON phase_rowop_pre(P, l, gw, ngw, lane); }
__global__ void __launch_bounds__(512, 2) k_gemm_in(Params P, int l) {
    PH_COMMON
    SchedDense S; S.nM = NROW / 256; S.nN = PN / 256; S.nwg = S.nM * S.nN; S.G = nwg; S.c = wg; S.Bt = (const char*)(P.WinT + (size_t)l * PN * 1024);
    EpiStoreBf16 E; E.O = P.p; E.ldo = PN;
    gemm_phase(lds, (const char*)P.abuf, S, E);
    phase_gates(P, l, gw, ngw, lane);
}
__global__ void __launch_bounds__(512, 2) k_gemm_out(Params P, int l, int nrows) {
    PH_COMMON
    SchedDense S; S.nM = nrows / 256; S.nN = 4; S.nwg = S.nM * S.nN; S.G = nwg; S.c = wg; S.Bt = (const char*)(P.WoutT + (size_t)l * 1024 * 1024);
    EpiStoreBf16 E; E.O = P.r1; E.ldo = 1024;
    gemm_phase(lds, (const char*)P.abuf, S, E);
}
__global__ void __launch_bounds__(512, 2) k_rowop_mid(Params P, int l, int nrows) { PH_COMMON phase_rowop_mid(P, l, nrows, gw, ngw, lane); }
__global__ void __launch_bounds__(512, 2) k_gemm_gateup(Params P, int mtn) {
    PH_COMMON
    SchedGateUp S; S.G = nwg; S.c = wg; S.mtn = mtn; S.glist = P.glist; S.Wg = (const char*)P.WegT; S.Wu = (const char*)P.WeuT;
    EpiGateUp E; E.hid = P.p;
    gemm_phase(lds, (const char*)P.abuf, S, E);
}
__global__ void __launch_bounds__(512, 2) k_gemm_down(Params P, int mtn) {
    PH_COMMON
    SchedDown S; S.G = nwg; S.c = wg; S.mtn = mtn; S.Wd = (const char*)P.WedT;
    EpiDown E; E.yp = P.r1; E.gval = P.gval;
    gemm_phase(lds, (const char*)P.p, S, E);
}
__global__ void __launch_bounds__(512, 2) k_rowop_post(Params P, int l, int nrows) { PH_COMMON phase_rowop_post(P, l, nrows, gw, ngw, lane); }

__global__ void __launch_bounds__(512, 2) k_skeleton(Params P) {
    cg::grid_group grid = cg::this_grid();
    unsigned* w = P.bar + 1024;
    if (threadIdx.x == 0) w[blockIdx.x] = blockIdx.x + 1;
    grid.sync();
    unsigned s = 0;
    if (threadIdx.x == 0) { for (int i = 0; i < (int)gridDim.x; ++i) s += w[i]; w[512 + blockIdx.x] = s; }
    grid.sync();
    if (threadIdx.x == 0 && blockIdx.x == 0) { unsigned ok = 1; for (int i = 0; i < (int)gridDim.x; ++i) ok &= (w[512 + i] == (unsigned)(gridDim.x * (gridDim.x + 1) / 2)); w[1023] = ok; }
}
}

extern "C" void kernel_launch(void* const* d_in, const int* in_sizes, int n_in, void* d_out, int out_size, void* d_ws, size_t ws_size, hipStream_t stream) {
    Params P{};
    P.x = (const float*)d_in[0]; P.c = (const float*)d_in[1]; P.ctx = (const float*)d_in[2]; P.c_ctx = (const float*)d_in[3];
    P.w_ada = (const float*)d_in[4]; P.b_ada = (const float*)d_in[5];
    P.g_mix_pre = (const float*)d_in[6]; P.g_mix_post = (const float*)d_in[7]; P.g_ffn_pre = (const float*)d_in[8]; P.g_ffn_post = (const float*)d_in[9];
    P.w_in = (const float*)d_in[10]; P.conv_qk = (const float*)d_in[11]; P.b_ml_gates = (const float*)d_in[12];
    P.w_gla_a2 = (const float*)d_in[13]; P.b_gla_a = (const float*)d_in[14]; P.g_ml_norm = (const float*)d_in[15]; P.g_gla_norm = (const float*)d_in[16];
    P.w_out = (const float*)d_in[17]; P.w_router = (const float*)d_in[18];
    P.w_e_gate = (const float*)d_in[19]; P.w_e_up = (const float*)d_in[20]; P.w_e_down = (const float*)d_in[21];
    P.out = (float*)d_out;

    char* ws = (char*)d_ws; size_t off = 0;
    auto carve = [&](size_t bytes) { void* r = ws + off; off += (bytes + 255) & ~(size_t)255; return r; };
    P.bar = (unsigned*)carve(65536);
    P.xc = (float*)carve((size_t)NCTX * 1024 * 4);
    P.WinT = (bf16_t*)carve((size_t)DEPTH * PN * 1024 * 2);
    P.WgaT = (bf16_t*)carve((size_t)DEPTH * 64 * 1024 * 2);
    P.WoutT = (bf16_t*)carve((size_t)DEPTH * 1024 * 1024 * 2);
    P.WegT = (bf16_t*)carve((size_t)NE * 1024 * 1024 * 2);
    P.WeuT = (bf16_t*)carve((size_t)NE * 1024 * 1024 * 2);
    P.WedT = (bf16_t*)carve((size_t)NE * 1024 * 1024 * 2);
    P.abuf = (bf16_t*)carve((size_t)NROW * 1024 * 2);
    P.p = (bf16_t*)carve((size_t)NROW * PN * 2);
    P.pga = (float*)carve((size_t)NROW * GA * 4);
    P.r1 = (bf16_t*)carve((size_t)2 * NROW * 1024 * 2);
    P.hm = (float*)carve((size_t)NROW * 512 * 4);
    P.og = (float*)carve((size_t)NROW * 512 * 4);
    P.qkf = (float*)carve((size_t)NROW * 1024 * 4);
    P.mod = (float*)carve((size_t)DEPTH * 3 * 6144 * 4);
    P.aff = (float*)carve((size_t)NROW * 16 * 4);
    P.glist = (int*)carve((size_t)NE * MZ * 4);
    P.gval = (float*)carve((size_t)NE * MZ * 4);
    P.inv = (int*)carve((size_t)NROW * 16 * 4);

    static int inited = 0;
    if (!inited) {
        inited = 1;
        (void)hipFuncSetAttribute((const void*)k_prep, hipFuncAttributeMaxDynamicSharedMemorySize, LDS_BYTES);
        (void)hipFuncSetAttribute((const void*)k_prep_experts, hipFuncAttributeMaxDynamicSharedMemorySize, LDS_BYTES);
        (void)hipFuncSetAttribute((const void*)k_gemm_in, hipFuncAttributeMaxDynamicSharedMemorySize, LDS_BYTES);
        (void)hipFuncSetAttribute((const void*)k_gemm_out, hipFuncAttributeMaxDynamicSharedMemorySize, LDS_BYTES);
        (void)hipFuncSetAttribute((const void*)k_gemm_gateup, hipFuncAttributeMaxDynamicSharedMemorySize, LDS_BYTES);
        (void)hipFuncSetAttribute((const void*)k_gemm_down, hipFuncAttributeMaxDynamicSharedMemorySize, LDS_BYTES);
    }
    (void)hipMemsetAsync(P.bar, 0, 65536, stream);
    {
        void* args[] = {&P};
        (void)hipLaunchCooperativeKernel((const void*)k_skeleton, dim3(NWG), dim3(NTHR), args, 0, stream);
    }
    k_prep<<<NWG, NTHR, LDS_BYTES, stream>>>(P);
    for (int l = 0; l < DEPTH; ++l) {
        const bool last = (l == DEPTH - 1);
        const int nrows = last ? NLAT : NROW;
        k_prep_experts<<<NWG, NTHR, LDS_BYTES, stream>>>(P, l);
        k_rowop_pre<<<NWG, NTHR, 0, stream>>>(P, l);
        k_gemm_in<<<NWG, NTHR, LDS_BYTES, stream>>>(P, l);
        k_qkconv<<<NROW * 4, 256, 0, stream>>>(P, l);
        k_mlstm_rec<<<256, 256, 0, stream>>>(P, l, last ? 0 : 1);
        k_gla_rec<<<256, 256, 0, stream>>>(P, l, last ? 0 : 1);
        k_merge<<<nrows / 4, 256, 0, stream>>>(P, l, nrows);
        k_gemm_out<<<NWG, NTHR, LDS_BYTES, stream>>>(P, l, nrows);
        k_rowop_mid<<<NWG, NTHR, 0, stream>>>(P, l, nrows);
        k_topk<<<last ? 32 : 64, 1024, 0, stream>>>(P);
        const int mtn = last ? 8 : 9;
        k_gemm_gateup<<<NWG, NTHR, LDS_BYTES, stream>>>(P, mtn);
        k_gemm_down<<<NWG, NTHR, LDS_BYTES, stream>>>(P, mtn);
        k_rowop_post<<<NWG, NTHR, 0, stream>>>(P, l, nrows);
    }
}
```

```cpp
#include <hip/hip_runtime.h>
#include <hip/hip_cooperative_groups.h>
#include <math.h>
namespace cg = cooperative_groups;

namespace {
#define LAS __attribute__((address_space(3)))
typedef unsigned short bf16_t;
typedef short bf16x8 __attribute__((ext_vector_type(8)));
typedef float f32x4 __attribute__((ext_vector_type(4)));
typedef unsigned u32x4 __attribute__((ext_vector_type(4)));
typedef unsigned u32x2 __attribute__((ext_vector_type(2)));

constexpr int D = 1024, NB = 2, SEQ = 8192, CTX = 256, DEPTH = 2;
constexpr int NLAT = NB * SEQ;
constexpr int NCTX = NB * CTX;
constexpr int NROW = NLAT + NCTX;
constexpr int PW = 3632;
constexpr int PN = 3584;
constexpr int P_MLQ = 0, P_MLK = 512, P_MLV = 1024, P_MLO = 1536, P_GQ = 2048, P_GK = 2304, P_GV = 2560, P_GR = 3072;
constexpr int GA = 64;
constexpr int NE = 16;
constexpr int MZ = 2112;
constexpr float EPS = 1e-6f;
constexpr int NWG = 256, NTHR = 512;
constexpr int LDS_BYTES = 160 * 1024;
constexpr int ML_IMG = 128 * 272, GL_IMG = 64 * 272;

__device__ __forceinline__ float wave_sum(float v) {
#pragma unroll
    for (int o = 32; o > 0; o >>= 1) v += __shfl_xor(v, o);
    return v;
}
__device__ __forceinline__ float siluf(float x) { return x / (1.f + expf(-x)); }
__device__ __forceinline__ float sigmoidf(float x) { return 1.f / (1.f + expf(-x)); }
__device__ __forceinline__ float logsigmoidf(float x) { return fminf(x, 0.f) - log1pf(expf(-fabsf(x))); }
__device__ __forceinline__ int modrow(int row) { return row < NLAT ? row / SEQ : 2; }
__device__ __forceinline__ unsigned pk2(float lo, float hi) { unsigned r; asm("v_cvt_pk_bf16_f32 %0, %1, %2" : "=v"(r) : "v"(lo), "v"(hi)); return r; }
__device__ __forceinline__ float bf2f(bf16_t b) { return __uint_as_float(((unsigned)b) << 16); }
__device__ __forceinline__ float bflo(unsigned u) { return __uint_as_float(u << 16); }
__device__ __forceinline__ float bfhi(unsigned u) { return __uint_as_float(u & 0xffff0000u); }

struct Params {
    const float *x, *c, *ctx, *c_ctx, *w_ada, *b_ada, *g_mix_pre, *g_mix_post, *g_ffn_pre, *g_ffn_post, *w_in, *conv_qk, *b_ml_gates, *w_gla_a2, *b_gla_a, *g_ml_norm, *g_gla_norm,
        *w_out, *w_router, *w_e_gate, *w_e_up, *w_e_down;
    float* out;
    float* xc;
    bf16_t *WinT, *WgaT, *WoutT, *WegT, *WeuT, *WedT;
    bf16_t *abuf;
    bf16_t *p;
    float* pga;
    bf16_t *r1;
    bf16_t* qk;
    bf16_t *ml_ck, *ml_pre;
    bf16_t *gl_ck, *gl_pre;
    float *mstat;
    float *mprev;
    float *gbend;
    float* mod;
    float* aff;
    int* glist; float* gval; int* inv;
    unsigned* bar;
    int pad_;
};

__device__ __forceinline__ float* xrow_ptr(const Params& P, int row) { return row < NLAT ? P.out + (size_t)row * 1024 : P.xc + (size_t)(row - NLAT) * 1024; }

__device__ __forceinline__ void transpose_item(const float* W, int ldw, int k0, int srccol0, int nvalid_lo, int nvalid_hi  , int special,
                                               bf16_t* WT, int dstrow0, LAS float* scr) {
    const int tid = threadIdx.x;
    {
        const int k = tid >> 3, n8 = (tid & 7) * 8;
#pragma unroll
        for (int q = 0; q < 2; ++q) {
            const int n = n8 + q * 4;
            float4 v = make_float4(0.f, 0.f, 0.f, 0.f);
            int sc;
            if (special) {
                if (n < 16) sc = 2048 + n; else if (n < 48) sc = 3600 + (n - 16); else sc = -1;
            } else sc = srccol0 + n;
            if (sc >= 0) v = *(const float4*)(W + (size_t)(k0 + k) * ldw + sc);
            scr[k * 65 + n + 0] = v.x; scr[k * 65 + n + 1] = v.y; scr[k * 65 + n + 2] = v.z; scr[k * 65 + n + 3] = v.w;
        }
    }
    __syncthreads();
    {
        const int n = tid >> 3, kc = (tid & 7) * 8;
        u32x4 o;
        o.x = pk2(scr[(kc + 0) * 65 + n], scr[(kc + 1) * 65 + n]); o.y = pk2(scr[(kc + 2) * 65 + n], scr[(kc + 3) * 65 + n]);
        o.z = pk2(scr[(kc + 4) * 65 + n], scr[(kc + 5) * 65 + n]); o.w = pk2(scr[(kc + 6) * 65 + n], scr[(kc + 7) * 65 + n]);
        *(u32x4*)(WT + (size_t)(dstrow0 + n) * 1024 + k0 + kc) = o;
    }
    __syncthreads();
}

constexpr int IT_IN = 16 * 56, IT_GA = 16, IT_OUT = 256, IT_EX = 3 * 16 * 256, IT_LAYER_SMALL = IT_IN + IT_GA + IT_OUT;
__device__ __forceinline__ void phase_prep_small(const Params& P, LAS unsigned char* lds, int wg, int nwg) {
    LAS float* scr = (LAS float*)lds;
    for (int it = wg; it < DEPTH * IT_LAYER_SMALL; it += nwg) {
        const int l = it / IT_LAYER_SMALL; int r = it % IT_LAYER_SMALL;
        if (r < IT_IN) { const int kb = r / 56, nb = r % 56, n0 = nb * 64; transpose_item(P.w_in + (size_t)l * 1024 * PW, PW, kb * 64, n0 + (n0 >= 2048 ? 16 : 0), 0, 64, 0, P.WinT + (size_t)l * PN * 1024, n0, scr); continue; }
        r -= IT_IN;
        if (r < IT_GA) { transpose_item(P.w_in + (size_t)l * 1024 * PW, PW, r * 64, 0, 0, 48, 1, P.WgaT + (size_t)l * 64 * 1024, 0, scr); continue; }
        r -= IT_GA;
        { const int kb = r / 16, nb = r % 16; transpose_item(P.w_out + (size_t)l * 1024 * 1024, 1024, kb * 64, nb * 64, 0, 64, 0, P.WoutT + (size_t)l * 1024 * 1024, nb * 64, scr); }
    }
}
__device__ __forceinline__ void phase_prep_experts(const Params& P, LAS unsigned char* lds, int l, int wg, int nwg) {
    LAS float* scr = (LAS float*)lds;
    for (int it = wg; it < IT_EX; it += nwg) {
        const int m = it / (16 * 256), e = (it / 256) % 16, r = it % 256, kb = r / 16, nb = r % 16;
        const float* src = (m == 0 ? P.w_e_gate : (m == 1 ? P.w_e_up : P.w_e_down)) + ((size_t)l * NE + e) * 1024 * 1024;
        bf16_t* dst = (m == 0 ? P.WegT : (m == 1 ? P.WeuT : P.WedT)) + (size_t)e * 1024 * 1024;
        transpose_item(src, 1024, kb * 64, nb * 64, 0, 64, 0, dst, nb * 64, scr);
    }
}

__device__ __forceinline__ void phase_ada(const Params& P, LAS unsigned char* lds, int wg, int nwg) {
    LAS float* s = (LAS float*)lds;
    for (int i = threadIdx.x; i < 1024; i += NTHR) { s[i] = siluf(P.c[i]); s[1024 + i] = siluf(P.c[1024 + i]); s[2048 + i] = siluf(P.c_ctx[i]); }
    __syncthreads();
    LAS float* red = s + 3072;
    for (int it = wg; it < DEPTH * 96; it += nwg) {
        const int l = it / 96, n = (it % 96) * 64 + (threadIdx.x & 63), ks = threadIdx.x >> 6;
        const float* w = P.w_ada + (size_t)l * 1024 * 6144 + n;
        float a0 = 0, a1 = 0, a2 = 0;
#pragma unroll 8
        for (int k = ks * 128; k < ks * 128 + 128; ++k) { const float wv = w[(size_t)k * 6144]; a0 += s[k] * wv; a1 += s[1024 + k] * wv; a2 += s[2048 + k] * wv; }
        red[(ks * 3 + 0) * 64 + (threadIdx.x & 63)] = a0; red[(ks * 3 + 1) * 64 + (threadIdx.x & 63)] = a1; red[(ks * 3 + 2) * 64 + (threadIdx.x & 63)] = a2;
        __syncthreads();
        if (threadIdx.x < 192) {
            const int r = threadIdx.x / 64, cidx = threadIdx.x & 63; float a = 0;
#pragma unroll
            for (int q = 0; q < 8; ++q) a += red[(q * 3 + r) * 64 + cidx];
            const int nn = (it % 96) * 64 + cidx;
            P.mod[((size_t)l * 3 + r) * 6144 + nn] = a + P.b_ada[l * 6144 + nn];
        }
        __syncthreads();
    }
}

__device__ __forceinline__ void phase_resid_init(const Params& P, int gw, int ngw, int lane) {
    for (int row = gw; row < NROW; row += ngw) {
        if (row < NLAT) {
            const int t = row % SEQ, r = t / 64, cc = t % 64;
#pragma unroll
            for (int j = 0; j < 4; ++j) {
                const int col = j * 256 + lane * 4;
                float4 v = *(const float4*)(P.x + (size_t)row * 1024 + col);
                float e[4];
#pragma unroll
                for (int q = 0; q < 4; ++q) { const int jj = (col + q) & 255; const float freq = powf(10000.f, -(float)jj / 256.f); const float arg = (float)(j < 2 ? r : cc) * freq; e[q] = (j & 1) ? cosf(arg) : sinf(arg); }
                v.x += e[0]; v.y += e[1]; v.z += e[2]; v.w += e[3];
                *(float4*)(P.out + (size_t)row * 1024 + col) = v;
            }
        } else {
#pragma unroll
            for (int j = 0; j < 4; ++j) { const int col = j * 256 + lane * 4; *(float4*)(P.xc + (size_t)(row - NLAT) * 1024 + col) = *(const float4*)(P.ctx + (size_t)(row - NLAT) * 1024 + col); }
        }
    }
}

__device__ __forceinline__ void store_bf16x4(bf16_t* p, float a, float b, float c, float d) { u32x2 o; o.x = pk2(a, b); o.y = pk2(c, d); *(u32x2*)p = o; }

__device__ __forceinline__ void phase_rowop_pre(const Params& P, int l, int gw, int ngw, int lane) {
    const float* g = P.g_mix_pre + l * 1024;
    for (int row = gw; row < NROW; row += ngw) {
        const float* xr = xrow_ptr(P, row);
        const float* m = P.mod + ((size_t)l * 3 + modrow(row)) * 6144;
        float4 v[4]; float ss = 0;
#pragma unroll
        for (int j = 0; j < 4; ++j) { v[j] = *(const float4*)(xr + j * 256 + lane * 4); ss += v[j].x * v[j].x + v[j].y * v[j].y + v[j].z * v[j].z + v[j].w * v[j].w; }
        const float rstd = rsqrtf(wave_sum(ss) * (1.f / 1024.f) + EPS);
#pragma unroll
        for (int j = 0; j < 4; ++j) {
            const int col = j * 256 + lane * 4;
            const float4 gg = *(const float4*)(g + col), sh = *(const float4*)(m + col), sc = *(const float4*)(m + 1024 + col);
            store_bf16x4(P.abuf + (size_t)row * 1024 + col, v[j].x * rstd * gg.x * (1.f + sc.x) + sh.x, v[j].y * rstd * gg.y * (1.f + sc.y) + sh.y,
                         v[j].z * rstd * gg.z * (1.f + sc.z) + sh.z, v[j].w * rstd * gg.w * (1.f + sc.w) + sh.w);
        }
    }
}

__device__ __forceinline__ void phase_rowop_mid(const Params& P, int l, int nrows, int gw, int ngw, int lane) {
    const float* g_post = P.g_mix_post + l * 1024; const float* g_pre2 = P.g_ffn_pre + l * 1024; const float* wr = P.w_router + (size_t)l * 1024 * 16;
    const bf16_t* y = P.r1;
    for (int row = gw; row < nrows; row += ngw) {
        float* xr = xrow_ptr(P, row);
        const float* m = P.mod + ((size_t)l * 3 + modrow(row)) * 6144;
        float yv[16], xv[16]; float ss = 0;
#pragma unroll
        for (int j = 0; j < 4; ++j) { const u32x2 u = *(const u32x2*)(y + (size_t)row * 1024 + j * 256 + lane * 4); yv[j * 4 + 0] = bflo(u.x); yv[j * 4 + 1] = bfhi(u.x); yv[j * 4 + 2] = bflo(u.y); yv[j * 4 + 3] = bfhi(u.y); }
#pragma unroll
        for (int i = 0; i < 16; ++i) ss += yv[i] * yv[i];
        float rstd = rsqrtf(wave_sum(ss) * (1.f / 1024.f) + EPS);
        ss = 0;
#pragma unroll
        for (int j = 0; j < 4; ++j) {
            const int col = j * 256 + lane * 4;
            const float4 xo = *(const float4*)(xr + col), gp = *(const float4*)(g_post + col), ga = *(const float4*)(m + 2048 + col);
            float4 xn; xn.x = xo.x + ga.x * (yv[j * 4 + 0] * rstd * gp.x); xn.y = xo.y + ga.y * (yv[j * 4 + 1] * rstd * gp.y); xn.z = xo.z + ga.z * (yv[j * 4 + 2] * rstd * gp.z); xn.w = xo.w + ga.w * (yv[j * 4 + 3] * rstd * gp.w);
            *(float4*)(xr + col) = xn;
            xv[j * 4 + 0] = xn.x; xv[j * 4 + 1] = xn.y; xv[j * 4 + 2] = xn.z; xv[j * 4 + 3] = xn.w;
            ss += xn.x * xn.x + xn.y * xn.y + xn.z * xn.z + xn.w * xn.w;
        }
        rstd = rsqrtf(wave_sum(ss) * (1.f / 1024.f) + EPS);
        float lg[16];
#pragma unroll
        for (int e = 0; e < 16; ++e) lg[e] = 0;
#pragma unroll
        for (int j = 0; j < 4; ++j) {
            const int col = j * 256 + lane * 4;
            const float4 gg = *(const float4*)(g_pre2 + col), sh = *(const float4*)(m + 3072 + col), sc = *(const float4*)(m + 4096 + col);
            float hv[4];
            hv[0] = xv[j * 4 + 0] * rstd * gg.x * (1.f + sc.x) + sh.x; hv[1] = xv[j * 4 + 1] * rstd * gg.y * (1.f + sc.y) + sh.y;
            hv[2] = xv[j * 4 + 2] * rstd * gg.z * (1.f + sc.z) + sh.z; hv[3] = xv[j * 4 + 3] * rstd * gg.w * (1.f + sc.w) + sh.w;
            store_bf16x4(P.abuf + (size_t)row * 1024 + col, hv[0], hv[1], hv[2], hv[3]);
#pragma unroll
            for (int q = 0; q < 4; ++q) {
                const float4* w4 = (const float4*)(wr + (size_t)(col + q) * 16);
#pragma unroll
                for (int e4 = 0; e4 < 4; ++e4) { const float4 w = w4[e4]; lg[e4 * 4 + 0] += hv[q] * w.x; lg[e4 * 4 + 1] += hv[q] * w.y; lg[e4 * 4 + 2] += hv[q] * w.z; lg[e4 * 4 + 3] += hv[q] * w.w; }
            }
        }
        float mx = -1e30f;
#pragma unroll
        for (int e = 0; e < 16; ++e) { lg[e] = wave_sum(lg[e]); mx = fmaxf(mx, lg[e]); }
        float se = 0;
#pragma unroll
        for (int e = 0; e < 16; ++e) { lg[e] = expf(lg[e] - mx); se += lg[e]; }
        float val = 0;
#pragma unroll
        for (int e = 0; e < 16; ++e) val = (e == lane) ? lg[e] : val;
        if (lane < 16) P.aff[(size_t)row * 16 + lane] = val / se;
    }
}

__device__ __forceinline__ void phase_rowop_post(const Params& P, int l, int nrows, int gw, int ngw, int lane) {
    const float* g_post = P.g_ffn_post + l * 1024;
    const bf16_t* yp = P.r1;
    for (int row = gw; row < nrows; row += ngw) {
        float* xr = xrow_ptr(P, row);
        const float* m = P.mod + ((size_t)l * 3 + modrow(row)) * 6144;
        float f[16];
#pragma unroll
        for (int i = 0; i < 16; ++i) f[i] = 0;
        const int myinv = P.inv[(size_t)row * 16 + (lane & 15)];
#pragma unroll 1
        for (int e = 0; e < 16; ++e) {
            const int pr = __shfl(myinv, e);
            if (pr >= 0) {
#pragma unroll
                for (int j = 0; j < 4; ++j) { const u32x2 u = *(const u32x2*)(yp + (size_t)pr * 1024 + j * 256 + lane * 4); f[j * 4 + 0] += bflo(u.x); f[j * 4 + 1] += bfhi(u.x); f[j * 4 + 2] += bflo(u.y); f[j * 4 + 3] += bfhi(u.y); }
            }
        }
        float ss = 0;
#pragma unroll
        for (int i = 0; i < 16; ++i) ss += f[i] * f[i];
        const float rstd = rsqrtf(wave_sum(ss) * (1.f / 1024.f) + EPS);
#pragma unroll
        for (int j = 0; j < 4; ++j) {
            const int col = j * 256 + lane * 4;
            const float4 xo = *(const float4*)(xr + col), gp = *(const float4*)(g_post + col), ga = *(const float4*)(m + 5120 + col);
            float4 xn; xn.x = xo.x + ga.x * (f[j * 4 + 0] * rstd * gp.x); xn.y = xo.y + ga.y * (f[j * 4 + 1] * rstd * gp.y); xn.z = xo.z + ga.z * (f[j * 4 + 2] * rstd * gp.z); xn.w = xo.w + ga.w * (f[j * 4 + 3] * rstd * gp.w);
            *(float4*)(xr + col) = xn;
        }
    }
}

constexpr int BK = 64, HALF = 128, HTB = HALF * BK * 2, GK = 1024;
__device__ __forceinline__ int lds_byte(int r, int c) { const int st = (r >> 4) * 2 + (c >> 5), rr = r & 15, cc = c & 31, ob = rr * 64 + cc * 2; return st * 1024 + (ob ^ (((ob >> 9) & 1) << 5)); }
__device__ __forceinline__ void stage_rc(int b, int& R, int& C) { const int st = b / 1024, sb = b % 1024, swz = sb ^ (((sb >> 9) & 1) << 5); R = (st >> 1) * 16 + swz / 64; C = (st & 1) * 32 + (swz % 64) / 2; }
__device__ __forceinline__ int perm32(int rho) { const int n = rho >> 4, i = rho & 15; return 8 * (i >> 2) + 4 * n + (i & 3); }

struct GUnit { int pm, pn, e, rows; };

template <class Sched, class Epi>
__device__ __forceinline__ void gemm_phase(LAS unsigned char* lds, const char* Abase, const Sched& S, const Epi& E) {
    const int tid = threadIdx.x, wid = __builtin_amdgcn_readfirstlane(tid >> 6), lane = tid & 63, wr = wid >> 2, wc = wid & 3, fr = lane & 15, fq = lane >> 4;
    constexpr int nt = GK / BK;
    int R0, C0, R1, C1; stage_rc(tid * 16, R0, C0); stage_rc(tid * 16 + 8192, R1, C1);
    const unsigned voffB0 = (unsigned)(((R0 & ~31) + perm32(R0 & 31)) * GK + C0) * 2u, voffB1 = (unsigned)(((R1 & ~31) + perm32(R1 & 31)) * GK + C1) * 2u;
    constexpr size_t kstep = (size_t)(BK * 2);
    const unsigned ldsw = (unsigned)wid * 1024u;
    const int aoff = lds_byte(wr * 64 + fr, fq * 8), boff = lds_byte(wc * 32 + fr, fq * 8);
#define G_SA(b, h) (((b) * 2 + (h)) * HTB)
#define G_SB(b, h) ((4 + (b) * 2 + (h)) * HTB)
#define G_GL(bufoff, p0, p1) do { __builtin_amdgcn_global_load_lds((const unsigned*)(p0), (LAS unsigned*)(lds + (bufoff) + ldsw), 16, 0, 0); \
        __builtin_amdgcn_global_load_lds((const unsigned*)(p1), (LAS unsigned*)(lds + (bufoff) + ldsw + 8192), 16, 0, 0); } while (0)
#define G_STA(bufoff, kptr, o0, o1) G_GL(bufoff, (kptr) + (o0), (kptr) + (o1))
#define G_STB(bufoff, bptr) G_GL(bufoff, (bptr) + voffB0, (bptr) + voffB1)
#define G_LDA(dst, b, h) do { _Pragma("unroll") for (int m = 0; m < 4; ++m) _Pragma("unroll") for (int k = 0; k < 2; ++k) dst[m][k] = *(const LAS bf16x8*)(lds + G_SA(b, h) + aoff + m * 2048 + k * 1024); } while (0)
#define G_LDB(dst, b, h) do { _Pragma("unroll") for (int n = 0; n < 2; ++n) _Pragma("unroll") for (int k = 0; k < 2; ++k) dst[n][k] = *(const LAS bf16x8*)(lds + G_SB(b, h) + boff + n * 2048 + k * 1024); } while (0)
#define G_MMA(ai, bj, At, Bt) do { __builtin_amdgcn_s_setprio(1); _Pragma("unroll") for (int m = 0; m < 4; ++m) _Pragma("unroll") for (int n = 0; n < 2; ++n) _Pragma("unroll") for (int k = 0; k < 2; ++k) \
        acc[ai][bj][m][n] = __builtin_amdgcn_mfma_f32_16x16x32_bf16(Bt[n][k], At[m][k], acc[ai][bj][m][n], 0, 0, 0); __builtin_amdgcn_s_setprio(0); } while (0)
#define G_WAIT_V(n) asm volatile("s_waitcnt vmcnt(" #n ")" ::: "memory")
#define G_WAIT_L(n) asm volatile("s_waitcnt lgkmcnt(" #n ")" ::: "memory")
#define G_BAR __builtin_amdgcn_s_barrier()
#define G_SCHED __builtin_amdgcn_sched_barrier(0)
    GUnit cur, nxt; int ui = 0;
    if (!S.next(0, cur)) return;
    f32x4 acc[2][2][4][2];
#pragma unroll
    for (int a = 0; a < 2; ++a)
#pragma unroll
        for (int b = 0; b < 2; ++b)
#pragma unroll
            for (int m = 0; m < 4; ++m)
#pragma unroll
                for (int n = 0; n < 2; ++n) acc[a][b][m][n] = (f32x4){0.f, 0.f, 0.f, 0.f};
    bf16x8 At[4][2], B0[2][2], B1[2][2];
    unsigned c00, c01, c10, c11, n00, n01, n10, n11;
    S.aoff(cur, 0, R0, C0, R1, C1, c00, c01); S.aoff(cur, 1, R0, C0, R1, C1, c10, c11);
    const char* cB0 = S.bptr(cur, 0); const char* cB1 = S.bptr(cur, 1);
    G_STB(G_SB(0, 0), cB0); G_STA(G_SA(0, 0), Abase, c00, c01); G_STB(G_SB(0, 1), cB1); G_STA(G_SA(0, 1), Abase, c10, c11);
    if (wr == 1) G_BAR;
    G_WAIT_V(4); G_BAR;
    G_STB(G_SB(1, 0), cB0 + kstep); G_STA(G_SA(1, 0), Abase + kstep, c00, c01); G_STB(G_SB(1, 1), cB1 + kstep);
    G_WAIT_V(6); G_BAR;
    for (;;) {
        const bool has_next = S.next(ui + 1, nxt);
        const char* nB0 = cB0; const char* nB1 = cB1;
        n00 = c00; n01 = c01; n10 = c10; n11 = c11;
        if (has_next) { S.aoff(nxt, 0, R0, C0, R1, C1, n00, n01); S.aoff(nxt, 1, R0, C0, R1, C1, n10, n11); nB0 = S.bptr(nxt, 0); nB1 = S.bptr(nxt, 1); }
        for (int t = 0; t < nt; t += 2) {
            const bool last = (t == nt - 2);
            const char* a1 = Abase + (size_t)(t + 1) * kstep;
            const char* a2 = last ? Abase : Abase + (size_t)(t + 2) * kstep;
            const char* b20 = last ? nB0 : cB0 + (size_t)(t + 2) * kstep; const char* b21 = last ? nB1 : cB1 + (size_t)(t + 2) * kstep;
            const char* a3 = a2 + kstep; const char* b30 = b20 + kstep; const char* b31 = b21 + kstep;
            const unsigned s00 = last ? n00 : c00, s01 = last ? n01 : c01, s10 = last ? n10 : c10, s11 = last ? n11 : c11;
            G_LDB(B0, 0, 0); G_SCHED; G_LDA(At, 0, 0); G_STA(G_SA(1, 1), a1, c10, c11);
            G_WAIT_L(8); G_BAR; G_WAIT_L(0); G_MMA(0, 0, At, B0); G_BAR; G_SCHED;
            G_LDB(B1, 0, 1); G_STB(G_SB(0, 0), b20);
            G_BAR; G_WAIT_L(0); G_MMA(0, 1, At, B1); G_BAR;
            G_LDA(At, 0, 1); G_STA(G_SA(0, 0), a2, s00, s01);
            G_BAR; G_WAIT_L(0); G_MMA(1, 0, At, B0); G_BAR; G_SCHED;
            G_STB(G_SB(0, 1), b21);
            G_WAIT_V(6); G_BAR; G_MMA(1, 1, At, B1); G_BAR;
            G_LDB(B0, 1, 0); G_SCHED; G_LDA(At, 1, 0); G_STA(G_SA(0, 1), a2, s10, s11);
            G_WAIT_L(8); G_BAR; G_WAIT_L(0); G_MMA(0, 0, At, B0); G_BAR; G_SCHED;
            G_LDB(B1, 1, 1); G_STB(G_SB(1, 0), b30);
            G_BAR; G_WAIT_L(0); G_MMA(0, 1, At, B1); G_BAR;
            G_LDA(At, 1, 1); G_STA(G_SA(1, 0), a3, s00, s01);
            G_BAR; G_WAIT_L(0); G_MMA(1, 0, At, B0); G_BAR; G_SCHED;
            G_STB(G_SB(1, 1), b31);
            G_WAIT_V(6); G_BAR; G_MMA(1, 1, At, B1); G_BAR;
        }
        E(acc, cur, wr, wc, fr, fq);
        if (!has_next) break;
#pragma unroll
        for (int a = 0; a < 2; ++a)
#pragma unroll
            for (int b = 0; b < 2; ++b)
#pragma unroll
                for (int m = 0; m < 4; ++m)
#pragma unroll
                    for (int n = 0; n < 2; ++n) acc[a][b][m][n] = (f32x4){0.f, 0.f, 0.f, 0.f};
        cur = nxt; cB0 = nB0; cB1 = nB1; c00 = n00; c01 = n01; c10 = n10; c11 = n11; ++ui;
    }
    G_WAIT_V(0);
    if (wr == 0) G_BAR;
    G_BAR;
#undef G_SA
#undef G_SB
#undef G_GL
#undef G_STA
#undef G_STB
#undef G_LDA
#undef G_LDB
#undef G_MMA
#undef G_WAIT_V
#undef G_WAIT_L
#undef G_BAR
#undef G_SCHED
}

struct SchedDense {
    int nM, nN, nwg, G, c; const char* Bt;
    __device__ __forceinline__ bool next(int i, GUnit& u) const {
        const long L = (long)i * G + c; if (L >= nwg) return false;
        int wgid = (int)L; { const int q = nwg / 8, r = nwg % 8, xcd = wgid % 8, off = wgid / 8; wgid = (xcd < r ? xcd * (q + 1) : r * (q + 1) + (xcd - r) * q) + off; }
        const int nig = 8 * nN, gid = wgid / nig, fm = gid * 8, gsz = (nM - fm) < 8 ? (nM - fm) : 8;
        u.pm = fm + ((wgid % nig) % gsz); u.pn = (wgid % nig) / gsz; u.e = 0; u.rows = 256; return true;
    }
    __device__ __forceinline__ void aoff(const GUnit& u, int h, int R0, int C0, int R1, int C1, unsigned& o0, unsigned& o1) const {
        const unsigned base = (unsigned)(u.pm * 256 + h * 128);
        o0 = ((base + R0) * GK + C0) * 2u; o1 = ((base + R1) * GK + C1) * 2u;
    }
    __device__ __forceinline__ const char* bptr(const GUnit& u, int h) const { return Bt + (size_t)(u.pn * 256 + h * 128) * GK * 2; }
};
struct SchedGateUp {
    int G, c, mtn; const int* glist; const char* Wg; const char* Wu;
    __device__ __forceinline__ bool next(int i, GUnit& u) const {
        const int x = c & 7, j = c >> 3, per = G >> 3, L = i * per + j, tot = 2 * mtn * 8;
        if (L >= tot) return false;
        const int es = L / (mtn * 8), rem = L % (mtn * 8);
        u.e = x + 8 * es; u.pm = rem >> 3; u.pn = rem & 7; u.rows = (u.pm == 8) ? 64 : 256; return true;
    }
    __device__ __forceinline__ void aoff(const GUnit& u, int h, int R0, int C0, int R1, int C1, unsigned& o0, unsigned& o1) const {
        int r0 = h * 128 + R0, r1 = h * 128 + R1;
        r0 = r0 < u.rows ? r0 : 0; r1 = r1 < u.rows ? r1 : 0;
        const int g0 = glist[u.e * MZ + u.pm * 256 + r0], g1 = glist[u.e * MZ + u.pm * 256 + r1];
        o0 = ((unsigned)g0 * GK + C0) * 2u; o1 = ((unsigned)g1 * GK + C1) * 2u;
    }
    __device__ __forceinline__ const char* bptr(const GUnit& u, int h) const { return (h ? Wu : Wg) + ((size_t)u.e * 1024 + u.pn * 128) * GK * 2; }
};
struct SchedDown {
    int G, c, mtn; const char* Wd;
    __device__ __forceinline__ bool next(int i, GUnit& u) const {
        const int x = c & 7, j = c >> 3, per = G >> 3, L = i * per + j, tot = 2 * mtn * 4;
        if (L >= tot) return false;
        const int es = L / (mtn * 4), rem = L % (mtn * 4);
        u.e = x + 8 * es; u.pm = rem >> 2; u.pn = rem & 3; u.rows = (u.pm == 8) ? 64 : 256; return true;
    }
    __device__ __forceinline__ void aoff(const GUnit& u, int h, int R0, int C0, int R1, int C1, unsigned& o0, unsigned& o1) const {
        const unsigned base = (unsigned)(u.e * MZ + u.pm * 256 + h * 128);
        o0 = ((base + R0) * GK + C0) * 2u; o1 = ((base + R1) * GK + C1) * 2u;
    }
    __device__ __forceinline__ const char* bptr(const GUnit& u, int h) const { return Wd + ((size_t)u.e * 1024 + u.pn * 256 + h * 128) * GK * 2; }
};

struct EpiStoreBf16 {
    bf16_t* O; int ldo;
    __device__ __forceinline__ void operator()(const f32x4 (&acc)[2][2][4][2], const GUnit& u, int wr, int wc, int fr, int fq) const {
#pragma unroll
        for (int ai = 0; ai < 2; ++ai)
#pragma unroll
            for (int m = 0; m < 4; ++m) {
                bf16_t* rowp = O + (size_t)(u.pm * 256 + ai * 128 + wr * 64 + m * 16 + fr) * ldo + u.pn * 256 + wc * 32 + 8 * fq;
#pragma unroll
                for (int bj = 0; bj < 2; ++bj) { const f32x4 v0 = acc[ai][bj][m][0], v1 = acc[ai][bj][m][1]; u32x4 o; o.x = pk2(v0[0], v0[1]); o.y = pk2(v0[2], v0[3]); o.z = pk2(v1[0], v1[1]); o.w = pk2(v1[2], v1[3]); *(u32x4*)(rowp + bj * 128) = o; }
            }
    }
};
struct EpiGateUp {
    bf16_t* hid;
    __device__ __forceinline__ void operator()(const f32x4 (&acc)[2][2][4][2], const GUnit& u, int wr, int wc, int fr, int fq) const {
#pragma unroll
        for (int ai = 0; ai < 2; ++ai)
#pragma unroll
            for (int m = 0; m < 4; ++m) {
                const int r = ai * 128 + wr * 64 + m * 16 + fr;
                if (r < u.rows) {
                    float h[8];
#pragma unroll
                    for (int n = 0; n < 2; ++n)
#pragma unroll
                        for (int j = 0; j < 4; ++j) { const float g = acc[ai][0][m][n][j], up = acc[ai][1][m][n][j]; h[n * 4 + j] = g * __frcp_rn(1.f + __expf(-g)) * up; }
                    u32x4 o; o.x = pk2(h[0], h[1]); o.y = pk2(h[2], h[3]); o.z = pk2(h[4], h[5]); o.w = pk2(h[6], h[7]);
                    *(u32x4*)(hid + (size_t)(u.e * MZ + u.pm * 256 + r) * 1024 + u.pn * 128 + wc * 32 + 8 * fq) = o;
                }
            }
    }
};
struct EpiDown {
    bf16_t* yp; const float* gval;
    __device__ __forceinline__ void operator()(const f32x4 (&acc)[2][2][4][2], const GUnit& u, int wr, int wc, int fr, int fq) const {
#pragma unroll
        for (int ai = 0; ai < 2; ++ai)
#pragma unroll
            for (int m = 0; m < 4; ++m) {
                const int r = ai * 128 + wr * 64 + m * 16 + fr;
                if (r < u.rows) {
                    const int pr = u.e * MZ + u.pm * 256 + r; const float g = gval[pr];
                    bf16_t* rowp = yp + (size_t)pr * 1024 + u.pn * 256 + wc * 32 + 8 * fq;
#pragma unroll
                    for (int bj = 0; bj < 2; ++bj) { const f32x4 v0 = acc[ai][bj][m][0] * g, v1 = acc[ai][bj][m][1] * g; u32x4 o; o.x = pk2(v0[0], v0[1]); o.y = pk2(v0[2], v0[3]); o.z = pk2(v1[0], v1[1]); o.w = pk2(v1[2], v1[3]); *(u32x4*)(rowp + bj * 128) = o; }
                }
            }
    }
};

__device__ __forceinline__ void phase_gates(const Params& P, int l, int gw, int ngw, int lane) {
    const int fr = lane & 15, fq = lane >> 4;
    const bf16_t* W = P.WgaT + (size_t)l * 64 * 1024;
    for (int rb = gw; rb < NROW / 16; rb += ngw) {
        f32x4 acc[4];
#pragma unroll
        for (int n = 0; n < 4; ++n) acc[n] = (f32x4){0.f, 0.f, 0.f, 0.f};
        const bf16_t* arow = P.abuf + (size_t)(rb * 16 + fr) * 1024 + fq * 8;
#pragma unroll 4
        for (int k0 = 0; k0 < 1024; k0 += 32) {
            const bf16x8 a = *(const bf16x8*)(arow + k0);
#pragma unroll
            for (int n = 0; n < 4; ++n) { const bf16x8 b = *(const bf16x8*)(W + (size_t)(n * 16 + fr) * 1024 + k0 + fq * 8); acc[n] = __builtin_amdgcn_mfma_f32_16x16x32_bf16(a, b, acc[n], 0, 0, 0); }
        }
#pragma unroll
        for (int n = 0; n < 4; ++n)
#pragma unroll
            for (int j = 0; j < 4; ++j) P.pga[(size_t)(rb * 16 + fq * 4 + j) * GA + n * 16 + fr] = acc[n][j];
    }
}

constexpr int TS = 272;
constexpr int TS64 = 144;
constexpr int VS = 304;

__device__ __forceinline__ int chunk_row0(int b, int pc) { return pc < 2 ? NLAT + b * CTX + pc * 128 : b * SEQ + (pc - 2) * 128; }
__device__ __forceinline__ int virt_pc(int dir, int j) { return dir == 0 ? j : (j == 0 ? 1 : (j == 1 ? 0 : 67 - j)); }
__device__ __forceinline__ float wave_incl_sum(float s, int lane) {
#pragma unroll
    for (int o = 1; o < 64; o <<= 1) { const float y = __shfl_up(s, o); if (lane >= o) s += y; }
    return s;
}
__device__ __forceinline__ float wave_incl_max(float s, int lane) {
#pragma unroll
    for (int o = 1; o < 64; o <<= 1) { const float y = __shfl_up(s, o); if (lane >= o) s = fmaxf(s, y); }
    return s;
}
__device__ __forceinline__ float wave_max(float v) {
#pragma unroll
    for (int o = 32; o > 0; o >>= 1) v = fmaxf(v, __shfl_xor(v, o));
    return v;
}
__device__ __forceinline__ bf16x8 mk_frag(u32x2 lo, u32x2 hi) { u32x4 v; v.x = lo.x; v.y = lo.y; v.z = hi.x; v.w = hi.y; return __builtin_bit_cast(bf16x8, v); }
template <int HI>
__device__ __forceinline__ bf16x8 tr_read1(unsigned addr) {
    u32x2 lo, hi;
    asm volatile("ds_read_b64_tr_b16 %0, %2\n\tds_read_b64_tr_b16 %1, %2 offset:%3\n\ts_waitcnt lgkmcnt(0)" : "=&v"(lo), "=&v"(hi) : "v"(addr), "i"(HI) : "memory");
    return mk_frag(lo, hi);
}
template <int HI, int FS>
__device__ __forceinline__ void tr_read4(unsigned addr, bf16x8& f0, bf16x8& f1, bf16x8& f2, bf16x8& f3) {
    u32x2 a0, a1, b0, b1, c0, c1, d0, d1;
    asm volatile("ds_read_b64_tr_b16 %0, %8\n\t"
                 "ds_read_b64_tr_b16 %1, %8 offset:%9\n\t"
                 "ds_read_b64_tr_b16 %2, %8 offset:%10\n\t"
                 "ds_read_b64_tr_b16 %3, %8 offset:%11\n\t"
                 "ds_read_b64_tr_b16 %4, %8 offset:%12\n\t"
                 "ds_read_b64_tr_b16 %5, %8 offset:%13\n\t"
                 "ds_read_b64_tr_b16 %6, %8 offset:%14\n\t"
                 "ds_read_b64_tr_b16 %7, %8 offset:%15\n\t"
                 "s_waitcnt lgkmcnt(0)"
                 : "=&v"(a0), "=&v"(a1), "=&v"(b0), "=&v"(b1), "=&v"(c0), "=&v"(c1), "=&v"(d0), "=&v"(d1)
                 : "v"(addr), "i"(HI), "i"(FS), "i"(FS + HI), "i"(2 * FS), "i"(2 * FS + HI), "i"(3 * FS), "i"(3 * FS + HI)
                 : "memory");
    f0 = mk_frag(a0, a1); f1 = mk_frag(b0, b1); f2 = mk_frag(c0, c1); f3 = mk_frag(d0, d1);
}
__device__ __forceinline__ unsigned lds_addr(LAS unsigned char* p) { return (unsigned)(size_t)p; }
__device__ __forceinline__ void unpack8(const u32x4 u, float (&f)[8]) { f[0] = bflo(u.x); f[1] = bfhi(u.x); f[2] = bflo(u.y); f[3] = bfhi(u.y); f[4] = bflo(u.z); f[5] = bfhi(u.z); f[6] = bflo(u.w); f[7] = bfhi(u.w); }
__device__ __forceinline__ u32x4 pack8(const float (&f)[8]) { u32x4 o; o.x = pk2(f[0], f[1]); o.y = pk2(f[2], f[3]); o.z = pk2(f[4], f[5]); o.w = pk2(f[6], f[7]); return o; }
#define MFMA16(a, b, c) __builtin_amdgcn_mfma_f32_16x16x32_bf16(a, b, c, 0, 0, 0)

__device__ __forceinline__ void ma_mlstm(const Params& P, LAS unsigned char* lds, int l, int b, int h, int pc) {
    const int tid = threadIdx.x, lane = tid & 63, wid = __builtin_amdgcn_readfirstlane(tid >> 6);
    LAS unsigned char* Kt = lds; LAS unsigned char* Vf = lds + 34816; LAS unsigned char* Vb = lds + 69632;
    LAS float* sc = (LAS float*)(lds + 104448);
    LAS float* red = sc + 6 * 128;
    const int row0 = chunk_row0(b, pc), sq0 = (b * 4 + h) * 2;
    if (tid < 128) {
        const float* ga = P.pga + (size_t)(row0 + tid) * GA; const float* bg = P.b_ml_gates + l * 16;
        sc[tid] = ga[h] + bg[h]; sc[128 + tid] = logsigmoidf(ga[4 + h] + bg[4 + h]); sc[256 + tid] = ga[8 + h] + bg[8 + h]; sc[384 + tid] = logsigmoidf(ga[12 + h] + bg[12 + h]);
    }
    __syncthreads();
    if (wid < 2) {
        const int dir = wid; LAS float* li = sc + dir * 256; LAS float* lf = li + 128; LAS float* e = sc + 512 + dir * 128;
        const int t0 = dir ? 127 - 2 * lane : 2 * lane, t1 = dir ? 126 - 2 * lane : 2 * lane + 1;
        const float x0 = lf[t0], x1 = lf[t1];
        const float incl = wave_incl_sum(x0 + x1, lane);
        const float b0 = incl - x1, b1 = incl;
        const float bend = __shfl(incl, 63);
        const float w0 = bend - b0 + li[t0], w1 = bend - b1 + li[t1];
        const float mk = wave_max(fmaxf(w0, w1));
        e[t0] = __expf(w0 - mk); e[t1] = __expf(w1 - mk);
        if (lane == 0) { float* ms = P.mstat + ((size_t)(sq0 + dir) * 66 + pc) * 2; ms[0] = bend; ms[1] = mk; }
    }
    __syncthreads();
    {
        const int c8 = tid & 15, tb = tid >> 4, qc = h * 128 + c8 * 8;
        const float* cw = P.conv_qk + (size_t)l * 3 * 1024;
        const bool segstart = (pc == 0 || pc == 2), segend = (pc == 1 || pc == 65);
        float wq[3][8], wk[3][8];
#pragma unroll
        for (int j = 0; j < 3; ++j)
#pragma unroll
            for (int e4 = 0; e4 < 2; ++e4) {
                const float4 a = *(const float4*)(cw + j * 1024 + qc + e4 * 4), c = *(const float4*)(cw + j * 1024 + 512 + qc + e4 * 4);
                wq[j][e4 * 4 + 0] = a.x; wq[j][e4 * 4 + 1] = a.y; wq[j][e4 * 4 + 2] = a.z; wq[j][e4 * 4 + 3] = a.w;
                wk[j][e4 * 4 + 0] = c.x; wk[j][e4 * 4 + 1] = c.y; wk[j][e4 * 4 + 2] = c.z; wk[j][e4 * 4 + 3] = c.w;
            }
#pragma unroll 1
        for (int i = 0; i < 4; ++i) {
            const int t = tb + 32 * i, row = row0 + t;
            const bf16_t* pr = P.p + (size_t)row * PN;
            const bool hasL = !(t == 0 && segstart), hasR = !(t == 127 && segend);
            const u32x4 z = (u32x4){0u, 0u, 0u, 0u};
            const u32x4 q0 = hasL ? *(const u32x4*)(pr - PN + P_MLQ + qc) : z, q1 = *(const u32x4*)(pr + P_MLQ + qc), q2 = hasR ? *(const u32x4*)(pr + PN + P_MLQ + qc) : z;
            const u32x4 k0 = hasL ? *(const u32x4*)(pr - PN + P_MLK + qc) : z, k1 = *(const u32x4*)(pr + P_MLK + qc), k2 = hasR ? *(const u32x4*)(pr + PN + P_MLK + qc) : z;
            const u32x4 vv = *(const u32x4*)(pr + P_MLV + qc);
            float a0[8], a1[8], a2[8], r[8];
            unpack8(q0, a0); unpack8(q1, a1); unpack8(q2, a2);
#pragma unroll
            for (int e = 0; e < 8; ++e) r[e] = siluf(wq[0][e] * a0[e] + wq[1][e] * a1[e] + wq[2][e] * a2[e]);
            *(u32x4*)(P.qk + (size_t)row * 1024 + qc) = pack8(r);
            unpack8(k0, a0); unpack8(k1, a1); unpack8(k2, a2);
#pragma unroll
            for (int e = 0; e < 8; ++e) r[e] = siluf(wk[0][e] * a0[e] + wk[1][e] * a1[e] + wk[2][e] * a2[e]);
            const u32x4 kp = pack8(r);
            *(u32x4*)(P.qk + (size_t)row * 1024 + 512 + qc) = kp;
            *(LAS u32x4*)(Kt + t * TS + c8 * 16) = kp;
            unpack8(vv, a0);
            const float ef = sc[512 + t], eb = sc[640 + t];
#pragma unroll
            for (int e = 0; e < 8; ++e) { a1[e] = a0[e] * ef; a2[e] = a0[e] * eb; }
            *(LAS u32x4*)(Vf + t * TS + c8 * 16) = pack8(a1);
            *(LAS u32x4*)(Vb + t * TS + c8 * 16) = pack8(a2);
        }
    }
    __syncthreads();
    unsigned char* imgf = (unsigned char*)P.ml_ck + ((size_t)(sq0 + 0) * 66 + pc) * ML_IMG;
    unsigned char* imgb = (unsigned char*)P.ml_ck + ((size_t)(sq0 + 1) * 66 + pc) * ML_IMG;
    {
        const int g = lane >> 4, fr = lane & 15, q4 = fr >> 2, p4 = lane & 3;
        f32x4 accf[8], accb[8];
#pragma unroll
        for (int n = 0; n < 8; ++n) { accf[n] = (f32x4){0.f, 0.f, 0.f, 0.f}; accb[n] = (f32x4){0.f, 0.f, 0.f, 0.f}; }
        const unsigned kb = lds_addr(Kt), vfb = lds_addr(Vf), vbb = lds_addr(Vb);
#pragma unroll 1
        for (int ks = 0; ks < 4; ++ks) {
            const unsigned ro = (unsigned)((32 * ks + 8 * g + q4) * TS + 8 * p4);
            const bf16x8 af = tr_read1<4 * TS>(vfb + ro + wid * 32), ab = tr_read1<4 * TS>(vbb + ro + wid * 32);
            bf16x8 bfr[8];
            tr_read4<4 * TS, 32>(kb + ro, bfr[0], bfr[1], bfr[2], bfr[3]);
            tr_read4<4 * TS, 32>(kb + ro + 128, bfr[4], bfr[5], bfr[6], bfr[7]);
#pragma unroll
            for (int n = 0; n < 8; ++n) { accf[n] = MFMA16(af, bfr[n], accf[n]); accb[n] = MFMA16(ab, bfr[n], accb[n]); }
        }
#pragma unroll
        for (int n = 0; n < 8; ++n) {
            const int k = 16 * n + fr, v0 = 16 * wid + 4 * g;
            u32x2 o; o.x = pk2(accf[n][0], accf[n][1]); o.y = pk2(accf[n][2], accf[n][3]); *(u32x2*)(imgf + k * TS + v0 * 2) = o;
            o.x = pk2(accb[n][0], accb[n][1]); o.y = pk2(accb[n][2], accb[n][3]); *(u32x2*)(imgb + k * TS + v0 * 2) = o;
        }
    }
    {
        const int k = tid & 127, part = tid >> 7; float nf = 0.f, nb = 0.f;
#pragma unroll 8
        for (int s = part * 32; s < part * 32 + 32; ++s) { const float kv = bf2f(*(LAS bf16_t*)(Kt + s * TS + k * 2)); nf += sc[512 + s] * kv; nb += sc[640 + s] * kv; }
        red[(part * 2 + 0) * 128 + k] = nf; red[(part * 2 + 1) * 128 + k] = nb;
    }
    __syncthreads();
    if (tid < 256) {
        const int dir = tid >> 7, k = tid & 127;
        const float n = red[(0 * 2 + dir) * 128 + k] + red[(1 * 2 + dir) * 128 + k] + red[(2 * 2 + dir) * 128 + k] + red[(3 * 2 + dir) * 128 + k];
        u32x4 o; o.x = pk2(n, 0.f); o.y = 0u; o.z = 0u; o.w = 0u;
        *(u32x4*)((dir ? imgb : imgf) + k * TS + 256) = o;
    }
    __syncthreads();
}

__device__ __forceinline__ void gla_gates(const Params& P, LAS float* alr  , LAS float* segtot  , int l, int h, int tid, float (&bF)[16], float (&bB)[16], float& totF, float& totB) {
    const int k = tid & 63, seg = tid >> 6;
    const float* w2 = P.w_gla_a2 + (size_t)l * 2 * 16 * 256; const float* ba = P.b_gla_a + (size_t)l * 2 * 256;
    float wf[16], wb[16];
#pragma unroll
    for (int r = 0; r < 16; ++r) { wf[r] = w2[(0 * 16 + r) * 256 + h * 64 + k]; wb[r] = w2[(1 * 16 + r) * 256 + h * 64 + k]; }
    const float baf = ba[h * 64 + k], bab = ba[256 + h * 64 + k];
#pragma unroll
    for (int tt = 0; tt < 16; ++tt) {
        const LAS float* ar = alr + (seg * 16 + tt) * 32;
        float xf = baf, xb = bab;
#pragma unroll
        for (int r = 0; r < 16; ++r) { xf += ar[r] * wf[r]; xb += ar[16 + r] * wb[r]; }
        bF[tt] = logsigmoidf(xf) * (1.f / 16.f); bB[tt] = logsigmoidf(xb) * (1.f / 16.f);
    }
#pragma unroll
    for (int tt = 1; tt < 16; ++tt) bF[tt] += bF[tt - 1];
#pragma unroll
    for (int tt = 14; tt >= 0; --tt) bB[tt] += bB[tt + 1];
    segtot[(0 * 8 + seg) * 64 + k] = bF[15]; segtot[(1 * 8 + seg) * 64 + k] = bB[0];
    __syncthreads();
    float offF = 0.f, offB = 0.f; totF = 0.f; totB = 0.f;
#pragma unroll
    for (int s2 = 0; s2 < 8; ++s2) { const float a = segtot[(0 * 8 + s2) * 64 + k], c = segtot[(1 * 8 + s2) * 64 + k]; totF += a; totB += c; offF += (s2 < seg) ? a : 0.f; offB += (s2 > seg) ? c : 0.f; }
#pragma unroll
    for (int tt = 0; tt < 16; ++tt) { bF[tt] += offF; bB[tt] += offB; }
}
__device__ __forceinline__ void gla_stage_alr(const Params& P, LAS float* alr, int row0, int tid) {
    const int t = tid >> 2, part = tid & 3;
    const float* src = P.pga + (size_t)(row0 + t) * GA + 16 + part * 8;
    const f32x4 a = *(const f32x4*)src, c = *(const f32x4*)(src + 4);
    *(LAS f32x4*)(alr + t * 32 + part * 8) = a; *(LAS f32x4*)(alr + t * 32 + part * 8 + 4) = c;
}

__device__ __forceinline__ void ma_gla(const Params& P, LAS unsigned char* lds, int l, int b, int h, int pc) {
    const int tid = threadIdx.x, lane = tid & 63, wid = __builtin_amdgcn_readfirstlane(tid >> 6);
    LAS unsigned char* Vt = lds; LAS unsigned char* Kdf = lds + 34816; LAS unsigned char* Kdb = lds + 53248;
    LAS float* alr = (LAS float*)(lds + 71680); LAS float* segtot = (LAS float*)(lds + 88064);
    const int row0 = chunk_row0(b, pc), sq0 = (b * 4 + h) * 2;
    gla_stage_alr(P, alr, row0, tid);
#pragma unroll
    for (int i = 0; i < 4; ++i) { const int id = tid + 512 * i, t = id >> 4, c = id & 15; *(LAS u32x4*)(Vt + t * TS + c * 16) = *(const u32x4*)(P.p + (size_t)(row0 + t) * PN + P_GV + h * 128 + c * 8); }
    __syncthreads();
    {
        float bF[16], bB[16], totF, totB;
        gla_gates(P, alr, segtot, l, h, tid, bF, bB, totF, totB);
        const int k = tid & 63, seg = tid >> 6;
#pragma unroll
        for (int tt = 0; tt < 16; ++tt) {
            const int t = seg * 16 + tt;
            const float kr = bf2f(P.p[(size_t)(row0 + t) * PN + P_GK + h * 64 + k]);
            const unsigned pf = pk2(kr * __expf(totF - bF[tt]), kr * __expf(totB - bB[tt]));
            *(LAS bf16_t*)(Kdf + t * TS64 + k * 2) = (bf16_t)(pf & 0xffffu); *(LAS bf16_t*)(Kdb + t * TS64 + k * 2) = (bf16_t)(pf >> 16);
        }
        if (seg == 0) { P.gbend[((size_t)(sq0 + 0) * 66 + pc) * 64 + k] = totF; P.gbend[((size_t)(sq0 + 1) * 66 + pc) * 64 + k] = totB; }
    }
    __syncthreads();
    unsigned char* imgf = (unsigned char*)P.gl_ck + ((size_t)(sq0 + 0) * 66 + pc) * GL_IMG;
    unsigned char* imgb = (unsigned char*)P.gl_ck + ((size_t)(sq0 + 1) * 66 + pc) * GL_IMG;
    {
        const int g = lane >> 4, fr = lane & 15, q4 = fr >> 2, p4 = lane & 3;
        f32x4 accf[4], accb[4];
#pragma unroll
        for (int n = 0; n < 4; ++n) { accf[n] = (f32x4){0.f, 0.f, 0.f, 0.f}; accb[n] = (f32x4){0.f, 0.f, 0.f, 0.f}; }
        const unsigned vb = lds_addr(Vt), kfb = lds_addr(Kdf), kbb = lds_addr(Kdb);
#pragma unroll 1
        for (int ks = 0; ks < 4; ++ks) {
            const int rr = 32 * ks + 8 * g + q4;
            const bf16x8 a = tr_read1<4 * TS>(vb + (unsigned)(rr * TS + 8 * p4) + wid * 32);
            bf16x8 bf[4], bb[4];
            tr_read4<4 * TS64, 32>(kfb + (unsigned)(rr * TS64 + 8 * p4), bf[0], bf[1], bf[2], bf[3]);
            tr_read4<4 * TS64, 32>(kbb + (unsigned)(rr * TS64 + 8 * p4), bb[0], bb[1], bb[2], bb[3]);
#pragma unroll
            for (int n = 0; n < 4; ++n) { accf[n] = MFMA16(a, bf[n], accf[n]); accb[n] = MFMA16(a, bb[n], accb[n]); }
        }
#pragma unroll
        for (int n = 0; n < 4; ++n) {
            const int k = 16 * n + fr, v0 = 16 * wid + 4 * g;
            u32x2 o; o.x = pk2(accf[n][0], accf[n][1]); o.y = pk2(accf[n][2], accf[n][3]); *(u32x2*)(imgf + k * TS + v0 * 2) = o;
            o.x = pk2(accb[n][0], accb[n][1]); o.y = pk2(accb[n][2], accb[n][3]); *(u32x2*)(imgb + k * TS + v0 * 2) = o;
        }
    }
    if (tid < 128) { const int dir = tid >> 6, k = tid & 63; *(u32x4*)((dir ? imgb : imgf) + k * TS + 256) = (u32x4){0u, 0u, 0u, 0u}; }
    __syncthreads();
}

__device__ __forceinline__ void phase_mix_a(const Params& P, LAS unsigned char* lds, int l, int wg, int nwg) {
    for (int it = wg; it < 2 * 8 * 66; it += nwg) {
        const int mixer = it / 528, r = it % 528, bh = r / 66, pc = r % 66;
        if (mixer == 0) ma_mlstm(P, lds, l, bh >> 2, bh & 3, pc); else ma_gla(P, lds, l, bh >> 2, bh & 3, pc);
    }
}

__device__ __forceinline__ void phase_mix_b(const Params& P, int wg, int nwg) {
    constexpr int MLC = ML_IMG / 16, GLC = GL_IMG / 16;
    const int gt = wg * NTHR + threadIdx.x, ngt = nwg * NTHR;
    for (int task = gt; task < 16 * (MLC + GLC); task += ngt) {
        float st[8];
#pragma unroll
        for (int e = 0; e < 8; ++e) st[e] = 0.f;
        if (task < 16 * MLC) {
            const int sq = task / MLC, ci = task % MLC, dir = sq & 1;
            const unsigned char* src = (const unsigned char*)P.ml_ck + (size_t)sq * 66 * ML_IMG + ci * 16;
            unsigned char* dst = (unsigned char*)P.ml_pre + (size_t)sq * 66 * ML_IMG + ci * 16;
            const float* ms = P.mstat + (size_t)sq * 66 * 2;
            float m = 0.f;
#pragma unroll 1
            for (int j0 = 0; j0 < 66; j0 += 11) {
                u32x4 cv[11]; float be[11], mk[11];
#pragma unroll
                for (int u = 0; u < 11; ++u) { const int pc = virt_pc(dir, j0 + u); cv[u] = *(const u32x4*)(src + (size_t)pc * ML_IMG); be[u] = ms[pc * 2]; mk[u] = ms[pc * 2 + 1]; }
#pragma unroll
                for (int u = 0; u < 11; ++u) {
                    const int pc = virt_pc(dir, j0 + u);
                    *(u32x4*)(dst + (size_t)pc * ML_IMG) = pack8(st);
                    if (ci == 0) P.mprev[sq * 66 + pc] = m;
                    const float mn = fmaxf(be[u] + m, mk[u]), ao = __expf(be[u] + m - mn), an = __expf(mk[u] - mn);
                    float c[8]; unpack8(cv[u], c);
#pragma unroll
                    for (int e = 0; e < 8; ++e) st[e] = ao * st[e] + an * c[e];
                    m = mn;
                }
            }
        } else {
            const int t2 = task - 16 * MLC, sq = t2 / GLC, ci = t2 % GLC, dir = sq & 1, k = (ci * 16) / TS;
            const unsigned char* src = (const unsigned char*)P.gl_ck + (size_t)sq * 66 * GL_IMG + ci * 16;
            unsigned char* dst = (unsigned char*)P.gl_pre + (size_t)sq * 66 * GL_IMG + ci * 16;
            const float* gb = P.gbend + (size_t)sq * 66 * 64 + k;
#pragma unroll 1
            for (int j0 = 0; j0 < 66; j0 += 11) {
                u32x4 cv[11]; float be[11];
#pragma unroll
                for (int u = 0; u < 11; ++u) { const int pc = virt_pc(dir, j0 + u); cv[u] = *(const u32x4*)(src + (size_t)pc * GL_IMG); be[u] = gb[pc * 64]; }
#pragma unroll
                for (int u = 0; u < 11; ++u) {
                    const int pc = virt_pc(dir, j0 + u);
                    *(u32x4*)(dst + (size_t)pc * GL_IMG) = pack8(st);
                    const float dc = __expf(be[u]);
                    float c[8]; unpack8(cv[u], c);
#pragma unroll
                    for (int e = 0; e < 8; ++e) st[e] = dc * st[e] + c[e];
                }
            }
        }
    }
}

__device__ __forceinline__ void mc_mlstm(const Params& P, LAS unsigned char* lds, int l, int b, int h, int pc) {
    const int tid = threadIdx.x, lane = tid & 63, wid = __builtin_amdgcn_readfirstlane(tid >> 6);
    const int g = lane >> 4, fr = lane & 15, q4 = fr >> 2, p4 = lane & 3;
    LAS unsigned char* Qt = lds; LAS unsigned char* Kt = lds + 34816; LAS unsigned char* V1 = lds + 69632; LAS unsigned char* CT = lds + 108544;
    LAS float* sc = (LAS float*)(lds + 143488);
    const int row0 = chunk_row0(b, pc), sq0 = (b * 4 + h) * 2;
    const float scale = 0.08838834764831845f;
    if (tid < 128) {
        const float* ga = P.pga + (size_t)(row0 + tid) * GA; const float* bg = P.b_ml_gates + l * 16;
        sc[tid] = ga[h] + bg[h]; sc[128 + tid] = logsigmoidf(ga[4 + h] + bg[4 + h]); sc[256 + tid] = ga[8 + h] + bg[8 + h]; sc[384 + tid] = logsigmoidf(ga[12 + h] + bg[12 + h]);
        u32x4 o; o.x = 0x00003F80u; o.y = 0u; o.z = 0u; o.w = 0u;
        *(LAS u32x4*)(V1 + tid * VS + 256) = o; o.x = 0u; *(LAS u32x4*)(V1 + tid * VS + 272) = o; *(LAS u32x4*)(V1 + tid * VS + 288) = o;
    }
#pragma unroll
    for (int i = 0; i < 4; ++i) {
        const int id = tid + 512 * i, t = id >> 4, c = id & 15;
        *(LAS u32x4*)(Qt + t * TS + c * 16) = *(const u32x4*)(P.qk + (size_t)(row0 + t) * 1024 + h * 128 + c * 8);
        *(LAS u32x4*)(Kt + t * TS + c * 16) = *(const u32x4*)(P.qk + (size_t)(row0 + t) * 1024 + 512 + h * 128 + c * 8);
        *(LAS u32x4*)(V1 + t * VS + c * 16) = *(const u32x4*)(P.p + (size_t)(row0 + t) * PN + P_MLV + h * 128 + c * 8);
    }
    {
        const unsigned char* img = (const unsigned char*)P.ml_pre + ((size_t)(sq0 + 0) * 66 + pc) * ML_IMG;
        for (int id = tid; id < ML_IMG / 16; id += NTHR) *(LAS u32x4*)(CT + id * 16) = *(const u32x4*)(img + id * 16);
    }
    __syncthreads();
    if (wid < 2) {
        const int dir = wid; LAS float* li = sc + dir * 256; LAS float* lf = li + 128; LAS float* o = sc + (4 + 4 * dir) * 128;
        const int t0 = dir ? 127 - 2 * lane : 2 * lane, t1 = dir ? 126 - 2 * lane : 2 * lane + 1;
        const float x0 = lf[t0], x1 = lf[t1];
        const float incl = wave_incl_sum(x0 + x1, lane);
        const float b0 = incl - x1, b1 = incl;
        const float g0 = li[t0] - b0, g1 = li[t1] - b1;
        const float pmx = wave_incl_max(fmaxf(g0, g1), lane);
        float pex = __shfl_up(pmx, 1); if (lane == 0) pex = -3.0e38f;
        const float pm0 = fmaxf(pex, g0), pm1 = pmx;
        const float mp = P.mprev[(sq0 + dir) * 66 + pc];
        const float m0 = fmaxf(b0 + mp, b0 + pm0), m1 = fmaxf(b1 + mp, b1 + pm1);
        o[t0] = b0 - m0; o[128 + t0] = g0; o[256 + t0] = __expf(b0 + mp - m0); o[384 + t0] = __expf(-m0);
        o[t1] = b1 - m1; o[128 + t1] = g1; o[256 + t1] = __expf(b1 + mp - m1); o[384 + t1] = __expf(-m1);
    }
    __syncthreads();
    bf16x8 qf[4];
#pragma unroll
    for (int kk = 0; kk < 4; ++kk) qf[kk] = *(const LAS bf16x8*)(Qt + (16 * wid + fr) * TS + (32 * kk + 8 * g) * 2);
    f32x4 hsum[8];
#pragma unroll
    for (int n = 0; n < 8; ++n) hsum[n] = (f32x4){0.f, 0.f, 0.f, 0.f};
    const unsigned ctb = lds_addr(CT), v1b = lds_addr(V1);
    const int tq = 16 * wid + fr;
#pragma unroll 1
    for (int dir = 0; dir < 2; ++dir) {
        if (dir == 1) {
            __syncthreads();
            const unsigned char* img = (const unsigned char*)P.ml_pre + ((size_t)(sq0 + 1) * 66 + pc) * ML_IMG;
            for (int id = tid; id < ML_IMG / 16; id += NTHR) *(LAS u32x4*)(CT + id * 16) = *(const u32x4*)(img + id * 16);
            __syncthreads();
        }
        LAS float* so = sc + (4 + 4 * dir) * 128;
        f32x4 acc[9];
#pragma unroll
        for (int n = 0; n < 9; ++n) acc[n] = (f32x4){0.f, 0.f, 0.f, 0.f};
#pragma unroll
        for (int kk = 0; kk < 4; ++kk) {
            const unsigned ro = ctb + (unsigned)((32 * kk + 8 * g + q4) * TS + 8 * p4);
            bf16x8 bfr[9];
            tr_read4<4 * TS, 32>(ro, bfr[0], bfr[1], bfr[2], bfr[3]);
            tr_read4<4 * TS, 32>(ro + 128, bfr[4], bfr[5], bfr[6], bfr[7]);
            bfr[8] = tr_read1<4 * TS>(ro + 256);
#pragma unroll
            for (int n = 0; n < 9; ++n) acc[n] = MFMA16(qf[kk], bfr[n], acc[n]);
        }
#pragma unroll
        for (int j = 0; j < 4; ++j) { const float as = so[256 + 16 * wid + 4 * g + j] * scale;
#pragma unroll
            for (int n = 0; n < 9; ++n) acc[n][j] *= as; }
        const float ut = so[tq];
        const int ilo = dir ? (wid >> 1) : 0, ihi = dir ? 3 : (wid >> 1);
#pragma unroll 1
        for (int i = ilo; i <= ihi; ++i) {
            unsigned pw[4];
#pragma unroll
            for (int half = 0; half < 2; ++half) {
                const int sb = 2 * i + half;
                f32x4 d = (f32x4){0.f, 0.f, 0.f, 0.f};
#pragma unroll
                for (int kk = 0; kk < 4; ++kk) { const bf16x8 kf = *(const LAS bf16x8*)(Kt + (16 * sb + fr) * TS + (32 * kk + 8 * g) * 2); d = MFMA16(kf, qf[kk], d); }
                float pv[4];
#pragma unroll
                for (int j = 0; j < 4; ++j) {
                    const int s = 16 * sb + 4 * g + j;
                    const bool valid = dir ? (s >= tq) : (s <= tq);
                    const float arg = ut + so[128 + s];
                    pv[j] = valid ? d[j] * scale * __expf(arg) : 0.f;
                }
                pw[half * 2 + 0] = pk2(pv[0], pv[1]); pw[half * 2 + 1] = pk2(pv[2], pv[3]);
            }
            u32x4 pu; pu.x = pw[0]; pu.y = pw[1]; pu.z = pw[2]; pu.w = pw[3];
            const bf16x8 pa = __builtin_bit_cast(bf16x8, pu);
            const unsigned ro = v1b + (unsigned)((32 * i + 4 * g + q4) * VS + 8 * p4);
            bf16x8 bfr[9];
            tr_read4<16 * VS, 32>(ro, bfr[0], bfr[1], bfr[2], bfr[3]);
            tr_read4<16 * VS, 32>(ro + 128, bfr[4], bfr[5], bfr[6], bfr[7]);
            bfr[8] = tr_read1<16 * VS>(ro + 256);
#pragma unroll
            for (int n = 0; n < 9; ++n) acc[n] = MFMA16(pa, bfr[n], acc[n]);
        }
#pragma unroll
        for (int j = 0; j < 4; ++j) {
            const float den = __shfl(acc[8][j], lane & 48);
            const float dn = fmaxf(fabsf(den), so[384 + 16 * wid + 4 * g + j]);
            const float inv = 1.f / dn;
#pragma unroll
            for (int n = 0; n < 8; ++n) hsum[n][j] += acc[n][j] * inv;
        }
    }
    const float* gml = P.g_ml_norm + l * 512 + h * 128;
#pragma unroll
    for (int j = 0; j < 4; ++j) {
        float ss = 0.f;
#pragma unroll
        for (int n = 0; n < 8; ++n) ss += hsum[n][j] * hsum[n][j];
        ss += __shfl_xor(ss, 1); ss += __shfl_xor(ss, 2); ss += __shfl_xor(ss, 4); ss += __shfl_xor(ss, 8);
        const float rstd = rsqrtf(ss * (1.f / 128.f) + EPS);
        const int row = row0 + 16 * wid + 4 * g + j;
#pragma unroll
        for (int n = 0; n < 8; ++n) {
            const int v = 16 * n + fr;
            const float og = sigmoidf(bf2f(P.p[(size_t)row * PN + P_MLO + h * 128 + v]));
            P.abuf[(size_t)row * 1024 + h * 128 + v] = (bf16_t)(pk2(hsum[n][j] * rstd * gml[v] * og, 0.f) & 0xffffu);
        }
    }
    __syncthreads();
}

__device__ __forceinline__ void mc_gla(const Params& P, LAS unsigned char* lds, int l, int b, int h, int pc) {
    const int tid = threadIdx.x, lane = tid & 63, wid = __builtin_amdgcn_readfirstlane(tid >> 6);
    const int g = lane >> 4, fr = lane & 15, q4 = fr >> 2, p4 = lane & 3;
    LAS unsigned char* Qf = lds; LAS unsigned char* Kf = lds + 18432; LAS unsigned char* Qb = lds + 36864; LAS unsigned char* Kb = lds + 55296;
    LAS unsigned char* Vt = lds + 73728; LAS unsigned char* Sf = lds + 108544; LAS unsigned char* Sb = lds + 126080;
    LAS float* segtot = (LAS float*)(lds + 143616);
    LAS float* alr = (LAS float*)Sf;
    const int row0 = chunk_row0(b, pc), sq0 = (b * 4 + h) * 2;
    gla_stage_alr(P, alr, row0, tid);
    __syncthreads();
    {
        float bF[16], bB[16], totF, totB;
        gla_gates(P, alr, segtot, l, h, tid, bF, bB, totF, totB);
        const int k = tid & 63, seg = tid >> 6;
#pragma unroll
        for (int tt = 0; tt < 16; ++tt) {
            const int t = seg * 16 + tt;
            const float qr = bf2f(P.p[(size_t)(row0 + t) * PN + P_GQ + h * 64 + k]) * 0.125f, kr = bf2f(P.p[(size_t)(row0 + t) * PN + P_GK + h * 64 + k]);
            const unsigned a = pk2(qr * __expf(bF[tt]), kr * __expf(-bF[tt])), c = pk2(qr * __expf(bB[tt]), kr * __expf(-bB[tt]));
            *(LAS bf16_t*)(Qf + t * TS64 + k * 2) = (bf16_t)(a & 0xffffu); *(LAS bf16_t*)(Kf + t * TS64 + k * 2) = (bf16_t)(a >> 16);
            *(LAS bf16_t*)(Qb + t * TS64 + k * 2) = (bf16_t)(c & 0xffffu); *(LAS bf16_t*)(Kb + t * TS64 + k * 2) = (bf16_t)(c >> 16);
        }
    }
    __syncthreads();
#pragma unroll
    for (int i = 0; i < 4; ++i) { const int id = tid + 512 * i, t = id >> 4, c = id & 15; *(LAS u32x4*)(Vt + t * TS + c * 16) = *(const u32x4*)(P.p + (size_t)(row0 + t) * PN + P_GV + h * 128 + c * 8); }
    {
        const unsigned char* i0 = (const unsigned char*)P.gl_pre + ((size_t)(sq0 + 0) * 66 + pc) * GL_IMG;
        const unsigned char* i1 = (const unsigned char*)P.gl_pre + ((size_t)(sq0 + 1) * 66 + pc) * GL_IMG;
        for (int id = tid; id < GL_IMG / 16; id += NTHR) { *(LAS u32x4*)(Sf + id * 16) = *(const u32x4*)(i0 + id * 16); *(LAS u32x4*)(Sb + id * 16) = *(const u32x4*)(i1 + id * 16); }
    }
    __syncthreads();
    f32x4 acc[8];
#pragma unroll
    for (int n = 0; n < 8; ++n) acc[n] = (f32x4){0.f, 0.f, 0.f, 0.f};
    const unsigned vtb = lds_addr(Vt);
    const int tq = 16 * wid + fr;
#pragma unroll 1
    for (int dir = 0; dir < 2; ++dir) {
        LAS unsigned char* Qd = dir ? Qb : Qf; LAS unsigned char* Kd = dir ? Kb : Kf;
        const unsigned sb_ = lds_addr(dir ? Sb : Sf);
        bf16x8 qf[2];
#pragma unroll
        for (int kk = 0; kk < 2; ++kk) qf[kk] = *(const LAS bf16x8*)(Qd + (16 * wid + fr) * TS64 + (32 * kk + 8 * g) * 2);
#pragma unroll
        for (int kk = 0; kk < 2; ++kk) {
            const unsigned ro = sb_ + (unsigned)((32 * kk + 8 * g + q4) * TS + 8 * p4);
            bf16x8 bfr[8];
            tr_read4<4 * TS, 32>(ro, bfr[0], bfr[1], bfr[2], bfr[3]);
            tr_read4<4 * TS, 32>(ro + 128, bfr[4], bfr[5], bfr[6], bfr[7]);
#pragma unroll
            for (int n = 0; n < 8; ++n) acc[n] = MFMA16(qf[kk], bfr[n], acc[n]);
        }
        const int ilo = dir ? (wid >> 1) : 0, ihi = dir ? 3 : (wid >> 1);
#pragma unroll 1
        for (int i = ilo; i <= ihi; ++i) {
            unsigned pw[4];
#pragma unroll
            for (int half = 0; half < 2; ++half) {
                const int sb = 2 * i + half;
                f32x4 d = (f32x4){0.f, 0.f, 0.f, 0.f};
#pragma unroll
                for (int kk = 0; kk < 2; ++kk) { const bf16x8 kf = *(const LAS bf16x8*)(Kd + (16 * sb + fr) * TS64 + (32 * kk + 8 * g) * 2); d = MFMA16(kf, qf[kk], d); }
                float pv[4];
#pragma unroll
                for (int j = 0; j < 4; ++j) { const int s = 16 * sb + 4 * g + j; const bool valid = dir ? (s >= tq) : (s <= tq); pv[j] = valid ? d[j] : 0.f; }
                pw[half * 2 + 0] = pk2(pv[0], pv[1]); pw[half * 2 + 1] = pk2(pv[2], pv[3]);
            }
            u32x4 pu; pu.x = pw[0]; pu.y = pw[1]; pu.z = pw[2]; pu.w = pw[3];
            const bf16x8 pa = __builtin_bit_cast(bf16x8, pu);
            const unsigned ro = vtb + (unsigned)((32 * i + 4 * g + q4) * TS + 8 * p4);
            bf16x8 bfr[8];
            tr_read4<16 * TS, 32>(ro, bfr[0], bfr[1], bfr[2], bfr[3]);
            tr_read4<16 * TS, 32>(ro + 128, bfr[4], bfr[5], bfr[6], bfr[7]);
#pragma unroll
            for (int n = 0; n < 8; ++n) acc[n] = MFMA16(pa, bfr[n], acc[n]);
        }
    }
    const float* ggl = P.g_gla_norm + l * 512 + h * 128;
#pragma unroll
    for (int j = 0; j < 4; ++j) {
        float ss = 0.f;
#pragma unroll
        for (int n = 0; n < 8; ++n) ss += acc[n][j] * acc[n][j];
        ss += __shfl_xor(ss, 1); ss += __shfl_xor(ss, 2); ss += __shfl_xor(ss, 4); ss += __shfl_xor(ss, 8);
        const float rstd = rsqrtf(ss * (1.f / 128.f) + EPS);
        const int row = row0 + 16 * wid + 4 * g + j;
#pragma unroll
        for (int n = 0; n < 8; ++n) {
            const int v = 16 * n + fr;
            const float rg = siluf(bf2f(P.p[(size_t)row * PN + P_GR + h * 128 + v]));
            P.abuf[(size_t)row * 1024 + 512 + h * 128 + v] = (bf16_t)(pk2(acc[n][j] * rstd * ggl[v] * rg, 0.f) & 0xffffu);
        }
    }
    __syncthreads();
}

__device__ __forceinline__ void phase_mix_c(const Params& P, LAS unsigned char* lds, int l, int pc0, int wg, int nwg) {
    const int npc = 66 - pc0, per = 8 * npc;
    for (int it = wg; it < 2 * per; it += nwg) {
        const int mixer = it / per, r = it % per, bh = r / npc, pc = pc0 + r % npc;
        if (mixer == 0) mc_mlstm(P, lds, l, bh >> 2, bh & 3, pc); else mc_gla(P, lds, l, bh >> 2, bh & 3, pc);
    }
}


__global__ void __launch_bounds__(1024) k_topk(Params P) {
    __shared__ float vals[SEQ];
    const int list = blockIdx.x, isctx = list >= 32, b = (list & 31) >> 4, e = list & 15;
    const int n = isctx ? CTX : SEQ, cap = n / 8;
    const int row0 = isctx ? NLAT + b * CTX : b * SEQ;
    const int segoff = isctx ? 2048 + b * 32 : b * 1024;
    for (int i = threadIdx.x; i < n; i += 1024) vals[i] = P.aff[(size_t)(row0 + i) * 16 + e];
    __syncthreads();
    for (int i = threadIdx.x; i < n; i += 1024) {
        const float vi = vals[i]; int cnt = 0;
        for (int j = 0; j < n; ++j) { const float vj = vals[j]; cnt += (vj > vi || (vj == vi && j < i)) ? 1 : 0; }
        int pr = -1;
        if (cnt < cap) { pr = e * MZ + segoff + cnt; P.glist[pr] = row0 + i; P.gval[pr] = vi; }
        P.inv[(size_t)(row0 + i) * 16 + e] = pr;
    }
}

extern __shared__ __attribute__((aligned(16))) unsigned char smem_dyn[];
#define PH_COMMON LAS unsigned char* lds = (LAS unsigned char*)smem_dyn; const int wg = blockIdx.x, nwg = gridDim.x; const int lane = threadIdx.x & 63; const int gw = wg * 8 + (threadIdx.x >> 6), ngw = nwg * 8; (void)lds; (void)lane; (void)gw; (void)ngw;

__global__ void __launch_bounds__(512, 2) k_prep(Params P) { PH_COMMON phase_prep_small(P, lds, wg, nwg); phase_ada(P, lds, wg, nwg); phase_resid_init(P, gw, ngw, lane); }
__global__ void __launch_bounds__(512, 2) k_prep_experts(Params P, int l) { PH_COMMON phase_prep_experts(P, lds, l, wg, nwg); }
__global__ void __launch_bounds__(512, 2) k_rowop_pre(Params P, int l) { PH_COMMON phase_rowop_pre(P, l, gw, ngw, lane); }
__global__ void __launch_bounds__(512, 2) k_gemm_in(Params P, int l) {
    PH_COMMON
    SchedDense S; S.nM = NROW / 256; S.nN = PN / 256; S.nwg = S.nM * S.nN; S.G = nwg; S.c = wg; S.Bt = (const char*)(P.WinT + (size_t)l * PN * 1024);
    EpiStoreBf16 E; E.O = P.p; E.ldo = PN;
    gemm_phase(lds, (const char*)P.abuf, S, E);
    phase_gates(P, l, gw, ngw, lane);
}
__global__ void __launch_bounds__(512, 2) k_gemm_out(Params P, int l, int nrows) {
    PH_COMMON
    SchedDense S; S.nM = nrows / 256; S.nN = 4; S.nwg = S.nM * S.nN; S.G = nwg; S.c = wg; S.Bt = (const char*)(P.WoutT + (size_t)l * 1024 * 1024);
    EpiStoreBf16 E; E.O = P.r1; E.ldo = 1024;
    gemm_phase(lds, (const char*)P.abuf, S, E);
}
__global__ void __launch_bounds__(512, 2) k_mix_a(Params P, int l) { PH_COMMON phase_mix_a(P, lds, l, wg, nwg); }
__global__ void __launch_bounds__(512, 2) k_mix_b(Params P) { PH_COMMON phase_mix_b(P, wg, nwg); }
__global__ void __launch_bounds__(512, 2) k_mix_c(Params P, int l, int pc0) { PH_COMMON phase_mix_c(P, lds, l, pc0, wg, nwg); }
__global__ void __launch_bounds__(512, 2) k_rowop_mid(Params P, int l, int nrows) { PH_COMMON phase_rowop_mid(P, l, nrows, gw, ngw, lane); }
__global__ void __launch_bounds__(512, 2) k_gemm_gateup(Params P, int mtn) {
    PH_COMMON
    SchedGateUp S; S.G = nwg; S.c = wg; S.mtn = mtn; S.glist = P.glist; S.Wg = (const char*)P.WegT; S.Wu = (const char*)P.WeuT;
    EpiGateUp E; E.hid = P.p;
    gemm_phase(lds, (const char*)P.abuf, S, E);
}
__global__ void __launch_bounds__(512, 2) k_gemm_down(Params P, int mtn) {
    PH_COMMON
    SchedDown S; S.G = nwg; S.c = wg; S.mtn = mtn; S.Wd = (const char*)P.WedT;
    EpiDown E; E.yp = P.r1; E.gval = P.gval;
    gemm_phase(lds, (const char*)P.p, S, E);
}
__global__ void __launch_bounds__(512, 2) k_rowop_post(Params P, int l, int nrows) { PH_COMMON phase_rowop_post(P, l, nrows, gw, ngw, lane); }

__global__ void __launch_bounds__(512, 2) k_skeleton(Params P) {
    cg::grid_group grid = cg::this_grid();
    unsigned* w = P.bar + 1024;
    if (threadIdx.x == 0) w[blockIdx.x] = blockIdx.x + 1;
    grid.sync();
    unsigned s = 0;
    if (threadIdx.x == 0) { for (int i = 0; i < (int)gridDim.x; ++i) s += w[i]; w[512 + blockIdx.x] = s; }
    grid.sync();
    if (threadIdx.x == 0 && blockIdx.x == 0) { unsigned ok = 1; for (int i = 0; i < (int)gridDim.x; ++i) ok &= (w[512 + i] == (unsigned)(gridDim.x * (gridDim.x + 1) / 2)); w[1023] = ok; }
}
}

extern "C" void kernel_launch(void* const* d_in, const int* in_sizes, int n_in, void* d_out, int out_size, void* d_ws, size_t ws_size, hipStream_t stream) {
    Params P{};
    P.x = (const float*)d_in[0]; P.c = (const float*)d_in[1]; P.ctx = (const float*)d_in[2]; P.c_ctx = (const float*)d_in[3];
    P.w_ada = (const float*)d_in[4]; P.b_ada = (const float*)d_in[5];
    P.g_mix_pre = (const float*)d_in[6]; P.g_mix_post = (const float*)d_in[7]; P.g_ffn_pre = (const float*)d_in[8]; P.g_ffn_post = (const float*)d_in[9];
    P.w_in = (const float*)d_in[10]; P.conv_qk = (const float*)d_in[11]; P.b_ml_gates = (const float*)d_in[12];
    P.w_gla_a2 = (const float*)d_in[13]; P.b_gla_a = (const float*)d_in[14]; P.g_ml_norm = (const float*)d_in[15]; P.g_gla_norm = (const float*)d_in[16];
    P.w_out = (const float*)d_in[17]; P.w_router = (const float*)d_in[18];
    P.w_e_gate = (const float*)d_in[19]; P.w_e_up = (const float*)d_in[20]; P.w_e_down = (const float*)d_in[21];
    P.out = (float*)d_out;

    char* ws = (char*)d_ws; size_t off = 0;
    auto carve = [&](size_t bytes) { void* r = ws + off; off += (bytes + 255) & ~(size_t)255; return r; };
    P.bar = (unsigned*)carve(65536);
    P.xc = (float*)carve((size_t)NCTX * 1024 * 4);
    P.WinT = (bf16_t*)carve((size_t)DEPTH * PN * 1024 * 2);
    P.WgaT = (bf16_t*)carve((size_t)DEPTH * 64 * 1024 * 2);
    P.WoutT = (bf16_t*)carve((size_t)DEPTH * 1024 * 1024 * 2);
    P.WegT = (bf16_t*)carve((size_t)NE * 1024 * 1024 * 2);
    P.WeuT = (bf16_t*)carve((size_t)NE * 1024 * 1024 * 2);
    P.WedT = (bf16_t*)carve((size_t)NE * 1024 * 1024 * 2);
    P.abuf = (bf16_t*)carve((size_t)NROW * 1024 * 2);
    P.p = (bf16_t*)carve((size_t)NROW * PN * 2);
    P.pga = (float*)carve((size_t)NROW * GA * 4);
    P.r1 = (bf16_t*)carve((size_t)2 * NROW * 1024 * 2);
    P.qk = P.r1 + (size_t)NROW * 1024;
    P.ml_ck = (bf16_t*)carve((size_t)16 * 66 * ML_IMG);
    P.ml_pre = (bf16_t*)carve((size_t)16 * 66 * ML_IMG);
    P.gl_ck = (bf16_t*)carve((size_t)16 * 66 * GL_IMG);
    P.gl_pre = (bf16_t*)carve((size_t)16 * 66 * GL_IMG);
    P.mstat = (float*)carve((size_t)16 * 66 * 2 * 4);
    P.mprev = (float*)carve((size_t)16 * 66 * 4);
    P.gbend = (float*)carve((size_t)16 * 66 * 64 * 4);
    P.mod = (float*)carve((size_t)DEPTH * 3 * 6144 * 4);
    P.aff = (float*)carve((size_t)NROW * 16 * 4);
    P.glist = (int*)carve((size_t)NE * MZ * 4);
    P.gval = (float*)carve((size_t)NE * MZ * 4);
    P.inv = (int*)carve((size_t)NROW * 16 * 4);

    static int inited = 0;
    if (!inited) {
        inited = 1;
        (void)hipFuncSetAttribute((const void*)k_prep, hipFuncAttributeMaxDynamicSharedMemorySize, LDS_BYTES);
        (void)hipFuncSetAttribute((const void*)k_prep_experts, hipFuncAttributeMaxDynamicSharedMemorySize, LDS_BYTES);
        (void)hipFuncSetAttribute((const void*)k_gemm_in, hipFuncAttributeMaxDynamicSharedMemorySize, LDS_BYTES);
        (void)hipFuncSetAttribute((const void*)k_gemm_out, hipFuncAttributeMaxDynamicSharedMemorySize, LDS_BYTES);
        (void)hipFuncSetAttribute((const void*)k_gemm_gateup, hipFuncAttributeMaxDynamicSharedMemorySize, LDS_BYTES);
        (void)hipFuncSetAttribute((const void*)k_gemm_down, hipFuncAttributeMaxDynamicSharedMemorySize, LDS_BYTES);
        (void)hipFuncSetAttribute((const void*)k_mix_a, hipFuncAttributeMaxDynamicSharedMemorySize, LDS_BYTES);
        (void)hipFuncSetAttribute((const void*)k_mix_c, hipFuncAttributeMaxDynamicSharedMemorySize, LDS_BYTES);
    }
    (void)hipMemsetAsync(P.bar, 0, 65536, stream);
    {
        void* args[] = {&P};
        (void)hipLaunchCooperativeKernel((const void*)k_skeleton, dim3(NWG), dim3(NTHR), args, 0, stream);
    }
    k_prep<<<NWG, NTHR, LDS_BYTES, stream>>>(P);
    for (int l = 0; l < DEPTH; ++l) {
        const bool last = (l == DEPTH - 1);
        const int nrows = last ? NLAT : NROW;
        k_prep_experts<<<NWG, NTHR, LDS_BYTES, stream>>>(P, l);
        k_rowop_pre<<<NWG, NTHR, 0, stream>>>(P, l);
        k_gemm_in<<<NWG, NTHR, LDS_BYTES, stream>>>(P, l);
        k_mix_a<<<NWG, NTHR, LDS_BYTES, stream>>>(P, l);
        k_mix_b<<<NWG, NTHR, 0, stream>>>(P);
        k_mix_c<<<NWG, NTHR, LDS_BYTES, stream>>>(P, l, last ? 2 : 0);
        k_gemm_out<<<NWG, NTHR, LDS_BYTES, stream>>>(P, l, nrows);
        k_rowop_mid<<<NWG, NTHR, 0, stream>>>(P, l, nrows);
        k_topk<<<last ? 32 : 64, 1024, 0, stream>>>(P);
        const int mtn = last ? 8 : 9;
        k_gemm_gateup<<<NWG, NTHR, LDS_BYTES, stream>>>(P, mtn);
        k_gemm_down<<<NWG, NTHR, LDS_BYTES, stream>>>(P, mtn);
        k_rowop_post<<<NWG, NTHR, 0, stream>>>(P, l, nrows);
    }
}
```

```cpp
#include <hip/hip_runtime.h>
#include <hip/hip_cooperative_groups.h>
#include <math.h>
namespace cg = cooperative_groups;

namespace {
#define LAS __attribute__((address_space(3)))
typedef unsigned short bf16_t;
typedef short bf16x8 __attribute__((ext_vector_type(8)));
typedef float f32x4 __attribute__((ext_vector_type(4)));
typedef unsigned u32x4 __attribute__((ext_vector_type(4)));
typedef unsigned u32x2 __attribute__((ext_vector_type(2)));

constexpr int D = 1024, NB = 2, SEQ = 8192, CTX = 256, DEPTH = 2;
constexpr int NLAT = NB * SEQ;
constexpr int NCTX = NB * CTX;
constexpr int NROW = NLAT + NCTX;
constexpr int PW = 3632;
constexpr int PN = 3584;
constexpr int P_MLQ = 0, P_MLK = 512, P_MLV = 1024, P_MLO = 1536, P_GQ = 2048, P_GK = 2304, P_GV = 2560, P_GR = 3072;
constexpr int GA = 64;
constexpr int NE = 16;
constexpr int MZ = 2112;
constexpr float EPS = 1e-6f;
constexpr int NWG = 256, NTHR = 512;
constexpr int LDS_BYTES = 152 * 1024;
constexpr int ML_IMG = 128 * 272, GL_IMG = 64 * 272;

__device__ __forceinline__ float wave_sum(float v) {
#pragma unroll
    for (int o = 32; o > 0; o >>= 1) v += __shfl_xor(v, o);
    return v;
}
__device__ __forceinline__ int ltid() { int t = threadIdx.x; asm volatile("" : "+v"(t)); return t; }
__device__ __forceinline__ float siluf(float x) { return x / (1.f + expf(-x)); }
__device__ __forceinline__ float sigmoidf(float x) { return 1.f / (1.f + expf(-x)); }
__device__ __forceinline__ float logsigmoidf(float x) { return fminf(x, 0.f) - log1pf(expf(-fabsf(x))); }
__device__ __forceinline__ int modrow(int row) { return row < NLAT ? row / SEQ : 2; }
__device__ __forceinline__ unsigned pk2(float lo, float hi) { unsigned r; asm("v_cvt_pk_bf16_f32 %0, %1, %2" : "=v"(r) : "v"(lo), "v"(hi)); return r; }
__device__ __forceinline__ float bf2f(bf16_t b) { return __uint_as_float(((unsigned)b) << 16); }
__device__ __forceinline__ float bflo(unsigned u) { return __uint_as_float(u << 16); }
__device__ __forceinline__ float bfhi(unsigned u) { return __uint_as_float(u & 0xffff0000u); }

struct Params {
    const float *x, *c, *ctx, *c_ctx, *w_ada, *b_ada, *g_mix_pre, *g_mix_post, *g_ffn_pre, *g_ffn_post, *w_in, *conv_qk, *b_ml_gates, *w_gla_a2, *b_gla_a, *g_ml_norm, *g_gla_norm,
        *w_out, *w_router, *w_e_gate, *w_e_up, *w_e_down;
    float* out;
    float* xc;
    bf16_t *WinT, *WgaT, *WoutT, *WegT, *WeuT, *WedT;
    bf16_t *abuf;
    bf16_t *p;
    float* pga;
    bf16_t *r1;
    bf16_t* qk;
    bf16_t *ml_ck, *ml_pre;
    bf16_t *gl_ck, *gl_pre;
    float *mstat;
    float *mprev;
    float *gbend;
    float* mod;
    float* aff;
    int* glist; float* gval; int* inv;
    unsigned* bar;
    int pad_;
};

__device__ __forceinline__ float* xrow_ptr(const Params& P, int row) { return row < NLAT ? P.out + (size_t)row * 1024 : P.xc + (size_t)(row - NLAT) * 1024; }

__device__ __forceinline__ void transpose_item(const float* W, int ldw, int k0, int srccol0, int nvalid_lo, int nvalid_hi  , int special,
                                               bf16_t* WT, int dstrow0, LAS float* scr, int tid) {
    {
        const int k = tid >> 3, n8 = (tid & 7) * 8;
#pragma unroll
        for (int q = 0; q < 2; ++q) {
            const int n = n8 + q * 4;
            float4 v = make_float4(0.f, 0.f, 0.f, 0.f);
            int sc;
            if (special) {
                if (n < 16) sc = 2048 + n; else if (n < 48) sc = 3600 + (n - 16); else sc = -1;
            } else sc = srccol0 + n;
            if (sc >= 0) v = *(const float4*)(W + (size_t)(k0 + k) * ldw + sc);
            scr[k * 65 + n + 0] = v.x; scr[k * 65 + n + 1] = v.y; scr[k * 65 + n + 2] = v.z; scr[k * 65 + n + 3] = v.w;
        }
    }
    __syncthreads();
    {
        const int n = tid >> 3, kc = (tid & 7) * 8;
        u32x4 o;
        o.x = pk2(scr[(kc + 0) * 65 + n], scr[(kc + 1) * 65 + n]); o.y = pk2(scr[(kc + 2) * 65 + n], scr[(kc + 3) * 65 + n]);
        o.z = pk2(scr[(kc + 4) * 65 + n], scr[(kc + 5) * 65 + n]); o.w = pk2(scr[(kc + 6) * 65 + n], scr[(kc + 7) * 65 + n]);
        *(u32x4*)(WT + (size_t)(dstrow0 + n) * 1024 + k0 + kc) = o;
    }
    __syncthreads();
}

constexpr int IT_IN = 16 * 56, IT_GA = 16, IT_OUT = 256, IT_EX = 3 * 16 * 256, IT_LAYER_SMALL = IT_IN + IT_GA + IT_OUT;
__device__ __forceinline__ void phase_prep_small(const Params& P, LAS unsigned char* lds, int wg, int nwg) {
    LAS float* scr = (LAS float*)lds; const int tid = ltid();
    for (int it = wg; it < DEPTH * IT_LAYER_SMALL; it += nwg) {
        const int l = it / IT_LAYER_SMALL; int r = it % IT_LAYER_SMALL;
        if (r < IT_IN) { const int kb = r / 56, nb = r % 56, n0 = nb * 64; transpose_item(P.w_in + (size_t)l * 1024 * PW, PW, kb * 64, n0 + (n0 >= 2048 ? 16 : 0), 0, 64, 0, P.WinT + (size_t)l * PN * 1024, n0, scr, tid); continue; }
        r -= IT_IN;
        if (r < IT_GA) { transpose_item(P.w_in + (size_t)l * 1024 * PW, PW, r * 64, 0, 0, 48, 1, P.WgaT + (size_t)l * 64 * 1024, 0, scr, tid); continue; }
        r -= IT_GA;
        { const int kb = r / 16, nb = r % 16; transpose_item(P.w_out + (size_t)l * 1024 * 1024, 1024, kb * 64, nb * 64, 0, 64, 0, P.WoutT + (size_t)l * 1024 * 1024, nb * 64, scr, tid); }
    }
}
__device__ __forceinline__ void phase_prep_experts(const Params& P, LAS unsigned char* lds, int l, int wg, int nwg) {
    LAS float* scr = (LAS float*)lds; const int tid = ltid();
    for (int it = wg; it < IT_EX; it += nwg) {
        const int m = it / (16 * 256), e = (it / 256) % 16, r = it % 256, kb = r / 16, nb = r % 16;
        const float* src = (m == 0 ? P.w_e_gate : (m == 1 ? P.w_e_up : P.w_e_down)) + ((size_t)l * NE + e) * 1024 * 1024;
        bf16_t* dst = (m == 0 ? P.WegT : (m == 1 ? P.WeuT : P.WedT)) + (size_t)e * 1024 * 1024;
        transpose_item(src, 1024, kb * 64, nb * 64, 0, 64, 0, dst, nb * 64, scr, tid);
    }
}

__device__ __forceinline__ void phase_ada(const Params& P, LAS unsigned char* lds, int wg, int nwg) {
    LAS float* s = (LAS float*)lds;
    const int tid = ltid();
    for (int i = tid; i < 1024; i += NTHR) { s[i] = siluf(P.c[i]); s[1024 + i] = siluf(P.c[1024 + i]); s[2048 + i] = siluf(P.c_ctx[i]); }
    __syncthreads();
    LAS float* red = s + 3072;
    for (int it = wg; it < DEPTH * 96; it += nwg) {
        const int l = it / 96, n = (it % 96) * 64 + (tid & 63), ks = tid >> 6;
        const float* w = P.w_ada + (size_t)l * 1024 * 6144 + n;
        float a0 = 0, a1 = 0, a2 = 0;
#pragma unroll 8
        for (int k = ks * 128; k < ks * 128 + 128; ++k) { const float wv = w[(size_t)k * 6144]; a0 += s[k] * wv; a1 += s[1024 + k] * wv; a2 += s[2048 + k] * wv; }
        red[(ks * 3 + 0) * 64 + (tid & 63)] = a0; red[(ks * 3 + 1) * 64 + (tid & 63)] = a1; red[(ks * 3 + 2) * 64 + (tid & 63)] = a2;
        __syncthreads();
        if (tid < 192) {
            const int r = tid / 64, cidx = tid & 63; float a = 0;
#pragma unroll
            for (int q = 0; q < 8; ++q) a += red[(q * 3 + r) * 64 + cidx];
            const int nn = (it % 96) * 64 + cidx;
            P.mod[((size_t)l * 3 + r) * 6144 + nn] = a + P.b_ada[l * 6144 + nn];
        }
        __syncthreads();
    }
}

__device__ __forceinline__ void phase_resid_init(const Params& P, int wg, int nwg) {
    const int tid_ = ltid(), lane = tid_ & 63, gw = wg * 8 + (tid_ >> 6), ngw = nwg * 8;
    for (int row = gw; row < NROW; row += ngw) {
        if (row < NLAT) {
            const int t = row % SEQ, r = t / 64, cc = t % 64;
#pragma unroll
            for (int j = 0; j < 4; ++j) {
                const int col = j * 256 + lane * 4;
                float4 v = *(const float4*)(P.x + (size_t)row * 1024 + col);
                float e[4];
#pragma unroll
                for (int q = 0; q < 4; ++q) { const int jj = (col + q) & 255; const float freq = powf(10000.f, -(float)jj / 256.f); const float arg = (float)(j < 2 ? r : cc) * freq; e[q] = (j & 1) ? cosf(arg) : sinf(arg); }
                v.x += e[0]; v.y += e[1]; v.z += e[2]; v.w += e[3];
                *(float4*)(P.out + (size_t)row * 1024 + col) = v;
            }
        } else {
#pragma unroll
            for (int j = 0; j < 4; ++j) { const int col = j * 256 + lane * 4; *(float4*)(P.xc + (size_t)(row - NLAT) * 1024 + col) = *(const float4*)(P.ctx + (size_t)(row - NLAT) * 1024 + col); }
        }
    }
}

__device__ __forceinline__ void store_bf16x4(bf16_t* p, float a, float b, float c, float d) { u32x2 o; o.x = pk2(a, b); o.y = pk2(c, d); *(u32x2*)p = o; }

__device__ __forceinline__ void phase_rowop_pre(const Params& P, int l, int wg, int nwg) {
    const int tid_ = ltid(), lane = tid_ & 63, gw = wg * 8 + (tid_ >> 6), ngw = nwg * 8;
    const float* g = P.g_mix_pre + l * 1024;
    for (int row = gw; row < NROW; row += ngw) {
        const float* xr = xrow_ptr(P, row);
        const float* m = P.mod + ((size_t)l * 3 + modrow(row)) * 6144;
        float4 v[4]; float ss = 0;
#pragma unroll
        for (int j = 0; j < 4; ++j) { v[j] = *(const float4*)(xr + j * 256 + lane * 4); ss += v[j].x * v[j].x + v[j].y * v[j].y + v[j].z * v[j].z + v[j].w * v[j].w; }
        const float rstd = rsqrtf(wave_sum(ss) * (1.f / 1024.f) + EPS);
#pragma unroll
        for (int j = 0; j < 4; ++j) {
            const int col = j * 256 + lane * 4;
            const float4 gg = *(const float4*)(g + col), sh = *(const float4*)(m + col), sc = *(const float4*)(m + 1024 + col);
            store_bf16x4(P.abuf + (size_t)row * 1024 + col, v[j].x * rstd * gg.x * (1.f + sc.x) + sh.x, v[j].y * rstd * gg.y * (1.f + sc.y) + sh.y,
                         v[j].z * rstd * gg.z * (1.f + sc.z) + sh.z, v[j].w * rstd * gg.w * (1.f + sc.w) + sh.w);
        }
    }
}

__device__ __forceinline__ void phase_rowop_mid(const Params& P, int l, int nrows, int wg, int nwg) {
    const int tid_ = ltid(), lane = tid_ & 63, gw = wg * 8 + (tid_ >> 6), ngw = nwg * 8;
    const float* g_post = P.g_mix_post + l * 1024; const float* g_pre2 = P.g_ffn_pre + l * 1024; const float* wr = P.w_router + (size_t)l * 1024 * 16;
    const bf16_t* y = P.r1;
    for (int row = gw; row < nrows; row += ngw) {
        float* xr = xrow_ptr(P, row);
        const float* m = P.mod + ((size_t)l * 3 + modrow(row)) * 6144;
        float yv[16], xv[16]; float ss = 0;
#pragma unroll
        for (int j = 0; j < 4; ++j) { const u32x2 u = *(const u32x2*)(y + (size_t)row * 1024 + j * 256 + lane * 4); yv[j * 4 + 0] = bflo(u.x); yv[j * 4 + 1] = bfhi(u.x); yv[j * 4 + 2] = bflo(u.y); yv[j * 4 + 3] = bfhi(u.y); }
#pragma unroll
        for (int i = 0; i < 16; ++i) ss += yv[i] * yv[i];
        float rstd = rsqrtf(wave_sum(ss) * (1.f / 1024.f) + EPS);
        ss = 0;
#pragma unroll
        for (int j = 0; j < 4; ++j) {
            const int col = j * 256 + lane * 4;
            const float4 xo = *(const float4*)(xr + col), gp = *(const float4*)(g_post + col), ga = *(const float4*)(m + 2048 + col);
            float4 xn; xn.x = xo.x + ga.x * (yv[j * 4 + 0] * rstd * gp.x); xn.y = xo.y + ga.y * (yv[j * 4 + 1] * rstd * gp.y); xn.z = xo.z + ga.z * (yv[j * 4 + 2] * rstd * gp.z); xn.w = xo.w + ga.w * (yv[j * 4 + 3] * rstd * gp.w);
            *(float4*)(xr + col) = xn;
            xv[j * 4 + 0] = xn.x; xv[j * 4 + 1] = xn.y; xv[j * 4 + 2] = xn.z; xv[j * 4 + 3] = xn.w;
            ss += xn.x * xn.x + xn.y * xn.y + xn.z * xn.z + xn.w * xn.w;
        }
        rstd = rsqrtf(wave_sum(ss) * (1.f / 1024.f) + EPS);
        float lg[16];
#pragma unroll
        for (int e = 0; e < 16; ++e) lg[e] = 0;
#pragma unroll
        for (int j = 0; j < 4; ++j) {
            const int col = j * 256 + lane * 4;
            const float4 gg = *(const float4*)(g_pre2 + col), sh = *(const float4*)(m + 3072 + col), sc = *(const float4*)(m + 4096 + col);
            float hv[4];
            hv[0] = xv[j * 4 + 0] * rstd * gg.x * (1.f + sc.x) + sh.x; hv[1] = xv[j * 4 + 1] * rstd * gg.y * (1.f + sc.y) + sh.y;
            hv[2] = xv[j * 4 + 2] * rstd * gg.z * (1.f + sc.z) + sh.z; hv[3] = xv[j * 4 + 3] * rstd * gg.w * (1.f + sc.w) + sh.w;
            store_bf16x4(P.abuf + (size_t)row * 1024 + col, hv[0], hv[1], hv[2], hv[3]);
#pragma unroll
            for (int q = 0; q < 4; ++q) {
                const float4* w4 = (const float4*)(wr + (size_t)(col + q) * 16);
#pragma unroll
                for (int e4 = 0; e4 < 4; ++e4) { const float4 w = w4[e4]; lg[e4 * 4 + 0] += hv[q] * w.x; lg[e4 * 4 + 1] += hv[q] * w.y; lg[e4 * 4 + 2] += hv[q] * w.z; lg[e4 * 4 + 3] += hv[q] * w.w; }
            }
        }
        float mx = -1e30f;
#pragma unroll
        for (int e = 0; e < 16; ++e) { lg[e] = wave_sum(lg[e]); mx = fmaxf(mx, lg[e]); }
        float se = 0;
#pragma unroll
        for (int e = 0; e < 16; ++e) { lg[e] = expf(lg[e] - mx); se += lg[e]; }
        float val = 0;
#pragma unroll
        for (int e = 0; e < 16; ++e) val = (e == lane) ? lg[e] : val;
        if (lane < 16) P.aff[(size_t)row * 16 + lane] = val / se;
    }
}

__device__ __forceinline__ void phase_rowop_post(const Params& P, int l, int nrows, int wg, int nwg) {
    const int tid_ = ltid(), lane = tid_ & 63, gw = wg * 8 + (tid_ >> 6), ngw = nwg * 8;
    const float* g_post = P.g_ffn_post + l * 1024;
    const bf16_t* yp = P.r1;
    for (int row = gw; row < nrows; row += ngw) {
        float* xr = xrow_ptr(P, row);
        const float* m = P.mod + ((size_t)l * 3 + modrow(row)) * 6144;
        float f[16];
#pragma unroll
        for (int i = 0; i < 16; ++i) f[i] = 0;
        const int myinv = P.inv[(size_t)row * 16 + (lane & 15)];
#pragma unroll 1
        for (int e = 0; e < 16; ++e) {
            const int pr = __shfl(myinv, e);
            if (pr >= 0) {
#pragma unroll
                for (int j = 0; j < 4; ++j) { const u32x2 u = *(const u32x2*)(yp + (size_t)pr * 1024 + j * 256 + lane * 4); f[j * 4 + 0] += bflo(u.x); f[j * 4 + 1] += bfhi(u.x); f[j * 4 + 2] += bflo(u.y); f[j * 4 + 3] += bfhi(u.y); }
            }
        }
        float ss = 0;
#pragma unroll
        for (int i = 0; i < 16; ++i) ss += f[i] * f[i];
        const float rstd = rsqrtf(wave_sum(ss) * (1.f / 1024.f) + EPS);
#pragma unroll
        for (int j = 0; j < 4; ++j) {
            const int col = j * 256 + lane * 4;
            const float4 xo = *(const float4*)(xr + col), gp = *(const float4*)(g_post + col), ga = *(const float4*)(m + 5120 + col);
            float4 xn; xn.x = xo.x + ga.x * (f[j * 4 + 0] * rstd * gp.x); xn.y = xo.y + ga.y * (f[j * 4 + 1] * rstd * gp.y); xn.z = xo.z + ga.z * (f[j * 4 + 2] * rstd * gp.z); xn.w = xo.w + ga.w * (f[j * 4 + 3] * rstd * gp.w);
            *(float4*)(xr + col) = xn;
        }
    }
}

constexpr int BK = 64, HALF = 128, HTB = HALF * BK * 2, GK = 1024;
__device__ __forceinline__ int lds_byte(int r, int c) { const int st = (r >> 4) * 2 + (c >> 5), rr = r & 15, cc = c & 31, ob = rr * 64 + cc * 2; return st * 1024 + (ob ^ (((ob >> 9) & 1) << 5)); }
__device__ __forceinline__ void stage_rc(int b, int& R, int& C) { const int st = b / 1024, sb = b % 1024, swz = sb ^ (((sb >> 9) & 1) << 5); R = (st >> 1) * 16 + swz / 64; C = (st & 1) * 32 + (swz % 64) / 2; }
__device__ __forceinline__ int perm32(int rho) { const int n = rho >> 4, i = rho & 15; return 8 * (i >> 2) + 4 * n + (i & 3); }

struct GUnit { int pm, pn, e, rows; };

template <class Sched, class Epi>
__device__ __forceinline__ void gemm_phase(LAS unsigned char* lds, const char* Abase, const Sched& S, const Epi& E) {
    const int tid = ltid(), wid = __builtin_amdgcn_readfirstlane(tid >> 6), lane = tid & 63, wr = wid >> 2, wc = wid & 3, fr = lane & 15, fq = lane >> 4;
    constexpr int nt = GK / BK;
    int R0, C0, R1, C1; stage_rc(tid * 16, R0, C0); stage_rc(tid * 16 + 8192, R1, C1);
    const unsigned voffB0 = (unsigned)(((R0 & ~31) + perm32(R0 & 31)) * GK + C0) * 2u, voffB1 = (unsigned)(((R1 & ~31) + perm32(R1 & 31)) * GK + C1) * 2u;
    constexpr size_t kstep = (size_t)(BK * 2);
    const unsigned ldsw = (unsigned)wid * 1024u;
    const int aoff = lds_byte(wr * 64 + fr, fq * 8), boff = lds_byte(wc * 32 + fr, fq * 8);
#define G_SA(b, h) (((b) * 2 + (h)) * HTB)
#define G_SB(b, h) ((4 + (b) * 2 + (h)) * HTB)
#define G_GL(bufoff, p0, p1) do { __builtin_amdgcn_global_load_lds((const unsigned*)(p0), (LAS unsigned*)(lds + (bufoff) + ldsw), 16, 0, 0); \
        __builtin_amdgcn_global_load_lds((const unsigned*)(p1), (LAS unsigned*)(lds + (bufoff) + ldsw + 8192), 16, 0, 0); } while (0)
#define G_STA(bufoff, kptr, o0, o1) G_GL(bufoff, (kptr) + (o0), (kptr) + (o1))
#define G_STB(bufoff, bptr) G_GL(bufoff, (bptr) + voffB0, (bptr) + voffB1)
#define G_LDA(dst, b, h) do { _Pragma("unroll") for (int m = 0; m < 4; ++m) _Pragma("unroll") for (int k = 0; k < 2; ++k) dst[m][k] = *(const LAS bf16x8*)(lds + G_SA(b, h) + aoff + m * 2048 + k * 1024); } while (0)
#define G_LDB(dst, b, h) do { _Pragma("unroll") for (int n = 0; n < 2; ++n) _Pragma("unroll") for (int k = 0; k < 2; ++k) dst[n][k] = *(const LAS bf16x8*)(lds + G_SB(b, h) + boff + n * 2048 + k * 1024); } while (0)
#define G_MMA(ai, bj, At, Bt) do { __builtin_amdgcn_s_setprio(1); _Pragma("unroll") for (int m = 0; m < 4; ++m) _Pragma("unroll") for (int n = 0; n < 2; ++n) _Pragma("unroll") for (int k = 0; k < 2; ++k) \
        acc[ai][bj][m][n] = __builtin_amdgcn_mfma_f32_16x16x32_bf16(Bt[n][k], At[m][k], acc[ai][bj][m][n], 0, 0, 0); __builtin_amdgcn_s_setprio(0); } while (0)
#define G_WAIT_V(n) asm volatile("s_waitcnt vmcnt(" #n ")" ::: "memory")
#define G_WAIT_L(n) asm volatile("s_waitcnt lgkmcnt(" #n ")" ::: "memory")
#define G_BAR __builtin_amdgcn_s_barrier()
#define G_SCHED __builtin_amdgcn_sched_barrier(0)
    GUnit cur, nxt; int ui = 0;
    if (!S.next(0, cur)) return;
    f32x4 acc[2][2][4][2];
#pragma unroll
    for (int a = 0; a < 2; ++a)
#pragma unroll
        for (int b = 0; b < 2; ++b)
#pragma unroll
            for (int m = 0; m < 4; ++m)
#pragma unroll
                for (int n = 0; n < 2; ++n) acc[a][b][m][n] = (f32x4){0.f, 0.f, 0.f, 0.f};
    bf16x8 At[4][2], B0[2][2], B1[2][2];
    unsigned c00, c01, c10, c11, n00, n01, n10, n11;
    S.aoff(cur, 0, R0, C0, R1, C1, c00, c01); S.aoff(cur, 1, R0, C0, R1, C1, c10, c11);
    const char* cB0 = S.bptr(cur, 0); const char* cB1 = S.bptr(cur, 1);
    G_STB(G_SB(0, 0), cB0); G_STA(G_SA(0, 0), Abase, c00, c01); G_STB(G_SB(0, 1), cB1); G_STA(G_SA(0, 1), Abase, c10, c11);
    if (wr == 1) G_BAR;
    G_WAIT_V(4); G_BAR;
    G_STB(G_SB(1, 0), cB0 + kstep); G_STA(G_SA(1, 0), Abase + kstep, c00, c01); G_STB(G_SB(1, 1), cB1 + kstep);
    G_WAIT_V(6); G_BAR;
    for (;;) {
        const bool has_next = S.next(ui + 1, nxt);
        const char* nB0 = cB0; const char* nB1 = cB1;
        n00 = c00; n01 = c01; n10 = c10; n11 = c11;
        if (has_next) { S.aoff(nxt, 0, R0, C0, R1, C1, n00, n01); S.aoff(nxt, 1, R0, C0, R1, C1, n10, n11); nB0 = S.bptr(nxt, 0); nB1 = S.bptr(nxt, 1); }
        for (int t = 0; t < nt; t += 2) {
            const bool last = (t == nt - 2);
            const char* a1 = Abase + (size_t)(t + 1) * kstep;
            const char* a2 = last ? Abase : Abase + (size_t)(t + 2) * kstep;
            const char* b20 = last ? nB0 : cB0 + (size_t)(t + 2) * kstep; const char* b21 = last ? nB1 : cB1 + (size_t)(t + 2) * kstep;
            const char* a3 = a2 + kstep; const char* b30 = b20 + kstep; const char* b31 = b21 + kstep;
            const unsigned s00 = last ? n00 : c00, s01 = last ? n01 : c01, s10 = last ? n10 : c10, s11 = last ? n11 : c11;
            G_LDB(B0, 0, 0); G_SCHED; G_LDA(At, 0, 0); G_STA(G_SA(1, 1), a1, c10, c11);
            G_WAIT_L(8); G_BAR; G_WAIT_L(0); G_MMA(0, 0, At, B0); G_BAR; G_SCHED;
            G_LDB(B1, 0, 1); G_STB(G_SB(0, 0), b20);
            G_BAR; G_WAIT_L(0); G_MMA(0, 1, At, B1); G_BAR;
            G_LDA(At, 0, 1); G_STA(G_SA(0, 0), a2, s00, s01);
            G_BAR; G_WAIT_L(0); G_MMA(1, 0, At, B0); G_BAR; G_SCHED;
            G_STB(G_SB(0, 1), b21);
            G_WAIT_V(6); G_BAR; G_MMA(1, 1, At, B1); G_BAR;
            G_LDB(B0, 1, 0); G_SCHED; G_LDA(At, 1, 0); G_STA(G_SA(0, 1), a2, s10, s11);
            G_WAIT_L(8); G_BAR; G_WAIT_L(0); G_MMA(0, 0, At, B0); G_BAR; G_SCHED;
            G_LDB(B1, 1, 1); G_STB(G_SB(1, 0), b30);
            G_BAR; G_WAIT_L(0); G_MMA(0, 1, At, B1); G_BAR;
            G_LDA(At, 1, 1); G_STA(G_SA(1, 0), a3, s00, s01);
            G_BAR; G_WAIT_L(0); G_MMA(1, 0, At, B0); G_BAR; G_SCHED;
            G_STB(G_SB(1, 1), b31);
            G_WAIT_V(6); G_BAR; G_MMA(1, 1, At, B1); G_BAR;
        }
        E(acc, cur, wr, wc, fr, fq);
        if (!has_next) break;
#pragma unroll
        for (int a = 0; a < 2; ++a)
#pragma unroll
            for (int b = 0; b < 2; ++b)
#pragma unroll
                for (int m = 0; m < 4; ++m)
#pragma unroll
                    for (int n = 0; n < 2; ++n) acc[a][b][m][n] = (f32x4){0.f, 0.f, 0.f, 0.f};
        cur = nxt; cB0 = nB0; cB1 = nB1; c00 = n00; c01 = n01; c10 = n10; c11 = n11; ++ui;
    }
    G_WAIT_V(0);
    if (wr == 0) G_BAR;
    G_BAR;
#undef G_SA
#undef G_SB
#undef G_GL
#undef G_STA
#undef G_STB
#undef G_LDA
#undef G_LDB
#undef G_MMA
#undef G_WAIT_V
#undef G_WAIT_L
#undef G_BAR
#undef G_SCHED
}

struct SchedDense {
    int nM, nN, nwg, G, c; const char* Bt;
    __device__ __forceinline__ bool next(int i, GUnit& u) const {
        const long L = (long)i * G + c; if (L >= nwg) return false;
        int wgid = (int)L; { const int q = nwg / 8, r = nwg % 8, xcd = wgid % 8, off = wgid / 8; wgid = (xcd < r ? xcd * (q + 1) : r * (q + 1) + (xcd - r) * q) + off; }
        const int nig = 8 * nN, gid = wgid / nig, fm = gid * 8, gsz = (nM - fm) < 8 ? (nM - fm) : 8;
        u.pm = fm + ((wgid % nig) % gsz); u.pn = (wgid % nig) / gsz; u.e = 0; u.rows = 256; return true;
    }
    __device__ __forceinline__ void aoff(const GUnit& u, int h, int R0, int C0, int R1, int C1, unsigned& o0, unsigned& o1) const {
        const unsigned base = (unsigned)(u.pm * 256 + h * 128);
        o0 = ((base + R0) * GK + C0) * 2u; o1 = ((base + R1) * GK + C1) * 2u;
    }
    __device__ __forceinline__ const char* bptr(const GUnit& u, int h) const { return Bt + (size_t)(u.pn * 256 + h * 128) * GK * 2; }
};
struct SchedGateUp {
    int G, c, mtn; const int* glist; const char* Wg; const char* Wu;
    __device__ __forceinline__ bool next(int i, GUnit& u) const {
        const int x = c & 7, j = c >> 3, per = G >> 3, L = i * per + j, tot = 2 * mtn * 8;
        if (L >= tot) return false;
        const int es = L / (mtn * 8), rem = L % (mtn * 8);
        u.e = x + 8 * es; u.pm = rem >> 3; u.pn = rem & 7; u.rows = (u.pm == 8) ? 64 : 256; return true;
    }
    __device__ __forceinline__ void aoff(const GUnit& u, int h, int R0, int C0, int R1, int C1, unsigned& o0, unsigned& o1) const {
        int r0 = h * 128 + R0, r1 = h * 128 + R1;
        r0 = r0 < u.rows ? r0 : 0; r1 = r1 < u.rows ? r1 : 0;
        const int g0 = glist[u.e * MZ + u.pm * 256 + r0], g1 = glist[u.e * MZ + u.pm * 256 + r1];
        o0 = ((unsigned)g0 * GK + C0) * 2u; o1 = ((unsigned)g1 * GK + C1) * 2u;
    }
    __device__ __forceinline__ const char* bptr(const GUnit& u, int h) const { return (h ? Wu : Wg) + ((size_t)u.e * 1024 + u.pn * 128) * GK * 2; }
};
struct SchedDown {
    int G, c, mtn; const char* Wd;
    __device__ __forceinline__ bool next(int i, GUnit& u) const {
        const int x = c & 7, j = c >> 3, per = G >> 3, L = i * per + j, tot = 2 * mtn * 4;
        if (L >= tot) return false;
        const int es = L / (mtn * 4), rem = L % (mtn * 4);
        u.e = x + 8 * es; u.pm = rem >> 2; u.pn = rem & 3; u.rows = (u.pm == 8) ? 64 : 256; return true;
    }
    __device__ __forceinline__ void aoff(const GUnit& u, int h, int R0, int C0, int R1, int C1, unsigned& o0, unsigned& o1) const {
        const unsigned base = (unsigned)(u.e * MZ + u.pm * 256 + h * 128);
        o0 = ((base + R0) * GK + C0) * 2u; o1 = ((base + R1) * GK + C1) * 2u;
    }
    __device__ __forceinline__ const char* bptr(const GUnit& u, int h) const { return Wd + ((size_t)u.e * 1024 + u.pn * 256 + h * 128) * GK * 2; }
};

struct EpiStoreBf16 {
    bf16_t* O; int ldo;
    __device__ __forceinline__ void operator()(const f32x4 (&acc)[2][2][4][2], const GUnit& u, int wr, int wc, int fr, int fq) const {
#pragma unroll
        for (int ai = 0; ai < 2; ++ai)
#pragma unroll
            for (int m = 0; m < 4; ++m) {
                bf16_t* rowp = O + (size_t)(u.pm * 256 + ai * 128 + wr * 64 + m * 16 + fr) * ldo + u.pn * 256 + wc * 32 + 8 * fq;
#pragma unroll
                for (int bj = 0; bj < 2; ++bj) { const f32x4 v0 = acc[ai][bj][m][0], v1 = acc[ai][bj][m][1]; u32x4 o; o.x = pk2(v0[0], v0[1]); o.y = pk2(v0[2], v0[3]); o.z = pk2(v1[0], v1[1]); o.w = pk2(v1[2], v1[3]); *(u32x4*)(rowp + bj * 128) = o; }
            }
    }
};
struct EpiGateUp {
    bf16_t* hid;
    __device__ __forceinline__ void operator()(const f32x4 (&acc)[2][2][4][2], const GUnit& u, int wr, int wc, int fr, int fq) const {
#pragma unroll
        for (int ai = 0; ai < 2; ++ai)
#pragma unroll
            for (int m = 0; m < 4; ++m) {
                const int r = ai * 128 + wr * 64 + m * 16 + fr;
                if (r < u.rows) {
                    float h[8];
#pragma unroll
                    for (int n = 0; n < 2; ++n)
#pragma unroll
                        for (int j = 0; j < 4; ++j) { const float g = acc[ai][0][m][n][j], up = acc[ai][1][m][n][j]; h[n * 4 + j] = g * __frcp_rn(1.f + __expf(-g)) * up; }
                    u32x4 o; o.x = pk2(h[0], h[1]); o.y = pk2(h[2], h[3]); o.z = pk2(h[4], h[5]); o.w = pk2(h[6], h[7]);
                    *(u32x4*)(hid + (size_t)(u.e * MZ + u.pm * 256 + r) * 1024 + u.pn * 128 + wc * 32 + 8 * fq) = o;
                }
            }
    }
};
struct EpiDown {
    bf16_t* yp; const float* gval;
    __device__ __forceinline__ void operator()(const f32x4 (&acc)[2][2][4][2], const GUnit& u, int wr, int wc, int fr, int fq) const {
#pragma unroll
        for (int ai = 0; ai < 2; ++ai)
#pragma unroll
            for (int m = 0; m < 4; ++m) {
                const int r = ai * 128 + wr * 64 + m * 16 + fr;
                if (r < u.rows) {
                    const int pr = u.e * MZ + u.pm * 256 + r; const float g = gval[pr];
                    bf16_t* rowp = yp + (size_t)pr * 1024 + u.pn * 256 + wc * 32 + 8 * fq;
#pragma unroll
                    for (int bj = 0; bj < 2; ++bj) { const f32x4 v0 = acc[ai][bj][m][0] * g, v1 = acc[ai][bj][m][1] * g; u32x4 o; o.x = pk2(v0[0], v0[1]); o.y = pk2(v0[2], v0[3]); o.z = pk2(v1[0], v1[1]); o.w = pk2(v1[2], v1[3]); *(u32x4*)(rowp + bj * 128) = o; }
                }
            }
    }
};

__device__ __forceinline__ void phase_gates(const Params& P, int l, int wg, int nwg) {
    const int tid_ = ltid(), lane = tid_ & 63, gw = wg * 8 + (tid_ >> 6), ngw = nwg * 8;
    const int fr = lane & 15, fq = lane >> 4;
    const bf16_t* W = P.WgaT + (size_t)l * 64 * 1024;
    for (int rb = gw; rb < NROW / 16; rb += ngw) {
        f32x4 acc[4];
#pragma unroll
        for (int n = 0; n < 4; ++n) acc[n] = (f32x4){0.f, 0.f, 0.f, 0.f};
        const bf16_t* arow = P.abuf + (size_t)(rb * 16 + fr) * 1024 + fq * 8;
#pragma unroll 4
        for (int k0 = 0; k0 < 1024; k0 += 32) {
            const bf16x8 a = *(const bf16x8*)(arow + k0);
#pragma unroll
            for (int n = 0; n < 4; ++n) { const bf16x8 b = *(const bf16x8*)(W + (size_t)(n * 16 + fr) * 1024 + k0 + fq * 8); acc[n] = __builtin_amdgcn_mfma_f32_16x16x32_bf16(a, b, acc[n], 0, 0, 0); }
        }
#pragma unroll
        for (int n = 0; n < 4; ++n)
#pragma unroll
            for (int j = 0; j < 4; ++j) P.pga[(size_t)(rb * 16 + fq * 4 + j) * GA + n * 16 + fr] = acc[n][j];
    }
}

constexpr int TS = 272;
constexpr int TS64 = 144;
constexpr int VS = 304;

__device__ __forceinline__ int chunk_row0(int b, int pc) { return pc < 2 ? NLAT + b * CTX + pc * 128 : b * SEQ + (pc - 2) * 128; }
__device__ __forceinline__ int virt_pc(int dir, int j) { return dir == 0 ? j : (j == 0 ? 1 : (j == 1 ? 0 : 67 - j)); }
__device__ __forceinline__ float wave_incl_sum(float s, int lane) {
#pragma unroll
    for (int o = 1; o < 64; o <<= 1) { const float y = __shfl_up(s, o); if (lane >= o) s += y; }
    return s;
}
__device__ __forceinline__ float wave_incl_max(float s, int lane) {
#pragma unroll
    for (int o = 1; o < 64; o <<= 1) { const float y = __shfl_up(s, o); if (lane >= o) s = fmaxf(s, y); }
    return s;
}
__device__ __forceinline__ float wave_max(float v) {
#pragma unroll
    for (int o = 32; o > 0; o >>= 1) v = fmaxf(v, __shfl_xor(v, o));
    return v;
}
__device__ __forceinline__ bf16x8 mk_frag(u32x2 lo, u32x2 hi) { u32x4 v; v.x = lo.x; v.y = lo.y; v.z = hi.x; v.w = hi.y; return __builtin_bit_cast(bf16x8, v); }
template <int HI>
__device__ __forceinline__ bf16x8 tr_read1(unsigned addr) {
    u32x2 lo, hi;
    asm volatile("ds_read_b64_tr_b16 %0, %2\n\tds_read_b64_tr_b16 %1, %2 offset:%3\n\ts_waitcnt lgkmcnt(0)" : "=&v"(lo), "=&v"(hi) : "v"(addr), "i"(HI) : "memory");
    return mk_frag(lo, hi);
}
template <int HI, int FS>
__device__ __forceinline__ void tr_read4(unsigned addr, bf16x8& f0, bf16x8& f1, bf16x8& f2, bf16x8& f3) {
    u32x2 a0, a1, b0, b1, c0, c1, d0, d1;
    asm volatile("ds_read_b64_tr_b16 %0, %8\n\t"
                 "ds_read_b64_tr_b16 %1, %8 offset:%9\n\t"
                 "ds_read_b64_tr_b16 %2, %8 offset:%10\n\t"
                 "ds_read_b64_tr_b16 %3, %8 offset:%11\n\t"
                 "ds_read_b64_tr_b16 %4, %8 offset:%12\n\t"
                 "ds_read_b64_tr_b16 %5, %8 offset:%13\n\t"
                 "ds_read_b64_tr_b16 %6, %8 offset:%14\n\t"
                 "ds_read_b64_tr_b16 %7, %8 offset:%15\n\t"
                 "s_waitcnt lgkmcnt(0)"
                 : "=&v"(a0), "=&v"(a1), "=&v"(b0), "=&v"(b1), "=&v"(c0), "=&v"(c1), "=&v"(d0), "=&v"(d1)
                 : "v"(addr), "i"(HI), "i"(FS), "i"(FS + HI), "i"(2 * FS), "i"(2 * FS + HI), "i"(3 * FS), "i"(3 * FS + HI)
                 : "memory");
    f0 = mk_frag(a0, a1); f1 = mk_frag(b0, b1); f2 = mk_frag(c0, c1); f3 = mk_frag(d0, d1);
}
__device__ __forceinline__ unsigned lds_addr(LAS unsigned char* p) { return (unsigned)(size_t)p; }
__device__ __forceinline__ void unpack8(const u32x4 u, float (&f)[8]) { f[0] = bflo(u.x); f[1] = bfhi(u.x); f[2] = bflo(u.y); f[3] = bfhi(u.y); f[4] = bflo(u.z); f[5] = bfhi(u.z); f[6] = bflo(u.w); f[7] = bfhi(u.w); }
__device__ __forceinline__ u32x4 pack8(const float (&f)[8]) { u32x4 o; o.x = pk2(f[0], f[1]); o.y = pk2(f[2], f[3]); o.z = pk2(f[4], f[5]); o.w = pk2(f[6], f[7]); return o; }
#define MFMA16(a, b, c) __builtin_amdgcn_mfma_f32_16x16x32_bf16(a, b, c, 0, 0, 0)

__device__ __forceinline__ void ma_mlstm(const Params& P, LAS unsigned char* lds, int l, int b, int h, int pc) {
    const int tid = ltid(), lane = tid & 63, wid = __builtin_amdgcn_readfirstlane(tid >> 6);
    LAS unsigned char* Kt = lds; LAS unsigned char* Vf = lds + 34816; LAS unsigned char* Vb = lds + 69632;
    LAS float* sc = (LAS float*)(lds + 104448);
    LAS float* red = sc + 6 * 128;
    const int row0 = chunk_row0(b, pc), sq0 = (b * 4 + h) * 2;
    if (tid < 128) {
        const float* ga = P.pga + (size_t)(row0 + tid) * GA; const float* bg = P.b_ml_gates + l * 16;
        sc[tid] = ga[h] + bg[h]; sc[128 + tid] = logsigmoidf(ga[4 + h] + bg[4 + h]); sc[256 + tid] = ga[8 + h] + bg[8 + h]; sc[384 + tid] = logsigmoidf(ga[12 + h] + bg[12 + h]);
    }
    __syncthreads();
    if (wid < 2) {
        const int dir = wid; LAS float* li = sc + dir * 256; LAS float* lf = li + 128; LAS float* e = sc + 512 + dir * 128;
        const int t0 = dir ? 127 - 2 * lane : 2 * lane, t1 = dir ? 126 - 2 * lane : 2 * lane + 1;
        const float x0 = lf[t0], x1 = lf[t1];
        const float incl = wave_incl_sum(x0 + x1, lane);
        const float b0 = incl - x1, b1 = incl;
        const float bend = __int_as_float(__builtin_amdgcn_readlane(__float_as_int(incl), 63));
        const float w0 = bend - b0 + li[t0], w1 = bend - b1 + li[t1];
        const float mk = wave_max(fmaxf(w0, w1));
        e[t0] = __expf(w0 - mk); e[t1] = __expf(w1 - mk);
        if (lane == 0) { float* ms = P.mstat + ((size_t)(sq0 + dir) * 66 + pc) * 2; ms[0] = bend; ms[1] = mk; }
    }
    __syncthreads();
    {
        const int c8 = tid & 15, tb = tid >> 4, qc = h * 128 + c8 * 8;
        const float* cw = P.conv_qk + (size_t)l * 3 * 1024;
        const bool segstart = (pc == 0 || pc == 2), segend = (pc == 1 || pc == 65);
        float wq[3][8], wk[3][8];
#pragma unroll
        for (int j = 0; j < 3; ++j)
#pragma unroll
            for (int e4 = 0; e4 < 2; ++e4) {
                const float4 a = *(const float4*)(cw + j * 1024 + qc + e4 * 4), c = *(const float4*)(cw + j * 1024 + 512 + qc + e4 * 4);
                wq[j][e4 * 4 + 0] = a.x; wq[j][e4 * 4 + 1] = a.y; wq[j][e4 * 4 + 2] = a.z; wq[j][e4 * 4 + 3] = a.w;
                wk[j][e4 * 4 + 0] = c.x; wk[j][e4 * 4 + 1] = c.y; wk[j][e4 * 4 + 2] = c.z; wk[j][e4 * 4 + 3] = c.w;
            }
#pragma unroll 1
        for (int i = 0; i < 4; ++i) {
            const int t = tb + 32 * i, row = row0 + t;
            const bf16_t* pr = P.p + (size_t)row * PN;
            const bool hasL = !(t == 0 && segstart), hasR = !(t == 127 && segend);
            unsigned zz = 0u; asm volatile("" : "+v"(zz)); u32x4 z; z.x = zz; z.y = zz; z.z = zz; z.w = zz;
            const u32x4 q0 = hasL ? *(const u32x4*)(pr - PN + P_MLQ + qc) : z, q1 = *(const u32x4*)(pr + P_MLQ + qc), q2 = hasR ? *(const u32x4*)(pr + PN + P_MLQ + qc) : z;
            const u32x4 k0 = hasL ? *(const u32x4*)(pr - PN + P_MLK + qc) : z, k1 = *(const u32x4*)(pr + P_MLK + qc), k2 = hasR ? *(const u32x4*)(pr + PN + P_MLK + qc) : z;
            const u32x4 vv = *(const u32x4*)(pr + P_MLV + qc);
            float a0[8], a1[8], a2[8], r[8];
            unpack8(q0, a0); unpack8(q1, a1); unpack8(q2, a2);
#pragma unroll
            for (int e = 0; e < 8; ++e) r[e] = siluf(wq[0][e] * a0[e] + wq[1][e] * a1[e] + wq[2][e] * a2[e]);
            *(u32x4*)(P.qk + (size_t)row * 1024 + qc) = pack8(r);
            unpack8(k0, a0); unpack8(k1, a1); unpack8(k2, a2);
#pragma unroll
            for (int e = 0; e < 8; ++e) r[e] = siluf(wk[0][e] * a0[e] + wk[1][e] * a1[e] + wk[2][e] * a2[e]);
            const u32x4 kp = pack8(r);
            *(u32x4*)(P.qk + (size_t)row * 1024 + 512 + qc) = kp;
            *(LAS u32x4*)(Kt + t * TS + c8 * 16) = kp;
            unpack8(vv, a0);
            const float ef = sc[512 + t], eb = sc[640 + t];
#pragma unroll
            for (int e = 0; e < 8; ++e) { a1[e] = a0[e] * ef; a2[e] = a0[e] * eb; }
            *(LAS u32x4*)(Vf + t * TS + c8 * 16) = pack8(a1);
            *(LAS u32x4*)(Vb + t * TS + c8 * 16) = pack8(a2);
        }
    }
    __syncthreads();
    unsigned char* imgf = (unsigned char*)P.ml_ck + ((size_t)(sq0 + 0) * 66 + pc) * ML_IMG;
    unsigned char* imgb = (unsigned char*)P.ml_ck + ((size_t)(sq0 + 1) * 66 + pc) * ML_IMG;
    {
        const int g = lane >> 4, fr = lane & 15, q4 = fr >> 2, p4 = lane & 3;
        f32x4 accf[8], accb[8];
#pragma unroll
        for (int n = 0; n < 8; ++n) { accf[n] = (f32x4){0.f, 0.f, 0.f, 0.f}; accb[n] = (f32x4){0.f, 0.f, 0.f, 0.f}; }
        const unsigned kb = lds_addr(Kt), vfb = lds_addr(Vf), vbb = lds_addr(Vb);
#pragma unroll 1
        for (int ks = 0; ks < 4; ++ks) {
            const unsigned ro = (unsigned)((32 * ks + 8 * g + q4) * TS + 8 * p4);
            const bf16x8 af = tr_read1<4 * TS>(vfb + ro + wid * 32), ab = tr_read1<4 * TS>(vbb + ro + wid * 32);
            bf16x8 bfr[8];
            tr_read4<4 * TS, 32>(kb + ro, bfr[0], bfr[1], bfr[2], bfr[3]);
            tr_read4<4 * TS, 32>(kb + ro + 128, bfr[4], bfr[5], bfr[6], bfr[7]);
#pragma unroll
            for (int n = 0; n < 8; ++n) { accf[n] = MFMA16(af, bfr[n], accf[n]); accb[n] = MFMA16(ab, bfr[n], accb[n]); }
        }
#pragma unroll
        for (int n = 0; n < 8; ++n) {
            const int k = 16 * n + fr, v0 = 16 * wid + 4 * g;
            u32x2 o; o.x = pk2(accf[n][0], accf[n][1]); o.y = pk2(accf[n][2], accf[n][3]); *(u32x2*)(imgf + k * TS + v0 * 2) = o;
            o.x = pk2(accb[n][0], accb[n][1]); o.y = pk2(accb[n][2], accb[n][3]); *(u32x2*)(imgb + k * TS + v0 * 2) = o;
        }
    }
    {
        const int k = tid & 127, part = tid >> 7; float nf = 0.f, nb = 0.f;
#pragma unroll 8
        for (int s = part * 32; s < part * 32 + 32; ++s) { const float kv = bf2f(*(LAS bf16_t*)(Kt + s * TS + k * 2)); nf += sc[512 + s] * kv; nb += sc[640 + s] * kv; }
        red[(part * 2 + 0) * 128 + k] = nf; red[(part * 2 + 1) * 128 + k] = nb;
    }
    __syncthreads();
    if (tid < 256) {
        const int dir = tid >> 7, k = tid & 127;
        const float n = red[(0 * 2 + dir) * 128 + k] + red[(1 * 2 + dir) * 128 + k] + red[(2 * 2 + dir) * 128 + k] + red[(3 * 2 + dir) * 128 + k];
        unsigned zz = 0u; asm volatile("" : "+v"(zz));
        u32x4 o; o.x = pk2(n, 0.f); o.y = zz; o.z = zz; o.w = zz;
        *(u32x4*)((dir ? imgb : imgf) + k * TS + 256) = o;
    }
    __syncthreads();
}

__device__ __forceinline__ void gla_gates(const Params& P, LAS float* alr  , LAS float* segtot  , int l, int h, int tid, float (&bF)[16], float (&bB)[16], float& totF, float& totB) {
    const int k = tid & 63, seg = tid >> 6;
    const float* w2 = P.w_gla_a2 + (size_t)l * 2 * 16 * 256; const float* ba = P.b_gla_a + (size_t)l * 2 * 256;
    float wf[16], wb[16];
#pragma unroll
    for (int r = 0; r < 16; ++r) { wf[r] = w2[(0 * 16 + r) * 256 + h * 64 + k]; wb[r] = w2[(1 * 16 + r) * 256 + h * 64 + k]; }
    const float baf = ba[h * 64 + k], bab = ba[256 + h * 64 + k];
#pragma unroll
    for (int tt = 0; tt < 16; ++tt) {
        const LAS float* ar = alr + (seg * 16 + tt) * 32;
        float xf = baf, xb = bab;
#pragma unroll
        for (int r = 0; r < 16; ++r) { xf += ar[r] * wf[r]; xb += ar[16 + r] * wb[r]; }
        bF[tt] = logsigmoidf(xf) * (1.f / 16.f); bB[tt] = logsigmoidf(xb) * (1.f / 16.f);
    }
#pragma unroll
    for (int tt = 1; tt < 16; ++tt) bF[tt] += bF[tt - 1];
#pragma unroll
    for (int tt = 14; tt >= 0; --tt) bB[tt] += bB[tt + 1];
    segtot[(0 * 8 + seg) * 64 + k] = bF[15]; segtot[(1 * 8 + seg) * 64 + k] = bB[0];
    __syncthreads();
    float offF = 0.f, offB = 0.f; totF = 0.f; totB = 0.f;
#pragma unroll
    for (int s2 = 0; s2 < 8; ++s2) { const float a = segtot[(0 * 8 + s2) * 64 + k], c = segtot[(1 * 8 + s2) * 64 + k]; totF += a; totB += c; offF += (s2 < seg) ? a : 0.f; offB += (s2 > seg) ? c : 0.f; }
#pragma unroll
    for (int tt = 0; tt < 16; ++tt) { bF[tt] += offF; bB[tt] += offB; }
}
__device__ __forceinline__ void gla_stage_alr(const Params& P, LAS float* alr, int row0, int tid) {
    const int t = tid >> 2, part = tid & 3;
    const float* src = P.pga + (size_t)(row0 + t) * GA + 16 + part * 8;
    const f32x4 a = *(const f32x4*)src, c = *(const f32x4*)(src + 4);
    *(LAS f32x4*)(alr + t * 32 + part * 8) = a; *(LAS f32x4*)(alr + t * 32 + part * 8 + 4) = c;
}

__device__ __forceinline__ void ma_gla(const Params& P, LAS unsigned char* lds, int l, int b, int h, int pc) {
    const int tid = ltid(), lane = tid & 63, wid = __builtin_amdgcn_readfirstlane(tid >> 6);
    LAS unsigned char* Vt = lds; LAS unsigned char* Kdf = lds + 34816; LAS unsigned char* Kdb = lds + 53248;
    LAS float* alr = (LAS float*)(lds + 71680); LAS float* segtot = (LAS float*)(lds + 88064);
    const int row0 = chunk_row0(b, pc), sq0 = (b * 4 + h) * 2;
    gla_stage_alr(P, alr, row0, tid);
#pragma unroll
    for (int i = 0; i < 4; ++i) { const int id = tid + 512 * i, t = id >> 4, c = id & 15; *(LAS u32x4*)(Vt + t * TS + c * 16) = *(const u32x4*)(P.p + (size_t)(row0 + t) * PN + P_GV + h * 128 + c * 8); }
    __syncthreads();
    {
        float bF[16], bB[16], totF, totB;
        gla_gates(P, alr, segtot, l, h, tid, bF, bB, totF, totB);
        const int k = tid & 63, seg = tid >> 6;
#pragma unroll
        for (int tt = 0; tt < 16; ++tt) {
            const int t = seg * 16 + tt;
            const float kr = bf2f(P.p[(size_t)(row0 + t) * PN + P_GK + h * 64 + k]);
            const unsigned pf = pk2(kr * __expf(totF - bF[tt]), kr * __expf(totB - bB[tt]));
            *(LAS bf16_t*)(Kdf + t * TS64 + k * 2) = (bf16_t)(pf & 0xffffu); *(LAS bf16_t*)(Kdb + t * TS64 + k * 2) = (bf16_t)(pf >> 16);
        }
        if (seg == 0) { P.gbend[((size_t)(sq0 + 0) * 66 + pc) * 64 + k] = totF; P.gbend[((size_t)(sq0 + 1) * 66 + pc) * 64 + k] = totB; }
    }
    __syncthreads();
    unsigned char* imgf = (unsigned char*)P.gl_ck + ((size_t)(sq0 + 0) * 66 + pc) * GL_IMG;
    unsigned char* imgb = (unsigned char*)P.gl_ck + ((size_t)(sq0 + 1) * 66 + pc) * GL_IMG;
    {
        const int g = lane >> 4, fr = lane & 15, q4 = fr >> 2, p4 = lane & 3;
        f32x4 accf[4], accb[4];
#pragma unroll
        for (int n = 0; n < 4; ++n) { accf[n] = (f32x4){0.f, 0.f, 0.f, 0.f}; accb[n] = (f32x4){0.f, 0.f, 0.f, 0.f}; }
        const unsigned vb = lds_addr(Vt), kfb = lds_addr(Kdf), kbb = lds_addr(Kdb);
#pragma unroll 1
        for (int ks = 0; ks < 4; ++ks) {
            const int rr = 32 * ks + 8 * g + q4;
            const bf16x8 a = tr_read1<4 * TS>(vb + (unsigned)(rr * TS + 8 * p4) + wid * 32);
            bf16x8 bf[4], bb[4];
            tr_read4<4 * TS64, 32>(kfb + (unsigned)(rr * TS64 + 8 * p4), bf[0], bf[1], bf[2], bf[3]);
            tr_read4<4 * TS64, 32>(kbb + (unsigned)(rr * TS64 + 8 * p4), bb[0], bb[1], bb[2], bb[3]);
#pragma unroll
            for (int n = 0; n < 4; ++n) { accf[n] = MFMA16(a, bf[n], accf[n]); accb[n] = MFMA16(a, bb[n], accb[n]); }
        }
#pragma unroll
        for (int n = 0; n < 4; ++n) {
            const int k = 16 * n + fr, v0 = 16 * wid + 4 * g;
            u32x2 o; o.x = pk2(accf[n][0], accf[n][1]); o.y = pk2(accf[n][2], accf[n][3]); *(u32x2*)(imgf + k * TS + v0 * 2) = o;
            o.x = pk2(accb[n][0], accb[n][1]); o.y = pk2(accb[n][2], accb[n][3]); *(u32x2*)(imgb + k * TS + v0 * 2) = o;
        }
    }
    if (tid < 128) { const int dir = tid >> 6, k = tid & 63; unsigned zz = 0u; asm volatile("" : "+v"(zz)); u32x4 o; o.x = zz; o.y = zz; o.z = zz; o.w = zz; *(u32x4*)((dir ? imgb : imgf) + k * TS + 256) = o; }
    __syncthreads();
}

__device__ __forceinline__ void phase_mix_a(const Params& P, LAS unsigned char* lds, int l, int wg, int nwg) {
    for (int it = wg; it < 2 * 8 * 66; it += nwg) {
        const int mixer = it / 528, r = it % 528, bh = r / 66, pc = r % 66;
        if (mixer == 0) ma_mlstm(P, lds, l, bh >> 2, bh & 3, pc); else ma_gla(P, lds, l, bh >> 2, bh & 3, pc);
    }
}

__device__ __forceinline__ void phase_mix_b(const Params& P, int wg, int nwg) {
    constexpr int MLC = ML_IMG / 16, GLC = GL_IMG / 16;
    const int gt = wg * NTHR + ltid(), ngt = nwg * NTHR;
    for (int task = gt; task < 16 * (MLC + GLC); task += ngt) {
        float st[8];
#pragma unroll
        for (int e = 0; e < 8; ++e) st[e] = 0.f;
        if (task < 16 * MLC) {
            const int sq = task / MLC, ci = task % MLC, dir = sq & 1;
            const unsigned char* src = (const unsigned char*)P.ml_ck + (size_t)sq * 66 * ML_IMG + ci * 16;
            unsigned char* dst = (unsigned char*)P.ml_pre + (size_t)sq * 66 * ML_IMG + ci * 16;
            const float* ms = P.mstat + (size_t)sq * 66 * 2;
            float m = 0.f;
#pragma unroll 1
            for (int j0 = 0; j0 < 66; j0 += 11) {
                u32x4 cv[11]; float be[11], mk[11];
#pragma unroll
                for (int u = 0; u < 11; ++u) { const int pc = virt_pc(dir, j0 + u); cv[u] = *(const u32x4*)(src + (size_t)pc * ML_IMG); be[u] = ms[pc * 2]; mk[u] = ms[pc * 2 + 1]; }
#pragma unroll
                for (int u = 0; u < 11; ++u) {
                    const int pc = virt_pc(dir, j0 + u);
                    *(u32x4*)(dst + (size_t)pc * ML_IMG) = pack8(st);
                    if (ci == 0) P.mprev[sq * 66 + pc] = m;
                    const float mn = fmaxf(be[u] + m, mk[u]), ao = __expf(be[u] + m - mn), an = __expf(mk[u] - mn);
                    float c[8]; unpack8(cv[u], c);
#pragma unroll
                    for (int e = 0; e < 8; ++e) st[e] = ao * st[e] + an * c[e];
                    m = mn;
                }
            }
        } else {
            const int t2 = task - 16 * MLC, sq = t2 / GLC, ci = t2 % GLC, dir = sq & 1, k = (ci * 16) / TS;
            const unsigned char* src = (const unsigned char*)P.gl_ck + (size_t)sq * 66 * GL_IMG + ci * 16;
            unsigned char* dst = (unsigned char*)P.gl_pre + (size_t)sq * 66 * GL_IMG + ci * 16;
            const float* gb = P.gbend + (size_t)sq * 66 * 64 + k;
#pragma unroll 1
            for (int j0 = 0; j0 < 66; j0 += 11) {
                u32x4 cv[11]; float be[11];
#pragma unroll
                for (int u = 0; u < 11; ++u) { const int pc = virt_pc(dir, j0 + u); cv[u] = *(const u32x4*)(src + (size_t)pc * GL_IMG); be[u] = gb[pc * 64]; }
#pragma unroll
                for (int u = 0; u < 11; ++u) {
                    const int pc = virt_pc(dir, j0 + u);
                    *(u32x4*)(dst + (size_t)pc * GL_IMG) = pack8(st);
                    const float dc = __expf(be[u]);
                    float c[8]; unpack8(cv[u], c);
#pragma unroll
                    for (int e = 0; e < 8; ++e) st[e] = dc * st[e] + c[e];
                }
            }
        }
    }
}

__device__ __forceinline__ void mc_mlstm(const Params& P, LAS unsigned char* lds, int l, int b, int h, int pc) {
    const int tid = ltid(), lane = tid & 63, wid = __builtin_amdgcn_readfirstlane(tid >> 6);
    const int g = lane >> 4, fr = lane & 15, q4 = fr >> 2, p4 = lane & 3;
    LAS unsigned char* Qt = lds; LAS unsigned char* Kt = lds + 34816; LAS unsigned char* V1 = lds + 69632; LAS unsigned char* CT = lds + 108544;
    LAS float* sc = (LAS float*)(lds + 143488);
    const int row0 = chunk_row0(b, pc), sq0 = (b * 4 + h) * 2;
    const float scale = 0.08838834764831845f;
    if (tid < 128) {
        const float* ga = P.pga + (size_t)(row0 + tid) * GA; const float* bg = P.b_ml_gates + l * 16;
        sc[tid] = ga[h] + bg[h]; sc[128 + tid] = logsigmoidf(ga[4 + h] + bg[4 + h]); sc[256 + tid] = ga[8 + h] + bg[8 + h]; sc[384 + tid] = logsigmoidf(ga[12 + h] + bg[12 + h]);
        unsigned zz = 0u; asm volatile("" : "+v"(zz));
        u32x4 o; o.x = zz | 0x00003F80u; o.y = zz; o.z = zz; o.w = zz;
        *(LAS u32x4*)(V1 + tid * VS + 256) = o; o.x = zz; *(LAS u32x4*)(V1 + tid * VS + 272) = o; *(LAS u32x4*)(V1 + tid * VS + 288) = o;
    }
#pragma unroll
    for (int i = 0; i < 4; ++i) {
        const int id = tid + 512 * i, t = id >> 4, c = id & 15;
        *(LAS u32x4*)(Qt + t * TS + c * 16) = *(const u32x4*)(P.qk + (size_t)(row0 + t) * 1024 + h * 128 + c * 8);
        *(LAS u32x4*)(Kt + t * TS + c * 16) = *(const u32x4*)(P.qk + (size_t)(row0 + t) * 1024 + 512 + h * 128 + c * 8);
        *(LAS u32x4*)(V1 + t * VS + c * 16) = *(const u32x4*)(P.p + (size_t)(row0 + t) * PN + P_MLV + h * 128 + c * 8);
    }
    {
        const unsigned char* img = (const unsigned char*)P.ml_pre + ((size_t)(sq0 + 0) * 66 + pc) * ML_IMG;
        for (int id = tid; id < ML_IMG / 16; id += NTHR) *(LAS u32x4*)(CT + id * 16) = *(const u32x4*)(img + id * 16);
    }
    __syncthreads();
    if (wid < 2) {
        const int dir = wid; LAS float* li = sc + dir * 256; LAS float* lf = li + 128; LAS float* o = sc + (4 + 4 * dir) * 128;
        const int t0 = dir ? 127 - 2 * lane : 2 * lane, t1 = dir ? 126 - 2 * lane : 2 * lane + 1;
        const float x0 = lf[t0], x1 = lf[t1];
        const float incl = wave_incl_sum(x0 + x1, lane);
        const float b0 = incl - x1, b1 = incl;
        const float g0 = li[t0] - b0, g1 = li[t1] - b1;
        const float pmx = wave_incl_max(fmaxf(g0, g1), lane);
        float pex = __shfl_up(pmx, 1); if (lane == 0) pex = -3.0e38f;
        const float pm0 = fmaxf(pex, g0), pm1 = pmx;
        const float mp = P.mprev[(sq0 + dir) * 66 + pc];
        const float m0 = fmaxf(b0 + mp, b0 + pm0), m1 = fmaxf(b1 + mp, b1 + pm1);
        o[t0] = b0 - m0; o[128 + t0] = g0; o[256 + t0] = __expf(b0 + mp - m0); o[384 + t0] = __expf(-m0);
        o[t1] = b1 - m1; o[128 + t1] = g1; o[256 + t1] = __expf(b1 + mp - m1); o[384 + t1] = __expf(-m1);
    }
    __syncthreads();
    bf16x8 qf[4];
#pragma unroll
    for (int kk = 0; kk < 4; ++kk) qf[kk] = *(const LAS bf16x8*)(Qt + (16 * wid + fr) * TS + (32 * kk + 8 * g) * 2);
    f32x4 hsum[8];
#pragma unroll
    for (int n = 0; n < 8; ++n) hsum[n] = (f32x4){0.f, 0.f, 0.f, 0.f};
    const unsigned ctb = lds_addr(CT), v1b = lds_addr(V1);
    const int tq = 16 * wid + fr;
#pragma unroll 1
    for (int dir = 0; dir < 2; ++dir) {
        if (dir == 1) {
            __syncthreads();
            const unsigned char* img = (const unsigned char*)P.ml_pre + ((size_t)(sq0 + 1) * 66 + pc) * ML_IMG;
            for (int id = tid; id < ML_IMG / 16; id += NTHR) *(LAS u32x4*)(CT + id * 16) = *(const u32x4*)(img + id * 16);
            __syncthreads();
        }
        LAS float* so = sc + (4 + 4 * dir) * 128;
        f32x4 acc[9];
#pragma unroll
        for (int n = 0; n < 9; ++n) acc[n] = (f32x4){0.f, 0.f, 0.f, 0.f};
#pragma unroll
        for (int kk = 0; kk < 4; ++kk) {
            const unsigned ro = ctb + (unsigned)((32 * kk + 8 * g + q4) * TS + 8 * p4);
            bf16x8 bfr[9];
            tr_read4<4 * TS, 32>(ro, bfr[0], bfr[1], bfr[2], bfr[3]);
            tr_read4<4 * TS, 32>(ro + 128, bfr[4], bfr[5], bfr[6], bfr[7]);
            bfr[8] = tr_read1<4 * TS>(ro + 256);
#pragma unroll
            for (int n = 0; n < 9; ++n) acc[n] = MFMA16(qf[kk], bfr[n], acc[n]);
        }
#pragma unroll
        for (int j = 0; j < 4; ++j) { const float as = so[256 + 16 * wid + 4 * g + j] * scale;
#pragma unroll
            for (int n = 0; n < 9; ++n) acc[n][j] *= as; }
        const float ut = so[tq];
        const int ilo = dir ? (wid >> 1) : 0, ihi = dir ? 3 : (wid >> 1);
#pragma unroll 1
        for (int i = ilo; i <= ihi; ++i) {
            unsigned pw[4];
#pragma unroll
            for (int half = 0; half < 2; ++half) {
                const int sb = 2 * i + half;
                f32x4 d = (f32x4){0.f, 0.f, 0.f, 0.f};
#pragma unroll
                for (int kk = 0; kk < 4; ++kk) { const bf16x8 kf = *(const LAS bf16x8*)(Kt + (16 * sb + fr) * TS + (32 * kk + 8 * g) * 2); d = MFMA16(kf, qf[kk], d); }
                float pv[4];
#pragma unroll
                for (int j = 0; j < 4; ++j) {
                    const int s = 16 * sb + 4 * g + j;
                    const bool valid = dir ? (s >= tq) : (s <= tq);
                    const float arg = ut + so[128 + s];
                    pv[j] = valid ? d[j] * scale * __expf(arg) : 0.f;
                }
                pw[half * 2 + 0] = pk2(pv[0], pv[1]); pw[half * 2 + 1] = pk2(pv[2], pv[3]);
            }
            u32x4 pu; pu.x = pw[0]; pu.y = pw[1]; pu.z = pw[2]; pu.w = pw[3];
            const bf16x8 pa = __builtin_bit_cast(bf16x8, pu);
            const unsigned ro = v1b + (unsigned)((32 * i + 4 * g + q4) * VS + 8 * p4);
            bf16x8 bfr[9];
            tr_read4<16 * VS, 32>(ro, bfr[0], bfr[1], bfr[2], bfr[3]);
            tr_read4<16 * VS, 32>(ro + 128, bfr[4], bfr[5], bfr[6], bfr[7]);
            bfr[8] = tr_read1<16 * VS>(ro + 256);
#pragma unroll
            for (int n = 0; n < 9; ++n) acc[n] = MFMA16(pa, bfr[n], acc[n]);
        }
#pragma unroll
        for (int j = 0; j < 4; ++j) {
            const float den = __shfl(acc[8][j], lane & 48);
            const float dn = fmaxf(fabsf(den), so[384 + 16 * wid + 4 * g + j]);
            const float inv = 1.f / dn;
#pragma unroll
            for (int n = 0; n < 8; ++n) hsum[n][j] += acc[n][j] * inv;
        }
    }
    const float* gml = P.g_ml_norm + l * 512 + h * 128;
#pragma unroll
    for (int j = 0; j < 4; ++j) {
        float ss = 0.f;
#pragma unroll
        for (int n = 0; n < 8; ++n) ss += hsum[n][j] * hsum[n][j];
        ss += __shfl_xor(ss, 1); ss += __shfl_xor(ss, 2); ss += __shfl_xor(ss, 4); ss += __shfl_xor(ss, 8);
        const float rstd = rsqrtf(ss * (1.f / 128.f) + EPS);
        const int row = row0 + 16 * wid + 4 * g + j;
#pragma unroll
        for (int n = 0; n < 8; ++n) {
            const int v = 16 * n + fr;
            const float og = sigmoidf(bf2f(P.p[(size_t)row * PN + P_MLO + h * 128 + v]));
            P.abuf[(size_t)row * 1024 + h * 128 + v] = (bf16_t)(pk2(hsum[n][j] * rstd * gml[v] * og, 0.f) & 0xffffu);
        }
    }
    __syncthreads();
}

__device__ __forceinline__ void mc_gla(const Params& P, LAS unsigned char* lds, int l, int b, int h, int pc) {
    const int tid = ltid(), lane = tid & 63, wid = __builtin_amdgcn_readfirstlane(tid >> 6);
    const int g = lane >> 4, fr = lane & 15, q4 = fr >> 2, p4 = lane & 3;
    LAS unsigned char* Qf = lds; LAS unsigned char* Kf = lds + 18432; LAS unsigned char* Qb = lds + 36864; LAS unsigned char* Kb = lds + 55296;
    LAS unsigned char* Vt = lds + 73728; LAS unsigned char* Sf = lds + 108544; LAS unsigned char* Sb = lds + 126080;
    LAS float* segtot = (LAS float*)(lds + 143616);
    LAS float* alr = (LAS float*)Sf;
    const int row0 = chunk_row0(b, pc), sq0 = (b * 4 + h) * 2;
    gla_stage_alr(P, alr, row0, tid);
    __syncthreads();
    {
        float bF[16], bB[16], totF, totB;
        gla_gates(P, alr, segtot, l, h, tid, bF, bB, totF, totB);
        const int k = tid & 63, seg = tid >> 6;
#pragma unroll
        for (int tt = 0; tt < 16; ++tt) {
            const int t = seg * 16 + tt;
            const float qr = bf2f(P.p[(size_t)(row0 + t) * PN + P_GQ + h * 64 + k]) * 0.125f, kr = bf2f(P.p[(size_t)(row0 + t) * PN + P_GK + h * 64 + k]);
            const unsigned a = pk2(qr * __expf(bF[tt]), kr * __expf(-bF[tt])), c = pk2(qr * __expf(bB[tt]), kr * __expf(-bB[tt]));
            *(LAS bf16_t*)(Qf + t * TS64 + k * 2) = (bf16_t)(a & 0xffffu); *(LAS bf16_t*)(Kf + t * TS64 + k * 2) = (bf16_t)(a >> 16);
            *(LAS bf16_t*)(Qb + t * TS64 + k * 2) = (bf16_t)(c & 0xffffu); *(LAS bf16_t*)(Kb + t * TS64 + k * 2) = (bf16_t)(c >> 16);
        }
    }
    __syncthreads();
#pragma unroll
    for (int i = 0; i < 4; ++i) { const int id = tid + 512 * i, t = id >> 4, c = id & 15; *(LAS u32x4*)(Vt + t * TS + c * 16) = *(const u32x4*)(P.p + (size_t)(row0 + t) * PN + P_GV + h * 128 + c * 8); }
    {
        const unsigned char* i0 = (const unsigned char*)P.gl_pre + ((size_t)(sq0 + 0) * 66 + pc) * GL_IMG;
        const unsigned char* i1 = (const unsigned char*)P.gl_pre + ((size_t)(sq0 + 1) * 66 + pc) * GL_IMG;
        for (int id = tid; id < GL_IMG / 16; id += NTHR) { *(LAS u32x4*)(Sf + id * 16) = *(const u32x4*)(i0 + id * 16); *(LAS u32x4*)(Sb + id * 16) = *(const u32x4*)(i1 + id * 16); }
    }
    __syncthreads();
    f32x4 acc[8];
#pragma unroll
    for (int n = 0; n < 8; ++n) acc[n] = (f32x4){0.f, 0.f, 0.f, 0.f};
    const unsigned vtb = lds_addr(Vt);
    const int tq = 16 * wid + fr;
#pragma unroll 1
    for (int dir = 0; dir < 2; ++dir) {
        LAS unsigned char* Qd = dir ? Qb : Qf; LAS unsigned char* Kd = dir ? Kb : Kf;
        const unsigned sb_ = lds_addr(dir ? Sb : Sf);
        bf16x8 qf[2];
#pragma unroll
        for (int kk = 0; kk < 2; ++kk) qf[kk] = *(const LAS bf16x8*)(Qd + (16 * wid + fr) * TS64 + (32 * kk + 8 * g) * 2);
#pragma unroll
        for (int kk = 0; kk < 2; ++kk) {
            const unsigned ro = sb_ + (unsigned)((32 * kk + 8 * g + q4) * TS + 8 * p4);
            bf16x8 bfr[8];
            tr_read4<4 * TS, 32>(ro, bfr[0], bfr[1], bfr[2], bfr[3]);
            tr_read4<4 * TS, 32>(ro + 128, bfr[4], bfr[5], bfr[6], bfr[7]);
#pragma unroll
            for (int n = 0; n < 8; ++n) acc[n] = MFMA16(qf[kk], bfr[n], acc[n]);
        }
        const int ilo = dir ? (wid >> 1) : 0, ihi = dir ? 3 : (wid >> 1);
#pragma unroll 1
        for (int i = ilo; i <= ihi; ++i) {
            unsigned pw[4];
#pragma unroll
            for (int half = 0; half < 2; ++half) {
                const int sb = 2 * i + half;
                f32x4 d = (f32x4){0.f, 0.f, 0.f, 0.f};
#pragma unroll
                for (int kk = 0; kk < 2; ++kk) { const bf16x8 kf = *(const LAS bf16x8*)(Kd + (16 * sb + fr) * TS64 + (32 * kk + 8 * g) * 2); d = MFMA16(kf, qf[kk], d); }
                float pv[4];
#pragma unroll
                for (int j = 0; j < 4; ++j) { const int s = 16 * sb + 4 * g + j; const bool valid = dir ? (s >= tq) : (s <= tq); pv[j] = valid ? d[j] : 0.f; }
                pw[half * 2 + 0] = pk2(pv[0], pv[1]); pw[half * 2 + 1] = pk2(pv[2], pv[3]);
            }
            u32x4 pu; pu.x = pw[0]; pu.y = pw[1]; pu.z = pw[2]; pu.w = pw[3];
            const bf16x8 pa = __builtin_bit_cast(bf16x8, pu);
            const unsigned ro = vtb + (unsigned)((32 * i + 4 * g + q4) * TS + 8 * p4);
            bf16x8 bfr[8];
            tr_read4<16 * TS, 32>(ro, bfr[0], bfr[1], bfr[2], bfr[3]);
            tr_read4<16 * TS, 32>(ro + 128, bfr[4], bfr[5], bfr[6], bfr[7]);
#pragma unroll
            for (int n = 0; n < 8; ++n) acc[n] = MFMA16(pa, bfr[n], acc[n]);
        }
    }
    const float* ggl = P.g_gla_norm + l * 512 + h * 128;
#pragma unroll
    for (int j = 0; j < 4; ++j) {
        float ss = 0.f;
#pragma unroll
        for (int n = 0; n < 8; ++n) ss += acc[n][j] * acc[n][j];
        ss += __shfl_xor(ss, 1); ss += __shfl_xor(ss, 2); ss += __shfl_xor(ss, 4); ss += __shfl_xor(ss, 8);
        const float rstd = rsqrtf(ss * (1.f / 128.f) + EPS);
        const int row = row0 + 16 * wid + 4 * g + j;
#pragma unroll
        for (int n = 0; n < 8; ++n) {
            const int v = 16 * n + fr;
            const float rg = siluf(bf2f(P.p[(size_t)row * PN + P_GR + h * 128 + v]));
            P.abuf[(size_t)row * 1024 + 512 + h * 128 + v] = (bf16_t)(pk2(acc[n][j] * rstd * ggl[v] * rg, 0.f) & 0xffffu);
        }
    }
    __syncthreads();
}

__device__ __forceinline__ void phase_mix_c(const Params& P, LAS unsigned char* lds, int l, int pc0, int wg, int nwg) {
    const int npc = 66 - pc0, per = 8 * npc;
    for (int it = wg; it < 2 * per; it += nwg) {
        const int mixer = it / per, r = it % per, bh = r / npc, pc = pc0 + r % npc;
        if (mixer == 0) mc_mlstm(P, lds, l, bh >> 2, bh & 3, pc); else mc_gla(P, lds, l, bh >> 2, bh & 3, pc);
    }
}


#define XB_TMO      128
#define XB_XCNT(j)  (256  + 64 * (j))
#define XB_XSUB(j)  (1280 + 64 * (j))
#define XB_XGEN(j)  (2304 + 64 * (j))
#define XB_TOP      3328
#define XB_TOPGEN   3392
#define XCD_BAR_WORDS 3456
#define XB_SPIN_CAP (1u << 22)
__device__ __forceinline__ unsigned xb_ld(unsigned* p)              { return __hip_atomic_load(p, __ATOMIC_RELAXED, __HIP_MEMORY_SCOPE_AGENT); }
__device__ __forceinline__ unsigned xb_add(unsigned* p, unsigned v) { return __hip_atomic_fetch_add(p, v, __ATOMIC_RELAXED, __HIP_MEMORY_SCOPE_AGENT); }
__device__ __forceinline__ unsigned xb_xcc_id() { return (unsigned)__builtin_amdgcn_s_getreg((3 << 11) | 20) & 0xFu; }
#define XB_SPIN(cond, bar) do { unsigned _sp = 0; while (cond) { __builtin_amdgcn_s_sleep(1); \
    if ((++_sp & 255u) == 0u) { if (xb_ld(&(bar)[XB_TMO])) break; if (_sp > XB_SPIN_CAP) { atomicAdd(&(bar)[XB_TMO], 1u); break; } } } } while (0)
struct XcdBarrier { unsigned* bar; unsigned x; volatile LAS unsigned* st; };
__device__ __forceinline__ XcdBarrier xcd_barrier_post(unsigned* bar, volatile LAS unsigned* st) {
    XcdBarrier b; b.bar = bar; b.x = xb_xcc_id(); b.st = st;
    if (threadIdx.x == 0) (void)xb_add(&bar[XB_XCNT(b.x)], 1u);
    return b;
}
__device__ __forceinline__ void xcd_barrier_complete(unsigned* bar, unsigned x, unsigned& nloc, unsigned& nx) {
    const unsigned G = gridDim.x * gridDim.y * gridDim.z;
    unsigned sum, cnt, mine, sp = 0u;
    for (;;) {
        sum = 0u; cnt = 0u; mine = 0u;
#pragma unroll
        for (unsigned j = 0; j < 16; ++j) { const unsigned c = xb_ld(&bar[XB_XCNT(j)]); sum += c; cnt += (c > 0u) ? 1u : 0u; mine = (j == x) ? c : mine; }
        if (sum == G) break;
        __builtin_amdgcn_s_sleep(1);
        if ((++sp & 255u) == 0u) { if (xb_ld(&bar[XB_TMO])) break; if (sp > XB_SPIN_CAP) { atomicAdd(&bar[XB_TMO], 1u); break; } }
    }
    nloc = mine > 0u ? mine : 1u; nx = cnt > 0u ? cnt : 1u;
}
__device__ __forceinline__ void xcd_barrier(const XcdBarrier& b) {
    asm volatile("s_waitcnt vmcnt(0)" ::: "memory");
    __syncthreads();
    if (threadIdx.x == 0) {
        unsigned* bar = b.bar;
        unsigned bx = b.x; asm volatile("" : "+v"(bx));
        __builtin_amdgcn_s_waitcnt(0);
        unsigned nloc = b.st[0], nx = b.st[1];
        if (nloc == 0u) { xcd_barrier_complete(bar, bx, nloc, nx); b.st[0] = nloc; b.st[1] = nx; }
        const unsigned old = xb_add(&bar[XB_XSUB(bx)], 1u);
        const unsigned gen = old / nloc;
        if (old + 1u == (gen + 1u) * nloc) {
            __builtin_amdgcn_fence(__ATOMIC_RELEASE, "agent");
            asm volatile("s_waitcnt vmcnt(0)" ::: "memory");
            const unsigned og = xb_add(&bar[XB_TOP], 1u);
            const unsigned tg = og / nx;
            if (og + 1u == (tg + 1u) * nx) xb_add(&bar[XB_TOPGEN], 1u);
            else XB_SPIN(xb_ld(&bar[XB_TOPGEN]) == tg, bar);
            __builtin_amdgcn_fence(__ATOMIC_ACQUIRE, "agent");
            xb_add(&bar[XB_XGEN(bx)], 1u);
            asm volatile("s_waitcnt vmcnt(0)" ::: "memory");
        } else {
            XB_SPIN(xb_ld(&bar[XB_XGEN(bx)]) == gen, bar);
            __builtin_amdgcn_fence(__ATOMIC_ACQUIRE, "agent");
            asm volatile("s_waitcnt vmcnt(0)" ::: "memory");
        }
    }
    __syncthreads();
}

__device__ __forceinline__ void topk_list(const Params& P, LAS unsigned char* lds, int list) {
    LAS unsigned* keys = (LAS unsigned*)lds;
    LAS unsigned* hist = keys + 8192;
    LAS unsigned* ctl = hist + 256;
    LAS unsigned* wsum = ctl + 4;
    const int tid = ltid(), lane = tid & 63, wid = tid >> 6;
    const int isctx = list >= 32, b = (list & 31) >> 4, e = list & 15;
    const int n = isctx ? CTX : SEQ, cap = n / 8;
    const int row0 = isctx ? NLAT + b * CTX : b * SEQ;
    const int segoff = isctx ? 2048 + b * 32 : b * 1024;
    for (int i = tid; i < n; i += NTHR) keys[i] = __float_as_uint(P.aff[(size_t)(row0 + i) * 16 + e]);
    unsigned prefix = 0u, mask = 0u; unsigned kth = (unsigned)cap;
    for (int pass = 0; pass < 4; ++pass) {
        const int shift = 24 - 8 * pass;
        if (tid < 256) hist[tid] = 0u;
        __syncthreads();
        for (int i = tid; i < n; i += NTHR) { const unsigned key = keys[i]; if ((key & mask) == prefix) __hip_atomic_fetch_add(&hist[(key >> shift) & 255u], 1u, __ATOMIC_RELAXED, __HIP_MEMORY_SCOPE_WORKGROUP); }
        __syncthreads();
        if (wid == 0) {
            const unsigned h0 = hist[4 * lane], h1 = hist[4 * lane + 1], h2 = hist[4 * lane + 2], h3 = hist[4 * lane + 3];
            const unsigned s = h0 + h1 + h2 + h3;
            unsigned suf = s;
#pragma unroll
            for (int o = 1; o < 64; o <<= 1) { const unsigned y = __shfl_down(suf, o); if (lane + o < 64) suf += y; }
            unsigned above = suf - s;
            if (above < kth && kth <= above + h3) { ctl[0] = 4 * lane + 3; ctl[1] = kth - above; }
            above += h3;
            if (above < kth && kth <= above + h2) { ctl[0] = 4 * lane + 2; ctl[1] = kth - above; }
            above += h2;
            if (above < kth && kth <= above + h1) { ctl[0] = 4 * lane + 1; ctl[1] = kth - above; }
            above += h1;
            if (above < kth && kth <= above + h0) { ctl[0] = 4 * lane + 0; ctl[1] = kth - above; }
        }
        __syncthreads();
        prefix |= ctl[0] << shift; mask |= 255u << shift; kth = ctl[1];
        __syncthreads();
    }
    const unsigned T = prefix, need_eq = kth;
    const int per = n / NTHR > 0 ? n / NTHR : 1;
    const int i0 = tid * per; const bool act = i0 < n;
    unsigned cgt = 0u, ceq = 0u;
    if (act) for (int i = 0; i < per; ++i) { const unsigned key = keys[i0 + i]; cgt += key > T; ceq += key == T; }
    const unsigned pk = (cgt << 16) | ceq; unsigned inc = pk;
#pragma unroll
    for (int o = 1; o < 64; o <<= 1) { const unsigned y = __shfl_up(inc, o); if (lane >= o) inc += y; }
    if (lane == 63) wsum[wid] = inc;
    __syncthreads();
    unsigned base = 0u;
    for (int w = 0; w < wid; ++w) base += wsum[w];
    const unsigned excl = base + inc - pk;
    unsigned gtb = excl >> 16, eqb = excl & 0xffffu;
    if (act) for (int i = 0; i < per; ++i) {
        const unsigned key = keys[i0 + i];
        int pr = -1;
        if (key > T) { pr = e * MZ + segoff + (int)(gtb + (eqb < need_eq ? eqb : need_eq)); ++gtb; }
        else if (key == T) { if (eqb < need_eq) pr = e * MZ + segoff + (int)(gtb + eqb); ++eqb; }
        if (pr >= 0) { P.glist[pr] = row0 + i0 + i; P.gval[pr] = __uint_as_float(key); }
        P.inv[(size_t)(row0 + i0 + i) * 16 + e] = pr;
    }
    __syncthreads();
}
__device__ __forceinline__ void phase_topk_prep(const Params& P, LAS unsigned char* lds, int l, int nlists, int wg, int nwg) {
    if (wg < nlists) topk_list(P, lds, wg);
    phase_prep_experts(P, lds, l, wg, nwg);
}

__device__ __forceinline__ void phase_rowop_post_pre(const Params& P, int l, int nrows, int wg, int nwg) {
    const int tid_ = ltid(), lane = tid_ & 63, gw = wg * 8 + (tid_ >> 6), ngw = nwg * 8;
    const float* g_post = P.g_ffn_post + l * 1024;
    const bf16_t* yp = P.r1;
    const int nl = l + 1;
    for (int row = gw; row < nrows; row += ngw) {
        float* xr = xrow_ptr(P, row);
        const float* m = P.mod + ((size_t)l * 3 + modrow(row)) * 6144;
        float f[16];
#pragma unroll
        for (int i = 0; i < 16; ++i) f[i] = 0;
        const int myinv = P.inv[(size_t)row * 16 + (lane & 15)];
#pragma unroll 1
        for (int e = 0; e < 16; ++e) {
            const int pr = __shfl(myinv, e);
            if (pr >= 0) {
#pragma unroll
                for (int j = 0; j < 4; ++j) { const u32x2 u = *(const u32x2*)(yp + (size_t)pr * 1024 + j * 256 + lane * 4); f[j * 4 + 0] += bflo(u.x); f[j * 4 + 1] += bfhi(u.x); f[j * 4 + 2] += bflo(u.y); f[j * 4 + 3] += bfhi(u.y); }
            }
        }
        float ss = 0;
#pragma unroll
        for (int i = 0; i < 16; ++i) ss += f[i] * f[i];
        float rstd = rsqrtf(wave_sum(ss) * (1.f / 1024.f) + EPS);
        float xv[16]; ss = 0;
#pragma unroll
        for (int j = 0; j < 4; ++j) {
            const int col = j * 256 + lane * 4;
            const float4 xo = *(const float4*)(xr + col), gp = *(const float4*)(g_post + col), ga = *(const float4*)(m + 5120 + col);
            float4 xn; xn.x = xo.x + ga.x * (f[j * 4 + 0] * rstd * gp.x); xn.y = xo.y + ga.y * (f[j * 4 + 1] * rstd * gp.y); xn.z = xo.z + ga.z * (f[j * 4 + 2] * rstd * gp.z); xn.w = xo.w + ga.w * (f[j * 4 + 3] * rstd * gp.w);
            *(float4*)(xr + col) = xn;
            xv[j * 4 + 0] = xn.x; xv[j * 4 + 1] = xn.y; xv[j * 4 + 2] = xn.z; xv[j * 4 + 3] = xn.w;
            ss += xn.x * xn.x + xn.y * xn.y + xn.z * xn.z + xn.w * xn.w;
        }
        if (nl < DEPTH) {
            rstd = rsqrtf(wave_sum(ss) * (1.f / 1024.f) + EPS);
            const float* g = P.g_mix_pre + nl * 1024;
            const float* m2 = P.mod + ((size_t)nl * 3 + modrow(row)) * 6144;
#pragma unroll
            for (int j = 0; j < 4; ++j) {
                const int col = j * 256 + lane * 4;
                const float4 gg = *(const float4*)(g + col), sh = *(const float4*)(m2 + col), sc = *(const float4*)(m2 + 1024 + col);
                store_bf16x4(P.abuf + (size_t)row * 1024 + col, xv[j * 4 + 0] * rstd * gg.x * (1.f + sc.x) + sh.x, xv[j * 4 + 1] * rstd * gg.y * (1.f + sc.y) + sh.y,
                             xv[j * 4 + 2] * rstd * gg.z * (1.f + sc.z) + sh.z, xv[j * 4 + 3] * rstd * gg.w * (1.f + sc.w) + sh.w);
            }
        }
    }
}

extern __shared__ __attribute__((aligned(16))) unsigned char smem_dyn[];
#define PH_COMMON LAS unsigned char* lds = (LAS unsigned char*)smem_dyn; const int wg = blockIdx.x, nwg = gridDim.x;

__global__ void __launch_bounds__(512, 2) k_mega(Params P) {
    PH_COMMON
    cg::grid_group grid = cg::this_grid();
    volatile LAS unsigned* xbw = (volatile LAS unsigned*)(lds + LDS_BYTES - 16);
    if (threadIdx.x == 0) { xbw[0] = 0u; xbw[1] = 0u; }
    __syncthreads();
    const XcdBarrier xb = xcd_barrier_post(P.bar, xbw);
#define GBAR() xcd_barrier(xb)
    phase_prep_small(P, lds, wg, nwg); phase_ada(P, lds, wg, nwg); phase_resid_init(P, wg, nwg);
    grid.sync();
    phase_rowop_pre(P, 0, wg, nwg);
    GBAR();
#pragma unroll 1
    for (int l = 0; l < DEPTH; ++l) {
        const bool last = (l == DEPTH - 1);
        const int nrows = last ? NLAT : NROW;
        {
            SchedDense S; S.nM = NROW / 256; S.nN = PN / 256; S.nwg = S.nM * S.nN; S.G = nwg; S.c = wg; S.Bt = (const char*)(P.WinT + (size_t)l * PN * 1024);
            EpiStoreBf16 E; E.O = P.p; E.ldo = PN;
            gemm_phase(lds, (const char*)P.abuf, S, E);
            phase_gates(P, l, wg, nwg);
        }
        GBAR();
        phase_mix_a(P, lds, l, wg, nwg);
        GBAR();
        phase_mix_b(P, wg, nwg);
        GBAR();
        phase_mix_c(P, lds, l, last ? 2 : 0, wg, nwg);
        GBAR();
        {
            SchedDense S; S.nM = nrows / 256; S.nN = 4; S.nwg = S.nM * S.nN; S.G = nwg; S.c = wg; S.Bt = (const char*)(P.WoutT + (size_t)l * 1024 * 1024);
            EpiStoreBf16 E; E.O = P.r1; E.ldo = 1024;
            gemm_phase(lds, (const char*)P.abuf, S, E);
        }
        GBAR();
        phase_rowop_mid(P, l, nrows, wg, nwg);
        GBAR();
        phase_topk_prep(P, lds, l, last ? 32 : 64, wg, nwg);
        GBAR();
        const int mtn = last ? 8 : 9;
        {
            SchedGateUp S; S.G = nwg; S.c = wg; S.mtn = mtn; S.glist = P.glist; S.Wg = (const char*)P.WegT; S.Wu = (const char*)P.WeuT;
            EpiGateUp E; E.hid = P.p;
            gemm_phase(lds, (const char*)P.abuf, S, E);
        }
        GBAR();
        {
            SchedDown S; S.G = nwg; S.c = wg; S.mtn = mtn; S.Wd = (const char*)P.WedT;
            EpiDown E; E.yp = P.r1; E.gval = P.gval;
            gemm_phase(lds, (const char*)P.p, S, E);
        }
        GBAR();
        phase_rowop_post_pre(P, l, nrows, wg, nwg);
        if (!last) GBAR();
    }
#undef GBAR
}
}

extern "C" void kernel_launch(void* const* d_in, const int* in_sizes, int n_in, void* d_out, int out_size, void* d_ws, size_t ws_size, hipStream_t stream) {
    Params P{};
    P.x = (const float*)d_in[0]; P.c = (const float*)d_in[1]; P.ctx = (const float*)d_in[2]; P.c_ctx = (const float*)d_in[3];
    P.w_ada = (const float*)d_in[4]; P.b_ada = (const float*)d_in[5];
    P.g_mix_pre = (const float*)d_in[6]; P.g_mix_post = (const float*)d_in[7]; P.g_ffn_pre = (const float*)d_in[8]; P.g_ffn_post = (const float*)d_in[9];
    P.w_in = (const float*)d_in[10]; P.conv_qk = (const float*)d_in[11]; P.b_ml_gates = (const float*)d_in[12];
    P.w_gla_a2 = (const float*)d_in[13]; P.b_gla_a = (const float*)d_in[14]; P.g_ml_norm = (const float*)d_in[15]; P.g_gla_norm = (const float*)d_in[16];
    P.w_out = (const float*)d_in[17]; P.w_router = (const float*)d_in[18];
    P.w_e_gate = (const float*)d_in[19]; P.w_e_up = (const float*)d_in[20]; P.w_e_down = (const float*)d_in[21];
    P.out = (float*)d_out;

    char* ws = (char*)d_ws; size_t off = 0;
    auto carve = [&](size_t bytes) { void* r = ws + off; off += (bytes + 255) & ~(size_t)255; return r; };
    P.bar = (unsigned*)carve(65536);
    P.xc = (float*)carve((size_t)NCTX * 1024 * 4);
    P.WinT = (bf16_t*)carve((size_t)DEPTH * PN * 1024 * 2);
    P.WgaT = (bf16_t*)carve((size_t)DEPTH * 64 * 1024 * 2);
    P.WoutT = (bf16_t*)carve((size_t)DEPTH * 1024 * 1024 * 2);
    P.WegT = (bf16_t*)carve((size_t)NE * 1024 * 1024 * 2);
    P.WeuT = (bf16_t*)carve((size_t)NE * 1024 * 1024 * 2);
    P.WedT = (bf16_t*)carve((size_t)NE * 1024 * 1024 * 2);
    P.abuf = (bf16_t*)carve((size_t)NROW * 1024 * 2);
    P.p = (bf16_t*)carve((size_t)NROW * PN * 2);
    P.pga = (float*)carve((size_t)NROW * GA * 4);
    P.r1 = (bf16_t*)carve((size_t)2 * NROW * 1024 * 2);
    P.qk = P.r1 + (size_t)NROW * 1024;
    P.ml_ck = (bf16_t*)carve((size_t)16 * 66 * ML_IMG);
    P.ml_pre = (bf16_t*)carve((size_t)16 * 66 * ML_IMG);
    P.gl_ck = (bf16_t*)carve((size_t)16 * 66 * GL_IMG);
    P.gl_pre = (bf16_t*)carve((size_t)16 * 66 * GL_IMG);
    P.mstat = (float*)carve((size_t)16 * 66 * 2 * 4);
    P.mprev = (float*)carve((size_t)16 * 66 * 4);
    P.gbend = (float*)carve((size_t)16 * 66 * 64 * 4);
    P.mod = (float*)carve((size_t)DEPTH * 3 * 6144 * 4);
    P.aff = (float*)carve((size_t)NROW * 16 * 4);
    P.glist = (int*)carve((size_t)NE * MZ * 4);
    P.gval = (float*)carve((size_t)NE * MZ * 4);
    P.inv = (int*)carve((size_t)NROW * 16 * 4);

    static int grid_blocks = 0;
    if (!grid_blocks) {
        int dev = 0, cus = 0, per_cu = 0;
        (void)hipGetDevice(&dev);
        (void)hipDeviceGetAttribute(&cus, hipDeviceAttributeMultiprocessorCount, dev);
        (void)hipFuncSetAttribute((const void*)k_mega, hipFuncAttributeMaxDynamicSharedMemorySize, LDS_BYTES);
        (void)hipOccupancyMaxActiveBlocksPerMultiprocessor(&per_cu, (const void*)k_mega, NTHR, LDS_BYTES);
        if (cus < 1) cus = NWG;
        grid_blocks = cus;
        if (per_cu < 1) grid_blocks = cus;
        if (grid_blocks > NWG) grid_blocks = NWG;
    }
    (void)hipMemsetAsync(P.bar, 0, 65536, stream);
    void* args[] = {&P};
    (void)hipLaunchCooperativeKernel((const void*)k_mega, dim3(grid_blocks), dim3(NTHR), args, LDS_BYTES, stream);
}
```

```cpp
#include <hip/hip_runtime.h>
#include <hip/hip_cooperative_groups.h>
#include <math.h>
namespace cg = cooperative_groups;

namespace {
#define LAS __attribute__((address_space(3)))
typedef unsigned short bf16_t;
typedef short bf16x8 __attribute__((ext_vector_type(8)));
typedef float f32x4 __attribute__((ext_vector_type(4)));
typedef unsigned u32x4 __attribute__((ext_vector_type(4)));
typedef unsigned u32x2 __attribute__((ext_vector_type(2)));

constexpr int D = 1024, NB = 2, SEQ = 8192, CTX = 256, DEPTH = 2;
constexpr int NLAT = NB * SEQ;
constexpr int NCTX = NB * CTX;
constexpr int NROW = NLAT + NCTX;
constexpr int PW = 3632;
constexpr int PN = 3584;
constexpr int P_MLQ = 0, P_MLK = 512, P_MLV = 1024, P_MLO = 1536, P_GQ = 2048, P_GK = 2304, P_GV = 2560, P_GR = 3072;
constexpr int GA = 64;
constexpr int NE = 16;
constexpr int MZ = 2112;
constexpr float EPS = 1e-6f;
constexpr int NWG = 256, NTHR = 512;
constexpr int LDS_BYTES = 152 * 1024;
constexpr int ML_IMG = 128 * 272, GL_IMG = 64 * 272;

__device__ __forceinline__ float wave_sum(float v) {
#pragma unroll
    for (int o = 32; o > 0; o >>= 1) v += __shfl_xor(v, o);
    return v;
}
__device__ __forceinline__ int ltid() { int t = threadIdx.x; asm volatile("" : "+v"(t)); return t; }
__device__ __forceinline__ int opaque_reps(int n) { asm volatile("" : "+s"(n)); return n; }
__device__ __forceinline__ float siluf(float x) { return x * __frcp_rn(1.f + __expf(-x)); }
__device__ __forceinline__ float sigmoidf(float x) { return __frcp_rn(1.f + __expf(-x)); }
__device__ __forceinline__ float logsigmoidf(float x) { return fminf(x, 0.f) - __logf(1.f + __expf(-fabsf(x))); }
__device__ __forceinline__ int modrow(int row) { return row < NLAT ? row / SEQ : 2; }
__device__ __forceinline__ unsigned pk2(float lo, float hi) { unsigned r; asm("v_cvt_pk_bf16_f32 %0, %1, %2" : "=v"(r) : "v"(lo), "v"(hi)); return r; }
__device__ __forceinline__ float bf2f(bf16_t b) { return __uint_as_float(((unsigned)b) << 16); }
__device__ __forceinline__ float bflo(unsigned u) { return __uint_as_float(u << 16); }
__device__ __forceinline__ float bfhi(unsigned u) { return __uint_as_float(u & 0xffff0000u); }

struct Params {
    const float *x, *c, *ctx, *c_ctx, *w_ada, *b_ada, *g_mix_pre, *g_mix_post, *g_ffn_pre, *g_ffn_post, *w_in, *conv_qk, *b_ml_gates, *w_gla_a2, *b_gla_a, *g_ml_norm, *g_gla_norm,
        *w_out, *w_router, *w_e_gate, *w_e_up, *w_e_down;
    float* out;
    float* xc;
    bf16_t *WinT, *WgaT, *WoutT, *WegT, *WeuT, *WedT;
    bf16_t *abuf;
    bf16_t *p;
    float* pga;
    bf16_t *r1;
    bf16_t* qk;
    bf16_t *ml_ck, *ml_pre;
    bf16_t *gl_ck, *gl_pre;
    float *mstat;
    float *mprev;
    float *gbend;
    float* mod;
    float* aff;
    int* glist; float* gval; int* inv;
    unsigned* bar;
    int pad_;
};

__device__ __forceinline__ float* xrow_ptr(const Params& P, int row) { return row < NLAT ? P.out + (size_t)row * 1024 : P.xc + (size_t)(row - NLAT) * 1024; }

__device__ __forceinline__ void transpose_item(const float* W, int ldw, int k0, int srccol0, int nvalid_lo, int nvalid_hi  , int special,
                                               bf16_t* WT, int dstrow0, LAS float* scr, int tid) {
    {
        const int k = tid >> 3, n8 = (tid & 7) * 8;
#pragma unroll
        for (int q = 0; q < 2; ++q) {
            const int n = n8 + q * 4;
            float4 v = make_float4(0.f, 0.f, 0.f, 0.f);
            int sc;
            if (special) {
                if (n < 16) sc = 2048 + n; else if (n < 48) sc = 3600 + (n - 16); else sc = -1;
            } else sc = srccol0 + n;
            if (sc >= 0) v = *(const float4*)(W + (size_t)(k0 + k) * ldw + sc);
            scr[k * 65 + n + 0] = v.x; scr[k * 65 + n + 1] = v.y; scr[k * 65 + n + 2] = v.z; scr[k * 65 + n + 3] = v.w;
        }
    }
    __syncthreads();
    {
        const int n = tid >> 3, kc = (tid & 7) * 8;
        u32x4 o;
        o.x = pk2(scr[(kc + 0) * 65 + n], scr[(kc + 1) * 65 + n]); o.y = pk2(scr[(kc + 2) * 65 + n], scr[(kc + 3) * 65 + n]);
        o.z = pk2(scr[(kc + 4) * 65 + n], scr[(kc + 5) * 65 + n]); o.w = pk2(scr[(kc + 6) * 65 + n], scr[(kc + 7) * 65 + n]);
        *(u32x4*)(WT + (size_t)(dstrow0 + n) * 1024 + k0 + kc) = o;
    }
    __syncthreads();
}

constexpr int IT_IN = 16 * 56, IT_GA = 16, IT_OUT = 256, IT_EX = 3 * 16 * 256, IT_LAYER_SMALL = IT_IN + IT_GA + IT_OUT;
__device__ __forceinline__ void phase_prep_small(const Params& P, LAS unsigned char* lds, int wg, int nwg) {
    LAS float* scr = (LAS float*)lds; const int tid = ltid();
    for (int it = wg; it < DEPTH * IT_LAYER_SMALL; it += nwg) {
        const int l = it / IT_LAYER_SMALL; int r = it % IT_LAYER_SMALL;
        if (r < IT_IN) { const int kb = r / 56, nb = r % 56, n0 = nb * 64; transpose_item(P.w_in + (size_t)l * 1024 * PW, PW, kb * 64, n0 + (n0 >= 2048 ? 16 : 0), 0, 64, 0, P.WinT + (size_t)l * PN * 1024, n0, scr, tid); continue; }
        r -= IT_IN;
        if (r < IT_GA) { transpose_item(P.w_in + (size_t)l * 1024 * PW, PW, r * 64, 0, 0, 48, 1, P.WgaT + (size_t)l * 64 * 1024, 0, scr, tid); continue; }
        r -= IT_GA;
        { const int kb = r / 16, nb = r % 16; transpose_item(P.w_out + (size_t)l * 1024 * 1024, 1024, kb * 64, nb * 64, 0, 64, 0, P.WoutT + (size_t)l * 1024 * 1024, nb * 64, scr, tid); }
    }
}
__device__ __forceinline__ void phase_prep_experts(const Params& P, LAS unsigned char* lds, int l, int wg, int nwg) {
    LAS float* scr = (LAS float*)lds; const int tid = ltid();
    for (int it = wg; it < IT_EX; it += nwg) {
        const int m = it / (16 * 256), e = (it / 256) % 16, r = it % 256, kb = r / 16, nb = r % 16;
        const float* src = (m == 0 ? P.w_e_gate : (m == 1 ? P.w_e_up : P.w_e_down)) + ((size_t)l * NE + e) * 1024 * 1024;
        bf16_t* dst = (m == 0 ? P.WegT : (m == 1 ? P.WeuT : P.WedT)) + (size_t)e * 1024 * 1024;
        transpose_item(src, 1024, kb * 64, nb * 64, 0, 64, 0, dst, nb * 64, scr, tid);
    }
}

__device__ __forceinline__ void phase_ada(const Params& P, LAS unsigned char* lds, int wg, int nwg) {
    LAS float* s = (LAS float*)lds;
    const int tid = ltid();
    for (int i = tid; i < 1024; i += NTHR) { s[i] = siluf(P.c[i]); s[1024 + i] = siluf(P.c[1024 + i]); s[2048 + i] = siluf(P.c_ctx[i]); }
    __syncthreads();
    LAS float* red = s + 3072;
    for (int it = wg; it < DEPTH * 96; it += nwg) {
        const int l = it / 96, n = (it % 96) * 64 + (tid & 63), ks = tid >> 6;
        const float* w = P.w_ada + (size_t)l * 1024 * 6144 + n;
        float a0 = 0, a1 = 0, a2 = 0;
#pragma unroll 8
        for (int k = ks * 128; k < ks * 128 + 128; ++k) { const float wv = w[(size_t)k * 6144]; a0 += s[k] * wv; a1 += s[1024 + k] * wv; a2 += s[2048 + k] * wv; }
        red[(ks * 3 + 0) * 64 + (tid & 63)] = a0; red[(ks * 3 + 1) * 64 + (tid & 63)] = a1; red[(ks * 3 + 2) * 64 + (tid & 63)] = a2;
        __syncthreads();
        if (tid < 192) {
            const int r = tid / 64, cidx = tid & 63; float a = 0;
#pragma unroll
            for (int q = 0; q < 8; ++q) a += red[(q * 3 + r) * 64 + cidx];
            const int nn = (it % 96) * 64 + cidx;
            P.mod[((size_t)l * 3 + r) * 6144 + nn] = a + P.b_ada[l * 6144 + nn];
        }
        __syncthreads();
    }
}

__device__ __forceinline__ void phase_resid_init(const Params& P, int wg, int nwg) {
    const int tid_ = ltid(), lane = tid_ & 63, gw = wg * 8 + (tid_ >> 6), ngw = nwg * 8;
    for (int row = gw; row < NROW; row += ngw) {
        if (row < NLAT) {
            const int t = row % SEQ, r = t / 64, cc = t % 64;
#pragma unroll
            for (int j = 0; j < 4; ++j) {
                const int col = j * 256 + lane * 4;
                float4 v = *(const float4*)(P.x + (size_t)row * 1024 + col);
                float e[4];
#pragma unroll
                for (int q = 0; q < 4; ++q) { const int jj = (col + q) & 255; const float freq = powf(10000.f, -(float)jj / 256.f); const float arg = (float)(j < 2 ? r : cc) * freq; e[q] = (j & 1) ? cosf(arg) : sinf(arg); }
                v.x += e[0]; v.y += e[1]; v.z += e[2]; v.w += e[3];
                *(float4*)(P.out + (size_t)row * 1024 + col) = v;
            }
        } else {
#pragma unroll
            for (int j = 0; j < 4; ++j) { const int col = j * 256 + lane * 4; *(float4*)(P.xc + (size_t)(row - NLAT) * 1024 + col) = *(const float4*)(P.ctx + (size_t)(row - NLAT) * 1024 + col); }
        }
    }
}

__device__ __forceinline__ void store_bf16x4(bf16_t* p, float a, float b, float c, float d) { u32x2 o; o.x = pk2(a, b); o.y = pk2(c, d); *(u32x2*)p = o; }

__device__ __forceinline__ void phase_rowop_pre(const Params& P, int l, int wg, int nwg) {
    const int tid_ = ltid(), lane = tid_ & 63, gw = wg * 8 + (tid_ >> 6), ngw = nwg * 8;
    const float* g = P.g_mix_pre + l * 1024;
    for (int row = gw; row < NROW; row += ngw) {
        const float* xr = xrow_ptr(P, row);
        const float* m = P.mod + ((size_t)l * 3 + modrow(row)) * 6144;
        float4 v[4]; float ss = 0;
#pragma unroll
        for (int j = 0; j < 4; ++j) { v[j] = *(const float4*)(xr + j * 256 + lane * 4); ss += v[j].x * v[j].x + v[j].y * v[j].y + v[j].z * v[j].z + v[j].w * v[j].w; }
        const float rstd = rsqrtf(wave_sum(ss) * (1.f / 1024.f) + EPS);
#pragma unroll
        for (int j = 0; j < 4; ++j) {
            const int col = j * 256 + lane * 4;
            const float4 gg = *(const float4*)(g + col), sh = *(const float4*)(m + col), sc = *(const float4*)(m + 1024 + col);
            store_bf16x4(P.abuf + (size_t)row * 1024 + col, v[j].x * rstd * gg.x * (1.f + sc.x) + sh.x, v[j].y * rstd * gg.y * (1.f + sc.y) + sh.y,
                         v[j].z * rstd * gg.z * (1.f + sc.z) + sh.z, v[j].w * rstd * gg.w * (1.f + sc.w) + sh.w);
        }
    }
}

__device__ __forceinline__ void phase_rowop_mid(const Params& P, LAS unsigned char* lds, int l, int nrows, int wg, int nwg, int dry = 0) {
    const int tid_ = ltid(), lane = tid_ & 63, gw = wg * 8 + (tid_ >> 6), ngw = nwg * 8;
    LAS float* wl = (LAS float*)lds;
    {
        const float* wsrc = P.w_router + (size_t)l * 1024 * 16;
        for (int i = tid_; i < 4096; i += NTHR) { const float4 w = *(const float4*)(wsrc + (size_t)i * 4); const int col = i >> 2, e0 = (i & 3) * 4;
            wl[(e0 + 0) * 1024 + col] = w.x; wl[(e0 + 1) * 1024 + col] = w.y; wl[(e0 + 2) * 1024 + col] = w.z; wl[(e0 + 3) * 1024 + col] = w.w; }
        __syncthreads();
    }
    const float* g_post = P.g_mix_post + l * 1024; const float* g_pre2 = P.g_ffn_pre + l * 1024;
    const bf16_t* y = P.r1;
    for (int row = gw; row < nrows; row += ngw) {
        float* xr = xrow_ptr(P, row);
        const float* m = P.mod + ((size_t)l * 3 + modrow(row)) * 6144;
        float yv[16], xv[16]; float ss = 0;
#pragma unroll
        for (int j = 0; j < 4; ++j) { const u32x2 u = *(const u32x2*)(y + (size_t)row * 1024 + j * 256 + lane * 4); yv[j * 4 + 0] = bflo(u.x); yv[j * 4 + 1] = bfhi(u.x); yv[j * 4 + 2] = bflo(u.y); yv[j * 4 + 3] = bfhi(u.y); }
#pragma unroll
        for (int i = 0; i < 16; ++i) ss += yv[i] * yv[i];
        float rstd = rsqrtf(wave_sum(ss) * (1.f / 1024.f) + EPS);
        ss = 0;
#pragma unroll
        for (int j = 0; j < 4; ++j) {
            const int col = j * 256 + lane * 4;
            const float4 xo = *(const float4*)(xr + col), gp = *(const float4*)(g_post + col), ga = *(const float4*)(m + 2048 + col);
            float4 xn; xn.x = xo.x + ga.x * (yv[j * 4 + 0] * rstd * gp.x); xn.y = xo.y + ga.y * (yv[j * 4 + 1] * rstd * gp.y); xn.z = xo.z + ga.z * (yv[j * 4 + 2] * rstd * gp.z); xn.w = xo.w + ga.w * (yv[j * 4 + 3] * rstd * gp.w);
            *(float4*)((dry ? (float*)P.p + (size_t)row * 1024 : xr) + col) = xn;
            xv[j * 4 + 0] = xn.x; xv[j * 4 + 1] = xn.y; xv[j * 4 + 2] = xn.z; xv[j * 4 + 3] = xn.w;
            ss += xn.x * xn.x + xn.y * xn.y + xn.z * xn.z + xn.w * xn.w;
        }
        rstd = rsqrtf(wave_sum(ss) * (1.f / 1024.f) + EPS);
        float lg[16];
#pragma unroll
        for (int e = 0; e < 16; ++e) lg[e] = 0;
#pragma unroll
        for (int j = 0; j < 4; ++j) {
            const int col = j * 256 + lane * 4;
            const float4 gg = *(const float4*)(g_pre2 + col), sh = *(const float4*)(m + 3072 + col), sc = *(const float4*)(m + 4096 + col);
            float hv[4];
            hv[0] = xv[j * 4 + 0] * rstd * gg.x * (1.f + sc.x) + sh.x; hv[1] = xv[j * 4 + 1] * rstd * gg.y * (1.f + sc.y) + sh.y;
            hv[2] = xv[j * 4 + 2] * rstd * gg.z * (1.f + sc.z) + sh.z; hv[3] = xv[j * 4 + 3] * rstd * gg.w * (1.f + sc.w) + sh.w;
            store_bf16x4(P.abuf + (size_t)row * 1024 + col, hv[0], hv[1], hv[2], hv[3]);
#pragma unroll
            for (int e = 0; e < 16; ++e) { const f32x4 w = *(const LAS f32x4*)(wl + e * 1024 + col); lg[e] += hv[0] * w[0] + hv[1] * w[1] + hv[2] * w[2] + hv[3] * w[3]; }
        }
        float mx = -1e30f;
#pragma unroll
        for (int e = 0; e < 16; ++e) { lg[e] = wave_sum(lg[e]); mx = fmaxf(mx, lg[e]); }
        float se = 0;
#pragma unroll
        for (int e = 0; e < 16; ++e) { lg[e] = __expf(lg[e] - mx); se += lg[e]; }
        float val = 0;
#pragma unroll
        for (int e = 0; e < 16; ++e) val = (e == lane) ? lg[e] : val;
        if (lane < 16) P.aff[(size_t)row * 16 + lane] = val / se;
    }
}

__device__ __forceinline__ void phase_rowop_post(const Params& P, int l, int nrows, int wg, int nwg) {
    const int tid_ = ltid(), lane = tid_ & 63, gw = wg * 8 + (tid_ >> 6), ngw = nwg * 8;
    const float* g_post = P.g_ffn_post + l * 1024;
    const bf16_t* yp = P.r1;
    for (int row = gw; row < nrows; row += ngw) {
        float* xr = xrow_ptr(P, row);
        const float* m = P.mod + ((size_t)l * 3 + modrow(row)) * 6144;
        float f[16];
#pragma unroll
        for (int i = 0; i < 16; ++i) f[i] = 0;
        const int myinv = P.inv[(size_t)row * 16 + (lane & 15)];
#pragma unroll 1
        for (int e = 0; e < 16; ++e) {
            const int pr = __shfl(myinv, e);
            if (pr >= 0) {
#pragma unroll
                for (int j = 0; j < 4; ++j) { const u32x2 u = *(const u32x2*)(yp + (size_t)pr * 1024 + j * 256 + lane * 4); f[j * 4 + 0] += bflo(u.x); f[j * 4 + 1] += bfhi(u.x); f[j * 4 + 2] += bflo(u.y); f[j * 4 + 3] += bfhi(u.y); }
            }
        }
        float ss = 0;
#pragma unroll
        for (int i = 0; i < 16; ++i) ss += f[i] * f[i];
        const float rstd = rsqrtf(wave_sum(ss) * (1.f / 1024.f) + EPS);
#pragma unroll
        for (int j = 0; j < 4; ++j) {
            const int col = j * 256 + lane * 4;
            const float4 xo = *(const float4*)(xr + col), gp = *(const float4*)(g_post + col), ga = *(const float4*)(m + 5120 + col);
            float4 xn; xn.x = xo.x + ga.x * (f[j * 4 + 0] * rstd * gp.x); xn.y = xo.y + ga.y * (f[j * 4 + 1] * rstd * gp.y); xn.z = xo.z + ga.z * (f[j * 4 + 2] * rstd * gp.z); xn.w = xo.w + ga.w * (f[j * 4 + 3] * rstd * gp.w);
            *(float4*)(xr + col) = xn;
        }
    }
}

constexpr int BK = 64, HALF = 128, HTB = HALF * BK * 2, GK = 1024;
__device__ __forceinline__ int lds_byte(int r, int c) { const int st = (r >> 4) * 2 + (c >> 5), rr = r & 15, cc = c & 31, ob = rr * 64 + cc * 2; return st * 1024 + (ob ^ (((ob >> 9) & 1) << 5)); }
__device__ __forceinline__ void stage_rc(int b, int& R, int& C) { const int st = b / 1024, sb = b % 1024, swz = sb ^ (((sb >> 9) & 1) << 5); R = (st >> 1) * 16 + swz / 64; C = (st & 1) * 32 + (swz % 64) / 2; }
__device__ __forceinline__ int perm32(int rho) { const int n = rho >> 4, i = rho & 15; return 8 * (i >> 2) + 4 * n + (i & 3); }

struct GUnit { int pm, pn, e, rows; };

template <class Sched, class Epi>
__device__ __forceinline__ void gemm_phase(LAS unsigned char* lds, const char* Abase, const Sched& S, const Epi& E) {
    const int tid = ltid(), wid = __builtin_amdgcn_readfirstlane(tid >> 6), lane = tid & 63, wr = wid >> 2, wc = wid & 3, fr = lane & 15, fq = lane >> 4;
    constexpr int nt = GK / BK;
    int R0, C0, R1, C1; stage_rc(tid * 16, R0, C0); stage_rc(tid * 16 + 8192, R1, C1);
    const unsigned voffB0 = (unsigned)(((R0 & ~31) + perm32(R0 & 31)) * GK + C0) * 2u, voffB1 = (unsigned)(((R1 & ~31) + perm32(R1 & 31)) * GK + C1) * 2u;
    constexpr size_t kstep = (size_t)(BK * 2);
    const unsigned ldsw = (unsigned)wid * 1024u;
    const int aoff = lds_byte(wr * 64 + fr, fq * 8), boff = lds_byte(wc * 32 + fr, fq * 8);
#define G_SA(b, h) (((b) * 2 + (h)) * HTB)
#define G_SB(b, h) ((4 + (b) * 2 + (h)) * HTB)
#define G_GL(bufoff, p0, p1) do { __builtin_amdgcn_global_load_lds((const unsigned*)(p0), (LAS unsigned*)(lds + (bufoff) + ldsw), 16, 0, 0); \
        __builtin_amdgcn_global_load_lds((const unsigned*)(p1), (LAS unsigned*)(lds + (bufoff) + ldsw + 8192), 16, 0, 0); } while (0)
#define G_STA(bufoff, kptr, o0, o1) G_GL(bufoff, (kptr) + (o0), (kptr) + (o1))
#define G_STB(bufoff, bptr) G_GL(bufoff, (bptr) + voffB0, (bptr) + voffB1)
#define G_LDA(dst, b, h) do { _Pragma("unroll") for (int m = 0; m < 4; ++m) _Pragma("unroll") for (int k = 0; k < 2; ++k) dst[m][k] = *(const LAS bf16x8*)(lds + G_SA(b, h) + aoff + m * 2048 + k * 1024); } while (0)
#define G_LDB(dst, b, h) do { _Pragma("unroll") for (int n = 0; n < 2; ++n) _Pragma("unroll") for (int k = 0; k < 2; ++k) dst[n][k] = *(const LAS bf16x8*)(lds + G_SB(b, h) + boff + n * 2048 + k * 1024); } while (0)
#define G_MMA(ai, bj, At, Bt) do { __builtin_amdgcn_s_setprio(1); _Pragma("unroll") for (int m = 0; m < 4; ++m) _Pragma("unroll") for (int n = 0; n < 2; ++n) _Pragma("unroll") for (int k = 0; k < 2; ++k) \
        acc[ai][bj][m][n] = __builtin_amdgcn_mfma_f32_16x16x32_bf16(Bt[n][k], At[m][k], acc[ai][bj][m][n], 0, 0, 0); __builtin_amdgcn_s_setprio(0); } while (0)
#define G_WAIT_V(n) asm volatile("s_waitcnt vmcnt(" #n ")" ::: "memory")
#define G_WAIT_L(n) asm volatile("s_waitcnt lgkmcnt(" #n ")" ::: "memory")
#define G_BAR __builtin_amdgcn_s_barrier()
#define G_SCHED __builtin_amdgcn_sched_barrier(0)
    GUnit cur, nxt; int ui = 0;
    if (!S.next(0, cur)) return;
    f32x4 acc[2][2][4][2];
#pragma unroll
    for (int a = 0; a < 2; ++a)
#pragma unroll
        for (int b = 0; b < 2; ++b)
#pragma unroll
            for (int m = 0; m < 4; ++m)
#pragma unroll
                for (int n = 0; n < 2; ++n) acc[a][b][m][n] = (f32x4){0.f, 0.f, 0.f, 0.f};
    bf16x8 At[4][2], B0[2][2], B1[2][2];
    unsigned c00, c01, c10, c11, n00, n01, n10, n11;
    S.aoff(cur, 0, R0, C0, R1, C1, c00, c01); S.aoff(cur, 1, R0, C0, R1, C1, c10, c11);
    const char* cB0 = S.bptr(cur, 0); const char* cB1 = S.bptr(cur, 1);
    G_STB(G_SB(0, 0), cB0); G_STA(G_SA(0, 0), Abase, c00, c01); G_STB(G_SB(0, 1), cB1); G_STA(G_SA(0, 1), Abase, c10, c11);
    if (wr == 1) G_BAR;
    G_WAIT_V(4); G_BAR;
    G_STB(G_SB(1, 0), cB0 + kstep); G_STA(G_SA(1, 0), Abase + kstep, c00, c01); G_STB(G_SB(1, 1), cB1 + kstep);
    G_WAIT_V(6); G_BAR;
    for (;;) {
        const bool has_next = S.next(ui + 1, nxt);
        const char* nB0 = cB0; const char* nB1 = cB1;
        n00 = c00; n01 = c01; n10 = c10; n11 = c11;
        if (has_next) { S.aoff(nxt, 0, R0, C0, R1, C1, n00, n01); S.aoff(nxt, 1, R0, C0, R1, C1, n10, n11); nB0 = S.bptr(nxt, 0); nB1 = S.bptr(nxt, 1); }
        for (int t = 0; t < nt; t += 2) {
            const bool last = (t == nt - 2);
            const char* a1 = Abase + (size_t)(t + 1) * kstep;
            const char* a2 = last ? Abase : Abase + (size_t)(t + 2) * kstep;
            const char* b20 = last ? nB0 : cB0 + (size_t)(t + 2) * kstep; const char* b21 = last ? nB1 : cB1 + (size_t)(t + 2) * kstep;
            const char* a3 = a2 + kstep; const char* b30 = b20 + kstep; const char* b31 = b21 + kstep;
            const unsigned s00 = last ? n00 : c00, s01 = last ? n01 : c01, s10 = last ? n10 : c10, s11 = last ? n11 : c11;
            G_LDB(B0, 0, 0); G_SCHED; G_LDA(At, 0, 0); G_STA(G_SA(1, 1), a1, c10, c11);
            G_WAIT_L(8); G_BAR; G_WAIT_L(0); G_MMA(0, 0, At, B0); G_BAR; G_SCHED;
            G_LDB(B1, 0, 1); G_STB(G_SB(0, 0), b20);
            G_BAR; G_WAIT_L(0); G_MMA(0, 1, At, B1); G_BAR;
            G_LDA(At, 0, 1); G_STA(G_SA(0, 0), a2, s00, s01);
            G_BAR; G_WAIT_L(0); G_MMA(1, 0, At, B0); G_BAR; G_SCHED;
            G_STB(G_SB(0, 1), b21);
            G_WAIT_V(6); G_BAR; G_MMA(1, 1, At, B1); G_BAR;
            G_LDB(B0, 1, 0); G_SCHED; G_LDA(At, 1, 0); G_STA(G_SA(0, 1), a2, s10, s11);
            G_WAIT_L(8); G_BAR; G_WAIT_L(0); G_MMA(0, 0, At, B0); G_BAR; G_SCHED;
            G_LDB(B1, 1, 1); G_STB(G_SB(1, 0), b30);
            G_BAR; G_WAIT_L(0); G_MMA(0, 1, At, B1); G_BAR;
            G_LDA(At, 1, 1); G_STA(G_SA(1, 0), a3, s00, s01);
            G_BAR; G_WAIT_L(0); G_MMA(1, 0, At, B0); G_BAR; G_SCHED;
            G_STB(G_SB(1, 1), b31);
            G_WAIT_V(6); G_BAR; G_MMA(1, 1, At, B1); G_BAR;
        }
        E(acc, cur, wr, wc, fr, fq);
        if (!has_next) break;
#pragma unroll
        for (int a = 0; a < 2; ++a)
#pragma unroll
            for (int b = 0; b < 2; ++b)
#pragma unroll
                for (int m = 0; m < 4; ++m)
#pragma unroll
                    for (int n = 0; n < 2; ++n) acc[a][b][m][n] = (f32x4){0.f, 0.f, 0.f, 0.f};
        cur = nxt; cB0 = nB0; cB1 = nB1; c00 = n00; c01 = n01; c10 = n10; c11 = n11; ++ui;
    }
    G_WAIT_V(0);
    if (wr == 0) G_BAR;
    G_BAR;
#undef G_SA
#undef G_SB
#undef G_GL
#undef G_STA
#undef G_STB
#undef G_LDA
#undef G_LDB
#undef G_MMA
#undef G_WAIT_V
#undef G_WAIT_L
#undef G_BAR
#undef G_SCHED
}

struct SchedDense {
    int nM, nN, nwg, G, c; const char* Bt;
    __device__ __forceinline__ bool next(int i, GUnit& u) const {
        const long L = (long)i * G + c; if (L >= nwg) return false;
        int wgid = (int)L; { const int q = nwg / 8, r = nwg % 8, xcd = wgid % 8, off = wgid / 8; wgid = (xcd < r ? xcd * (q + 1) : r * (q + 1) + (xcd - r) * q) + off; }
        const int nig = 8 * nN, gid = wgid / nig, fm = gid * 8, gsz = (nM - fm) < 8 ? (nM - fm) : 8;
        u.pm = fm + ((wgid % nig) % gsz); u.pn = (wgid % nig) / gsz; u.e = 0; u.rows = 256; return true;
    }
    __device__ __forceinline__ void aoff(const GUnit& u, int h, int R0, int C0, int R1, int C1, unsigned& o0, unsigned& o1) const {
        const unsigned base = (unsigned)(u.pm * 256 + h * 128);
        o0 = ((base + R0) * GK + C0) * 2u; o1 = ((base + R1) * GK + C1) * 2u;
    }
    __device__ __forceinline__ const char* bptr(const GUnit& u, int h) const { return Bt + (size_t)(u.pn * 256 + h * 128) * GK * 2; }
};
struct SchedGateUp {
    int G, c, mtn; const int* glist; const char* Wg; const char* Wu;
    __device__ __forceinline__ bool next(int i, GUnit& u) const {
        const int x = c & 7, j = c >> 3, per = G >> 3, L = i * per + j, tot = 2 * mtn * 8;
        if (L >= tot) return false;
        const int es = L / (mtn * 8), rem = L % (mtn * 8);
        u.e = x + 8 * es; u.pm = rem >> 3; u.pn = rem & 7; u.rows = (u.pm == 8) ? 64 : 256; return true;
    }
    __device__ __forceinline__ void aoff(const GUnit& u, int h, int R0, int C0, int R1, int C1, unsigned& o0, unsigned& o1) const {
        int r0 = h * 128 + R0, r1 = h * 128 + R1;
        r0 = r0 < u.rows ? r0 : 0; r1 = r1 < u.rows ? r1 : 0;
        const int g0 = glist[u.e * MZ + u.pm * 256 + r0], g1 = glist[u.e * MZ + u.pm * 256 + r1];
        o0 = ((unsigned)g0 * GK + C0) * 2u; o1 = ((unsigned)g1 * GK + C1) * 2u;
    }
    __device__ __forceinline__ const char* bptr(const GUnit& u, int h) const { return (h ? Wu : Wg) + ((size_t)u.e * 1024 + u.pn * 128) * GK * 2; }
};
struct SchedDown {
    int G, c, mtn; const char* Wd;
    __device__ __forceinline__ bool next(int i, GUnit& u) const {
        const int x = c & 7, j = c >> 3, per = G >> 3, L = i * per + j, tot = 2 * mtn * 4;
        if (L >= tot) return false;
        const int es = L / (mtn * 4), rem = L % (mtn * 4);
        u.e = x + 8 * es; u.pm = rem >> 2; u.pn = rem & 3; u.rows = (u.pm == 8) ? 64 : 256; return true;
    }
    __device__ __forceinline__ void aoff(const GUnit& u, int h, int R0, int C0, int R1, int C1, unsigned& o0, unsigned& o1) const {
        const unsigned base = (unsigned)(u.e * MZ + u.pm * 256 + h * 128);
        o0 = ((base + R0) * GK + C0) * 2u; o1 = ((base + R1) * GK + C1) * 2u;
    }
    __device__ __forceinline__ const char* bptr(const GUnit& u, int h) const { return Wd + ((size_t)u.e * 1024 + u.pn * 256 + h * 128) * GK * 2; }
};

struct EpiStoreBf16 {
    bf16_t* O; int ldo;
    __device__ __forceinline__ void operator()(const f32x4 (&acc)[2][2][4][2], const GUnit& u, int wr, int wc, int fr, int fq) const {
#pragma unroll
        for (int ai = 0; ai < 2; ++ai)
#pragma unroll
            for (int m = 0; m < 4; ++m) {
                bf16_t* rowp = O + (size_t)(u.pm * 256 + ai * 128 + wr * 64 + m * 16 + fr) * ldo + u.pn * 256 + wc * 32 + 8 * fq;
#pragma unroll
                for (int bj = 0; bj < 2; ++bj) { const f32x4 v0 = acc[ai][bj][m][0], v1 = acc[ai][bj][m][1]; u32x4 o; o.x = pk2(v0[0], v0[1]); o.y = pk2(v0[2], v0[3]); o.z = pk2(v1[0], v1[1]); o.w = pk2(v1[2], v1[3]); *(u32x4*)(rowp + bj * 128) = o; }
            }
    }
};
struct EpiGateUp {
    bf16_t* hid;
    __device__ __forceinline__ void operator()(const f32x4 (&acc)[2][2][4][2], const GUnit& u, int wr, int wc, int fr, int fq) const {
#pragma unroll
        for (int ai = 0; ai < 2; ++ai)
#pragma unroll
            for (int m = 0; m < 4; ++m) {
                const int r = ai * 128 + wr * 64 + m * 16 + fr;
                if (r < u.rows) {
                    float h[8];
#pragma unroll
                    for (int n = 0; n < 2; ++n)
#pragma unroll
                        for (int j = 0; j < 4; ++j) { const float g = acc[ai][0][m][n][j], up = acc[ai][1][m][n][j]; h[n * 4 + j] = g * __frcp_rn(1.f + __expf(-g)) * up; }
                    u32x4 o; o.x = pk2(h[0], h[1]); o.y = pk2(h[2], h[3]); o.z = pk2(h[4], h[5]); o.w = pk2(h[6], h[7]);
                    *(u32x4*)(hid + (size_t)(u.e * MZ + u.pm * 256 + r) * 1024 + u.pn * 128 + wc * 32 + 8 * fq) = o;
                }
            }
    }
};
struct EpiDown {
    bf16_t* yp; const float* gval;
    __device__ __forceinline__ void operator()(const f32x4 (&acc)[2][2][4][2], const GUnit& u, int wr, int wc, int fr, int fq) const {
#pragma unroll
        for (int ai = 0; ai < 2; ++ai)
#pragma unroll
            for (int m = 0; m < 4; ++m) {
                const int r = ai * 128 + wr * 64 + m * 16 + fr;
                if (r < u.rows) {
                    const int pr = u.e * MZ + u.pm * 256 + r; const float g = gval[pr];
                    bf16_t* rowp = yp + (size_t)pr * 1024 + u.pn * 256 + wc * 32 + 8 * fq;
#pragma unroll
                    for (int bj = 0; bj < 2; ++bj) { const f32x4 v0 = acc[ai][bj][m][0] * g, v1 = acc[ai][bj][m][1] * g; u32x4 o; o.x = pk2(v0[0], v0[1]); o.y = pk2(v0[2], v0[3]); o.z = pk2(v1[0], v1[1]); o.w = pk2(v1[2], v1[3]); *(u32x4*)(rowp + bj * 128) = o; }
                }
            }
    }
};

__device__ __forceinline__ void phase_gates(const Params& P, int l, int wg, int nwg) {
    const int tid_ = ltid(), lane = tid_ & 63, gw = wg * 8 + (tid_ >> 6), ngw = nwg * 8;
    const int fr = lane & 15, fq = lane >> 4;
    const bf16_t* W = P.WgaT + (size_t)l * 64 * 1024;
    for (int rb = gw; rb < NROW / 16; rb += ngw) {
        f32x4 acc[4];
#pragma unroll
        for (int n = 0; n < 4; ++n) acc[n] = (f32x4){0.f, 0.f, 0.f, 0.f};
        const bf16_t* arow = P.abuf + (size_t)(rb * 16 + fr) * 1024 + fq * 8;
#pragma unroll 4
        for (int k0 = 0; k0 < 1024; k0 += 32) {
            const bf16x8 a = *(const bf16x8*)(arow + k0);
#pragma unroll
            for (int n = 0; n < 4; ++n) { const bf16x8 b = *(const bf16x8*)(W + (size_t)(n * 16 + fr) * 1024 + k0 + fq * 8); acc[n] = __builtin_amdgcn_mfma_f32_16x16x32_bf16(a, b, acc[n], 0, 0, 0); }
        }
#pragma unroll
        for (int n = 0; n < 4; ++n)
#pragma unroll
            for (int j = 0; j < 4; ++j) P.pga[(size_t)(rb * 16 + fq * 4 + j) * GA + n * 16 + fr] = acc[n][j];
    }
}

constexpr int TS = 272;
constexpr int TS64 = 144;
constexpr int VS = 304;

__device__ __forceinline__ int chunk_row0(int b, int pc) { return pc < 2 ? NLAT + b * CTX + pc * 128 : b * SEQ + (pc - 2) * 128; }
__device__ __forceinline__ int virt_pc(int dir, int j) { return dir == 0 ? j : (j == 0 ? 1 : (j == 1 ? 0 : 67 - j)); }
__device__ __forceinline__ float wave_incl_sum(float s, int lane) {
#pragma unroll
    for (int o = 1; o < 64; o <<= 1) { const float y = __shfl_up(s, o); if (lane >= o) s += y; }
    return s;
}
__device__ __forceinline__ float wave_incl_max(float s, int lane) {
#pragma unroll
    for (int o = 1; o < 64; o <<= 1) { const float y = __shfl_up(s, o); if (lane >= o) s = fmaxf(s, y); }
    return s;
}
__device__ __forceinline__ float wave_max(float v) {
#pragma unroll
    for (int o = 32; o > 0; o >>= 1) v = fmaxf(v, __shfl_xor(v, o));
    return v;
}
__device__ __forceinline__ bf16x8 mk_frag(u32x2 lo, u32x2 hi) { u32x4 v; v.x = lo.x; v.y = lo.y; v.z = hi.x; v.w = hi.y; return __builtin_bit_cast(bf16x8, v); }
template <int HI>
__device__ __forceinline__ bf16x8 tr_read1(unsigned addr) {
    u32x2 lo, hi;
    asm volatile("ds_read_b64_tr_b16 %0, %2\n\tds_read_b64_tr_b16 %1, %2 offset:%3\n\ts_waitcnt lgkmcnt(0)" : "=&v"(lo), "=&v"(hi) : "v"(addr), "i"(HI) : "memory");
    return mk_frag(lo, hi);
}
template <int HI, int FS>
__device__ __forceinline__ void tr_read4(unsigned addr, bf16x8& f0, bf16x8& f1, bf16x8& f2, bf16x8& f3) {
    u32x2 a0, a1, b0, b1, c0, c1, d0, d1;
    asm volatile("ds_read_b64_tr_b16 %0, %8\n\t"
                 "ds_read_b64_tr_b16 %1, %8 offset:%9\n\t"
                 "ds_read_b64_tr_b16 %2, %8 offset:%10\n\t"
                 "ds_read_b64_tr_b16 %3, %8 offset:%11\n\t"
                 "ds_read_b64_tr_b16 %4, %8 offset:%12\n\t"
                 "ds_read_b64_tr_b16 %5, %8 offset:%13\n\t"
                 "ds_read_b64_tr_b16 %6, %8 offset:%14\n\t"
                 "ds_read_b64_tr_b16 %7, %8 offset:%15\n\t"
                 "s_waitcnt lgkmcnt(0)"
                 : "=&v"(a0), "=&v"(a1), "=&v"(b0), "=&v"(b1), "=&v"(c0), "=&v"(c1), "=&v"(d0), "=&v"(d1)
                 : "v"(addr), "i"(HI), "i"(FS), "i"(FS + HI), "i"(2 * FS), "i"(2 * FS + HI), "i"(3 * FS), "i"(3 * FS + HI)
                 : "memory");
    f0 = mk_frag(a0, a1); f1 = mk_frag(b0, b1); f2 = mk_frag(c0, c1); f3 = mk_frag(d0, d1);
}
__device__ __forceinline__ unsigned lds_addr(LAS unsigned char* p) { return (unsigned)(size_t)p; }
__device__ __forceinline__ void unpack8(const u32x4 u, float (&f)[8]) { f[0] = bflo(u.x); f[1] = bfhi(u.x); f[2] = bflo(u.y); f[3] = bfhi(u.y); f[4] = bflo(u.z); f[5] = bfhi(u.z); f[6] = bflo(u.w); f[7] = bfhi(u.w); }
__device__ __forceinline__ u32x4 pack8(const float (&f)[8]) { u32x4 o; o.x = pk2(f[0], f[1]); o.y = pk2(f[2], f[3]); o.z = pk2(f[4], f[5]); o.w = pk2(f[6], f[7]); return o; }
#define MFMA16(a, b, c) __builtin_amdgcn_mfma_f32_16x16x32_bf16(a, b, c, 0, 0, 0)

__device__ __forceinline__ void ma_mlstm(const Params& P, LAS unsigned char* lds, int l, int b, int h, int pc) {
    const int tid = ltid(), lane = tid & 63, wid = __builtin_amdgcn_readfirstlane(tid >> 6);
    LAS unsigned char* Kt = lds; LAS unsigned char* Vf = lds + 34816; LAS unsigned char* Vb = lds + 69632;
    LAS float* sc = (LAS float*)(lds + 104448);
    LAS float* red = sc + 6 * 128;
    const int row0 = chunk_row0(b, pc), sq0 = (b * 4 + h) * 2;
    if (tid < 128) {
        const float* ga = P.pga + (size_t)(row0 + tid) * GA; const float* bg = P.b_ml_gates + l * 16;
        sc[tid] = ga[h] + bg[h]; sc[128 + tid] = logsigmoidf(ga[4 + h] + bg[4 + h]); sc[256 + tid] = ga[8 + h] + bg[8 + h]; sc[384 + tid] = logsigmoidf(ga[12 + h] + bg[12 + h]);
    }
    __syncthreads();
    if (wid < 2) {
        const int dir = wid; LAS float* li = sc + dir * 256; LAS float* lf = li + 128; LAS float* e = sc + 512 + dir * 128;
        const int t0 = dir ? 127 - 2 * lane : 2 * lane, t1 = dir ? 126 - 2 * lane : 2 * lane + 1;
        const float x0 = lf[t0], x1 = lf[t1];
        const float incl = wave_incl_sum(x0 + x1, lane);
        const float b0 = incl - x1, b1 = incl;
        const float bend = __int_as_float(__builtin_amdgcn_readlane(__float_as_int(incl), 63));
        const float w0 = bend - b0 + li[t0], w1 = bend - b1 + li[t1];
        const float mk = wave_max(fmaxf(w0, w1));
        e[t0] = __expf(w0 - mk); e[t1] = __expf(w1 - mk);
        if (lane == 0) { float* ms = P.mstat + ((size_t)(sq0 + dir) * 66 + pc) * 2; ms[0] = bend; ms[1] = mk; }
    }
    __syncthreads();
    {
        const int c8 = tid & 15, tb = tid >> 4, qc = h * 128 + c8 * 8;
        const float* cw = P.conv_qk + (size_t)l * 3 * 1024;
        const bool segstart = (pc == 0 || pc == 2), segend = (pc == 1 || pc == 65);
        float wq[3][8], wk[3][8];
#pragma unroll
        for (int j = 0; j < 3; ++j)
#pragma unroll
            for (int e4 = 0; e4 < 2; ++e4) {
                const float4 a = *(const float4*)(cw + j * 1024 + qc + e4 * 4), c = *(const float4*)(cw + j * 1024 + 512 + qc + e4 * 4);
                wq[j][e4 * 4 + 0] = a.x; wq[j][e4 * 4 + 1] = a.y; wq[j][e4 * 4 + 2] = a.z; wq[j][e4 * 4 + 3] = a.w;
                wk[j][e4 * 4 + 0] = c.x; wk[j][e4 * 4 + 1] = c.y; wk[j][e4 * 4 + 2] = c.z; wk[j][e4 * 4 + 3] = c.w;
            }
#pragma unroll 1
        for (int i = 0; i < 4; ++i) {
            const int t = tb + 32 * i, row = row0 + t;
            const bf16_t* pr = P.p + (size_t)row * PN;
            const bool hasL = !(t == 0 && segstart), hasR = !(t == 127 && segend);
            unsigned zz = 0u; asm volatile("" : "+v"(zz)); u32x4 z; z.x = zz; z.y = zz; z.z = zz; z.w = zz;
            const u32x4 q0 = hasL ? *(const u32x4*)(pr - PN + P_MLQ + qc) : z, q1 = *(const u32x4*)(pr + P_MLQ + qc), q2 = hasR ? *(const u32x4*)(pr + PN + P_MLQ + qc) : z;
            const u32x4 k0 = hasL ? *(const u32x4*)(pr - PN + P_MLK + qc) : z, k1 = *(const u32x4*)(pr + P_MLK + qc), k2 = hasR ? *(const u32x4*)(pr + PN + P_MLK + qc) : z;
            const u32x4 vv = *(const u32x4*)(pr + P_MLV + qc);
            float a0[8], a1[8], a2[8], r[8];
            unpack8(q0, a0); unpack8(q1, a1); unpack8(q2, a2);
#pragma unroll
            for (int e = 0; e < 8; ++e) r[e] = siluf(wq[0][e] * a0[e] + wq[1][e] * a1[e] + wq[2][e] * a2[e]);
            *(u32x4*)(P.qk + (size_t)row * 1024 + qc) = pack8(r);
            unpack8(k0, a0); unpack8(k1, a1); unpack8(k2, a2);
#pragma unroll
            for (int e = 0; e < 8; ++e) r[e] = siluf(wk[0][e] * a0[e] + wk[1][e] * a1[e] + wk[2][e] * a2[e]);
            const u32x4 kp = pack8(r);
            *(u32x4*)(P.qk + (size_t)row * 1024 + 512 + qc) = kp;
            *(LAS u32x4*)(Kt + t * TS + c8 * 16) = kp;
            unpack8(vv, a0);
            const float ef = sc[512 + t], eb = sc[640 + t];
#pragma unroll
            for (int e = 0; e < 8; ++e) { a1[e] = a0[e] * ef; a2[e] = a0[e] * eb; }
            *(LAS u32x4*)(Vf + t * TS + c8 * 16) = pack8(a1);
            *(LAS u32x4*)(Vb + t * TS + c8 * 16) = pack8(a2);
        }
    }
    __syncthreads();
    unsigned char* imgf = (unsigned char*)P.ml_ck + ((size_t)(sq0 + 0) * 66 + pc) * ML_IMG;
    unsigned char* imgb = (unsigned char*)P.ml_ck + ((size_t)(sq0 + 1) * 66 + pc) * ML_IMG;
    {
        const int g = lane >> 4, fr = lane & 15, q4 = fr >> 2, p4 = lane & 3;
        f32x4 accf[8], accb[8];
#pragma unroll
        for (int n = 0; n < 8; ++n) { accf[n] = (f32x4){0.f, 0.f, 0.f, 0.f}; accb[n] = (f32x4){0.f, 0.f, 0.f, 0.f}; }
        const unsigned kb = lds_addr(Kt), vfb = lds_addr(Vf), vbb = lds_addr(Vb);
#pragma unroll 1
        for (int ks = 0; ks < 4; ++ks) {
            const unsigned ro = (unsigned)((32 * ks + 8 * g + q4) * TS + 8 * p4);
            const bf16x8 af = tr_read1<4 * TS>(vfb + ro + wid * 32), ab = tr_read1<4 * TS>(vbb + ro + wid * 32);
            bf16x8 bfr[8];
            tr_read4<4 * TS, 32>(kb + ro, bfr[0], bfr[1], bfr[2], bfr[3]);
            tr_read4<4 * TS, 32>(kb + ro + 128, bfr[4], bfr[5], bfr[6], bfr[7]);
#pragma unroll
            for (int n = 0; n < 8; ++n) { accf[n] = MFMA16(af, bfr[n], accf[n]); accb[n] = MFMA16(ab, bfr[n], accb[n]); }
        }
#pragma unroll
        for (int n = 0; n < 8; ++n) {
            const int k = 16 * n + fr, v0 = 16 * wid + 4 * g;
            u32x2 o; o.x = pk2(accf[n][0], accf[n][1]); o.y = pk2(accf[n][2], accf[n][3]); *(u32x2*)(imgf + k * TS + v0 * 2) = o;
            o.x = pk2(accb[n][0], accb[n][1]); o.y = pk2(accb[n][2], accb[n][3]); *(u32x2*)(imgb + k * TS + v0 * 2) = o;
        }
    }
    {
        const int k = tid & 127, part = tid >> 7; float nf = 0.f, nb = 0.f;
#pragma unroll 8
        for (int s = part * 32; s < part * 32 + 32; ++s) { const float kv = bf2f(*(LAS bf16_t*)(Kt + s * TS + k * 2)); nf += sc[512 + s] * kv; nb += sc[640 + s] * kv; }
        red[(part * 2 + 0) * 128 + k] = nf; red[(part * 2 + 1) * 128 + k] = nb;
    }
    __syncthreads();
    if (tid < 256) {
        const int dir = tid >> 7, k = tid & 127;
        const float n = red[(0 * 2 + dir) * 128 + k] + red[(1 * 2 + dir) * 128 + k] + red[(2 * 2 + dir) * 128 + k] + red[(3 * 2 + dir) * 128 + k];
        unsigned zz = 0u; asm volatile("" : "+v"(zz));
        u32x4 o; o.x = pk2(n, 0.f); o.y = zz; o.z = zz; o.w = zz;
        *(u32x4*)((dir ? imgb : imgf) + k * TS + 256) = o;
    }
    __syncthreads();
}

__device__ __forceinline__ void gla_gates(const Params& P, LAS float* alr  , LAS float* segtot  , int l, int h, int tid, float (&bF)[16], float (&bB)[16], float& totF, float& totB) {
    const int k = tid & 63, seg = tid >> 6;
    const float* w2 = P.w_gla_a2 + (size_t)l * 2 * 16 * 256; const float* ba = P.b_gla_a + (size_t)l * 2 * 256;
    float wf[16], wb[16];
#pragma unroll
    for (int r = 0; r < 16; ++r) { wf[r] = w2[(0 * 16 + r) * 256 + h * 64 + k]; wb[r] = w2[(1 * 16 + r) * 256 + h * 64 + k]; }
    const float baf = ba[h * 64 + k], bab = ba[256 + h * 64 + k];
#pragma unroll
    for (int tt = 0; tt < 16; ++tt) {
        const LAS float* ar = alr + (seg * 16 + tt) * 32;
        float xf = baf, xb = bab;
#pragma unroll
        for (int r = 0; r < 16; ++r) { xf += ar[r] * wf[r]; xb += ar[16 + r] * wb[r]; }
        bF[tt] = logsigmoidf(xf) * (1.f / 16.f); bB[tt] = logsigmoidf(xb) * (1.f / 16.f);
    }
#pragma unroll
    for (int tt = 1; tt < 16; ++tt) bF[tt] += bF[tt - 1];
#pragma unroll
    for (int tt = 14; tt >= 0; --tt) bB[tt] += bB[tt + 1];
    segtot[(0 * 8 + seg) * 64 + k] = bF[15]; segtot[(1 * 8 + seg) * 64 + k] = bB[0];
    __syncthreads();
    float offF = 0.f, offB = 0.f; totF = 0.f; totB = 0.f;
#pragma unroll
    for (int s2 = 0; s2 < 8; ++s2) { const float a = segtot[(0 * 8 + s2) * 64 + k], c = segtot[(1 * 8 + s2) * 64 + k]; totF += a; totB += c; offF += (s2 < seg) ? a : 0.f; offB += (s2 > seg) ? c : 0.f; }
#pragma unroll
    for (int tt = 0; tt < 16; ++tt) { bF[tt] += offF; bB[tt] += offB; }
}
__device__ __forceinline__ void gla_stage_alr(const Params& P, LAS float* alr, int row0, int tid) {
    const int t = tid >> 2, part = tid & 3;
    const float* src = P.pga + (size_t)(row0 + t) * GA + 16 + part * 8;
    const f32x4 a = *(const f32x4*)src, c = *(const f32x4*)(src + 4);
    *(LAS f32x4*)(alr + t * 32 + part * 8) = a; *(LAS f32x4*)(alr + t * 32 + part * 8 + 4) = c;
}

__device__ __forceinline__ void ma_gla(const Params& P, LAS unsigned char* lds, int l, int b, int h, int pc) {
    const int tid = ltid(), lane = tid & 63, wid = __builtin_amdgcn_readfirstlane(tid >> 6);
    LAS unsigned char* Vt = lds; LAS unsigned char* Kdf = lds + 34816; LAS unsigned char* Kdb = lds + 53248;
    LAS float* alr = (LAS float*)(lds + 71680); LAS float* segtot = (LAS float*)(lds + 88064);
    const int row0 = chunk_row0(b, pc), sq0 = (b * 4 + h) * 2;
    gla_stage_alr(P, alr, row0, tid);
#pragma unroll
    for (int i = 0; i < 4; ++i) { const int id = tid + 512 * i, t = id >> 4, c = id & 15; *(LAS u32x4*)(Vt + t * TS + c * 16) = *(const u32x4*)(P.p + (size_t)(row0 + t) * PN + P_GV + h * 128 + c * 8); }
    __syncthreads();
    {
        float bF[16], bB[16], totF, totB;
        gla_gates(P, alr, segtot, l, h, tid, bF, bB, totF, totB);
        const int k = tid & 63, seg = tid >> 6;
#pragma unroll
        for (int tt = 0; tt < 16; ++tt) {
            const int t = seg * 16 + tt;
            const float kr = bf2f(P.p[(size_t)(row0 + t) * PN + P_GK + h * 64 + k]);
            const unsigned pf = pk2(kr * __expf(totF - bF[tt]), kr * __expf(totB - bB[tt]));
            *(LAS bf16_t*)(Kdf + t * TS64 + k * 2) = (bf16_t)(pf & 0xffffu); *(LAS bf16_t*)(Kdb + t * TS64 + k * 2) = (bf16_t)(pf >> 16);
        }
        if (seg == 0) { P.gbend[((size_t)(sq0 + 0) * 66 + pc) * 64 + k] = totF; P.gbend[((size_t)(sq0 + 1) * 66 + pc) * 64 + k] = totB; }
    }
    __syncthreads();
    unsigned char* imgf = (unsigned char*)P.gl_ck + ((size_t)(sq0 + 0) * 66 + pc) * GL_IMG;
    unsigned char* imgb = (unsigned char*)P.gl_ck + ((size_t)(sq0 + 1) * 66 + pc) * GL_IMG;
    {
        const int g = lane >> 4, fr = lane & 15, q4 = fr >> 2, p4 = lane & 3;
        f32x4 accf[4], accb[4];
#pragma unroll
        for (int n = 0; n < 4; ++n) { accf[n] = (f32x4){0.f, 0.f, 0.f, 0.f}; accb[n] = (f32x4){0.f, 0.f, 0.f, 0.f}; }
        const unsigned vb = lds_addr(Vt), kfb = lds_addr(Kdf), kbb = lds_addr(Kdb);
#pragma unroll 1
        for (int ks = 0; ks < 4; ++ks) {
            const int rr = 32 * ks + 8 * g + q4;
            const bf16x8 a = tr_read1<4 * TS>(vb + (unsigned)(rr * TS + 8 * p4) + wid * 32);
            bf16x8 bf[4], bb[4];
            tr_read4<4 * TS64, 32>(kfb + (unsigned)(rr * TS64 + 8 * p4), bf[0], bf[1], bf[2], bf[3]);
            tr_read4<4 * TS64, 32>(kbb + (unsigned)(rr * TS64 + 8 * p4), bb[0], bb[1], bb[2], bb[3]);
#pragma unroll
            for (int n = 0; n < 4; ++n) { accf[n] = MFMA16(a, bf[n], accf[n]); accb[n] = MFMA16(a, bb[n], accb[n]); }
        }
#pragma unroll
        for (int n = 0; n < 4; ++n) {
            const int k = 16 * n + fr, v0 = 16 * wid + 4 * g;
            u32x2 o; o.x = pk2(accf[n][0], accf[n][1]); o.y = pk2(accf[n][2], accf[n][3]); *(u32x2*)(imgf + k * TS + v0 * 2) = o;
            o.x = pk2(accb[n][0], accb[n][1]); o.y = pk2(accb[n][2], accb[n][3]); *(u32x2*)(imgb + k * TS + v0 * 2) = o;
        }
    }
    if (tid < 128) { const int dir = tid >> 6, k = tid & 63; unsigned zz = 0u; asm volatile("" : "+v"(zz)); u32x4 o; o.x = zz; o.y = zz; o.z = zz; o.w = zz; *(u32x4*)((dir ? imgb : imgf) + k * TS + 256) = o; }
    __syncthreads();
}

__device__ __forceinline__ void phase_mix_a(const Params& P, LAS unsigned char* lds, int l, int wg, int nwg) {
    for (int it = wg; it < 2 * 8 * 66; it += nwg) {
        const int mixer = it / 528, r = it % 528, bh = r / 66, pc = r % 66;
        if (mixer == 0) ma_mlstm(P, lds, l, bh >> 2, bh & 3, pc); else ma_gla(P, lds, l, bh >> 2, bh & 3, pc);
    }
}

__device__ __forceinline__ void phase_mix_b(const Params& P, int wg, int nwg) {
    constexpr int MLC = ML_IMG / 16, GLC = GL_IMG / 16;
    const int gt = wg * NTHR + ltid(), ngt = nwg * NTHR;
    for (int task = gt; task < 16 * (MLC + GLC); task += ngt) {
        float st[8];
#pragma unroll
        for (int e = 0; e < 8; ++e) st[e] = 0.f;
        if (task < 16 * MLC) {
            const int sq = task / MLC, ci = task % MLC, dir = sq & 1;
            const unsigned char* src = (const unsigned char*)P.ml_ck + (size_t)sq * 66 * ML_IMG + ci * 16;
            unsigned char* dst = (unsigned char*)P.ml_pre + (size_t)sq * 66 * ML_IMG + ci * 16;
            const float* ms = P.mstat + (size_t)sq * 66 * 2;
            float m = 0.f;
#pragma unroll 1
            for (int j0 = 0; j0 < 66; j0 += 11) {
                u32x4 cv[11]; float be[11], mk[11];
#pragma unroll
                for (int u = 0; u < 11; ++u) { const int pc = virt_pc(dir, j0 + u); cv[u] = *(const u32x4*)(src + (size_t)pc * ML_IMG); be[u] = ms[pc * 2]; mk[u] = ms[pc * 2 + 1]; }
#pragma unroll
                for (int u = 0; u < 11; ++u) {
                    const int pc = virt_pc(dir, j0 + u);
                    *(u32x4*)(dst + (size_t)pc * ML_IMG) = pack8(st);
                    if (ci == 0) P.mprev[sq * 66 + pc] = m;
                    const float mn = fmaxf(be[u] + m, mk[u]), ao = __expf(be[u] + m - mn), an = __expf(mk[u] - mn);
                    float c[8]; unpack8(cv[u], c);
#pragma unroll
                    for (int e = 0; e < 8; ++e) st[e] = ao * st[e] + an * c[e];
                    m = mn;
                }
            }
        } else {
            const int t2 = task - 16 * MLC, sq = t2 / GLC, ci = t2 % GLC, dir = sq & 1, k = (ci * 16) / TS;
            const unsigned char* src = (const unsigned char*)P.gl_ck + (size_t)sq * 66 * GL_IMG + ci * 16;
            unsigned char* dst = (unsigned char*)P.gl_pre + (size_t)sq * 66 * GL_IMG + ci * 16;
            const float* gb = P.gbend + (size_t)sq * 66 * 64 + k;
#pragma unroll 1
            for (int j0 = 0; j0 < 66; j0 += 11) {
                u32x4 cv[11]; float be[11];
#pragma unroll
                for (int u = 0; u < 11; ++u) { const int pc = virt_pc(dir, j0 + u); cv[u] = *(const u32x4*)(src + (size_t)pc * GL_IMG); be[u] = gb[pc * 64]; }
#pragma unroll
                for (int u = 0; u < 11; ++u) {
                    const int pc = virt_pc(dir, j0 + u);
                    *(u32x4*)(dst + (size_t)pc * GL_IMG) = pack8(st);
                    const float dc = __expf(be[u]);
                    float c[8]; unpack8(cv[u], c);
#pragma unroll
                    for (int e = 0; e < 8; ++e) st[e] = dc * st[e] + c[e];
                }
            }
        }
    }
}

__device__ __forceinline__ void mc_mlstm(const Params& P, LAS unsigned char* lds, int l, int b, int h, int pc) {
    const int tid = ltid(), lane = tid & 63, wid = __builtin_amdgcn_readfirstlane(tid >> 6);
    const int g = lane >> 4, fr = lane & 15, q4 = fr >> 2, p4 = lane & 3;
    LAS unsigned char* Qt = lds; LAS unsigned char* Kt = lds + 34816; LAS unsigned char* V1 = lds + 69632; LAS unsigned char* CT = lds + 108544;
    LAS float* sc = (LAS float*)(lds + 143488);
    const int row0 = chunk_row0(b, pc), sq0 = (b * 4 + h) * 2;
    const float scale = 0.08838834764831845f;
    if (tid < 128) {
        const float* ga = P.pga + (size_t)(row0 + tid) * GA; const float* bg = P.b_ml_gates + l * 16;
        sc[tid] = ga[h] + bg[h]; sc[128 + tid] = logsigmoidf(ga[4 + h] + bg[4 + h]); sc[256 + tid] = ga[8 + h] + bg[8 + h]; sc[384 + tid] = logsigmoidf(ga[12 + h] + bg[12 + h]);
        unsigned zz = 0u; asm volatile("" : "+v"(zz));
        u32x4 o; o.x = zz | 0x00003F80u; o.y = zz; o.z = zz; o.w = zz;
        *(LAS u32x4*)(V1 + tid * VS + 256) = o; o.x = zz; *(LAS u32x4*)(V1 + tid * VS + 272) = o; *(LAS u32x4*)(V1 + tid * VS + 288) = o;
    }
#pragma unroll
    for (int i = 0; i < 4; ++i) {
        const int id = tid + 512 * i, t = id >> 4, c = id & 15;
        *(LAS u32x4*)(Qt + t * TS + c * 16) = *(const u32x4*)(P.qk + (size_t)(row0 + t) * 1024 + h * 128 + c * 8);
        *(LAS u32x4*)(Kt + t * TS + c * 16) = *(const u32x4*)(P.qk + (size_t)(row0 + t) * 1024 + 512 + h * 128 + c * 8);
        *(LAS u32x4*)(V1 + t * VS + c * 16) = *(const u32x4*)(P.p + (size_t)(row0 + t) * PN + P_MLV + h * 128 + c * 8);
    }
    {
        const unsigned char* img = (const unsigned char*)P.ml_pre + ((size_t)(sq0 + 0) * 66 + pc) * ML_IMG;
        for (int id = tid; id < ML_IMG / 16; id += NTHR) *(LAS u32x4*)(CT + id * 16) = *(const u32x4*)(img + id * 16);
    }
    __syncthreads();
    if (wid < 2) {
        const int dir = wid; LAS float* li = sc + dir * 256; LAS float* lf = li + 128; LAS float* o = sc + (4 + 4 * dir) * 128;
        const int t0 = dir ? 127 - 2 * lane : 2 * lane, t1 = dir ? 126 - 2 * lane : 2 * lane + 1;
        const float x0 = lf[t0], x1 = lf[t1];
        const float incl = wave_incl_sum(x0 + x1, lane);
        const float b0 = incl - x1, b1 = incl;
        const float g0 = li[t0] - b0, g1 = li[t1] - b1;
        const float pmx = wave_incl_max(fmaxf(g0, g1), lane);
        float pex = __shfl_up(pmx, 1); if (lane == 0) pex = -3.0e38f;
        const float pm0 = fmaxf(pex, g0), pm1 = pmx;
        const float mp = P.mprev[(sq0 + dir) * 66 + pc];
        const float m0 = fmaxf(b0 + mp, b0 + pm0), m1 = fmaxf(b1 + mp, b1 + pm1);
        o[t0] = b0 - m0; o[128 + t0] = g0; o[256 + t0] = __expf(b0 + mp - m0); o[384 + t0] = __expf(-m0);
        o[t1] = b1 - m1; o[128 + t1] = g1; o[256 + t1] = __expf(b1 + mp - m1); o[384 + t1] = __expf(-m1);
    }
    __syncthreads();
    bf16x8 qf[4];
#pragma unroll
    for (int kk = 0; kk < 4; ++kk) qf[kk] = *(const LAS bf16x8*)(Qt + (16 * wid + fr) * TS + (32 * kk + 8 * g) * 2);
    f32x4 hsum[8];
#pragma unroll
    for (int n = 0; n < 8; ++n) hsum[n] = (f32x4){0.f, 0.f, 0.f, 0.f};
    const unsigned ctb = lds_addr(CT), v1b = lds_addr(V1);
    const int tq = 16 * wid + fr;
#pragma unroll 1
    for (int dir = 0; dir < 2; ++dir) {
        if (dir == 1) {
            __syncthreads();
            const unsigned char* img = (const unsigned char*)P.ml_pre + ((size_t)(sq0 + 1) * 66 + pc) * ML_IMG;
            for (int id = tid; id < ML_IMG / 16; id += NTHR) *(LAS u32x4*)(CT + id * 16) = *(const u32x4*)(img + id * 16);
            __syncthreads();
        }
        LAS float* so = sc + (4 + 4 * dir) * 128;
        f32x4 acc[9];
#pragma unroll
        for (int n = 0; n < 9; ++n) acc[n] = (f32x4){0.f, 0.f, 0.f, 0.f};
#pragma unroll
        for (int kk = 0; kk < 4; ++kk) {
            const unsigned ro = ctb + (unsigned)((32 * kk + 8 * g + q4) * TS + 8 * p4);
            bf16x8 bfr[9];
            tr_read4<4 * TS, 32>(ro, bfr[0], bfr[1], bfr[2], bfr[3]);
            tr_read4<4 * TS, 32>(ro + 128, bfr[4], bfr[5], bfr[6], bfr[7]);
            bfr[8] = tr_read1<4 * TS>(ro + 256);
#pragma unroll
            for (int n = 0; n < 9; ++n) acc[n] = MFMA16(qf[kk], bfr[n], acc[n]);
        }
#pragma unroll
        for (int j = 0; j < 4; ++j) { const float as = so[256 + 16 * wid + 4 * g + j] * scale;
#pragma unroll
            for (int n = 0; n < 9; ++n) acc[n][j] *= as; }
        const float ut = so[tq];
        const int ilo = dir ? (wid >> 1) : 0, ihi = dir ? 3 : (wid >> 1);
#pragma unroll 1
        for (int i = ilo; i <= ihi; ++i) {
            unsigned pw[4];
#pragma unroll
            for (int half = 0; half < 2; ++half) {
                const int sb = 2 * i + half;
                f32x4 d = (f32x4){0.f, 0.f, 0.f, 0.f};
#pragma unroll
                for (int kk = 0; kk < 4; ++kk) { const bf16x8 kf = *(const LAS bf16x8*)(Kt + (16 * sb + fr) * TS + (32 * kk + 8 * g) * 2); d = MFMA16(kf, qf[kk], d); }
                float pv[4];
#pragma unroll
                for (int j = 0; j < 4; ++j) {
                    const int s = 16 * sb + 4 * g + j;
                    const bool valid = dir ? (s >= tq) : (s <= tq);
                    const float arg = ut + so[128 + s];
                    pv[j] = valid ? d[j] * scale * __expf(arg) : 0.f;
                }
                pw[half * 2 + 0] = pk2(pv[0], pv[1]); pw[half * 2 + 1] = pk2(pv[2], pv[3]);
            }
            u32x4 pu; pu.x = pw[0]; pu.y = pw[1]; pu.z = pw[2]; pu.w = pw[3];
            const bf16x8 pa = __builtin_bit_cast(bf16x8, pu);
            const unsigned ro = v1b + (unsigned)((32 * i + 4 * g + q4) * VS + 8 * p4);
            bf16x8 bfr[9];
            tr_read4<16 * VS, 32>(ro, bfr[0], bfr[1], bfr[2], bfr[3]);
            tr_read4<16 * VS, 32>(ro + 128, bfr[4], bfr[5], bfr[6], bfr[7]);
            bfr[8] = tr_read1<16 * VS>(ro + 256);
#pragma unroll
            for (int n = 0; n < 9; ++n) acc[n] = MFMA16(pa, bfr[n], acc[n]);
        }
#pragma unroll
        for (int j = 0; j < 4; ++j) {
            const float den = __shfl(acc[8][j], lane & 48);
            const float dn = fmaxf(fabsf(den), so[384 + 16 * wid + 4 * g + j]);
            const float inv = 1.f / dn;
#pragma unroll
            for (int n = 0; n < 8; ++n) hsum[n][j] += acc[n][j] * inv;
        }
    }
    const float* gml = P.g_ml_norm + l * 512 + h * 128;
    __syncthreads();
#pragma unroll
    for (int j = 0; j < 4; ++j) {
        float ss = 0.f;
#pragma unroll
        for (int n = 0; n < 8; ++n) ss += hsum[n][j] * hsum[n][j];
        ss += __shfl_xor(ss, 1); ss += __shfl_xor(ss, 2); ss += __shfl_xor(ss, 4); ss += __shfl_xor(ss, 8);
        const float rstd = rsqrtf(ss * (1.f / 128.f) + EPS);
#pragma unroll
        for (int n = 0; n < 8; ++n) { const int v = 16 * n + fr; *(LAS bf16_t*)(Qt + (16 * wid + 4 * g + j) * TS + v * 2) = (bf16_t)(pk2(hsum[n][j] * rstd * gml[v], 0.f) & 0xffffu); }
    }
    __syncthreads();
#pragma unroll
    for (int i = 0; i < 4; ++i) {
        const int id = tid + 512 * i, t = id >> 4, c = id & 15;
        float a[8], og[8];
        unpack8(*(const LAS u32x4*)(Qt + t * TS + c * 16), a);
        unpack8(*(const u32x4*)(P.p + (size_t)(row0 + t) * PN + P_MLO + h * 128 + c * 8), og);
#pragma unroll
        for (int e = 0; e < 8; ++e) a[e] *= sigmoidf(og[e]);
        *(u32x4*)(P.abuf + (size_t)(row0 + t) * 1024 + h * 128 + c * 8) = pack8(a);
    }
    __syncthreads();
}

__device__ __forceinline__ void mc_gla(const Params& P, LAS unsigned char* lds, int l, int b, int h, int pc) {
    const int tid = ltid(), lane = tid & 63, wid = __builtin_amdgcn_readfirstlane(tid >> 6);
    const int g = lane >> 4, fr = lane & 15, q4 = fr >> 2, p4 = lane & 3;
    LAS unsigned char* Qf = lds; LAS unsigned char* Kf = lds + 18432; LAS unsigned char* Qb = lds + 36864; LAS unsigned char* Kb = lds + 55296;
    LAS unsigned char* Vt = lds + 73728; LAS unsigned char* Sf = lds + 108544; LAS unsigned char* Sb = lds + 126080;
    LAS float* segtot = (LAS float*)(lds + 143616);
    LAS float* alr = (LAS float*)Sf;
    const int row0 = chunk_row0(b, pc), sq0 = (b * 4 + h) * 2;
    gla_stage_alr(P, alr, row0, tid);
    __syncthreads();
    {
        float bF[16], bB[16], totF, totB;
        gla_gates(P, alr, segtot, l, h, tid, bF, bB, totF, totB);
        const int k = tid & 63, seg = tid >> 6;
#pragma unroll
        for (int tt = 0; tt < 16; ++tt) {
            const int t = seg * 16 + tt;
            const float qr = bf2f(P.p[(size_t)(row0 + t) * PN + P_GQ + h * 64 + k]) * 0.125f, kr = bf2f(P.p[(size_t)(row0 + t) * PN + P_GK + h * 64 + k]);
            const unsigned a = pk2(qr * __expf(bF[tt]), kr * __expf(-bF[tt])), c = pk2(qr * __expf(bB[tt]), kr * __expf(-bB[tt]));
            *(LAS bf16_t*)(Qf + t * TS64 + k * 2) = (bf16_t)(a & 0xffffu); *(LAS bf16_t*)(Kf + t * TS64 + k * 2) = (bf16_t)(a >> 16);
            *(LAS bf16_t*)(Qb + t * TS64 + k * 2) = (bf16_t)(c & 0xffffu); *(LAS bf16_t*)(Kb + t * TS64 + k * 2) = (bf16_t)(c >> 16);
        }
    }
    __syncthreads();
#pragma unroll
    for (int i = 0; i < 4; ++i) { const int id = tid + 512 * i, t = id >> 4, c = id & 15; *(LAS u32x4*)(Vt + t * TS + c * 16) = *(const u32x4*)(P.p + (size_t)(row0 + t) * PN + P_GV + h * 128 + c * 8); }
    {
        const unsigned char* i0 = (const unsigned char*)P.gl_pre + ((size_t)(sq0 + 0) * 66 + pc) * GL_IMG;
        const unsigned char* i1 = (const unsigned char*)P.gl_pre + ((size_t)(sq0 + 1) * 66 + pc) * GL_IMG;
        for (int id = tid; id < GL_IMG / 16; id += NTHR) { *(LAS u32x4*)(Sf + id * 16) = *(const u32x4*)(i0 + id * 16); *(LAS u32x4*)(Sb + id * 16) = *(const u32x4*)(i1 + id * 16); }
    }
    __syncthreads();
    f32x4 acc[8];
#pragma unroll
    for (int n = 0; n < 8; ++n) acc[n] = (f32x4){0.f, 0.f, 0.f, 0.f};
    const unsigned vtb = lds_addr(Vt);
    const int tq = 16 * wid + fr;
#pragma unroll 1
    for (int dir = 0; dir < 2; ++dir) {
        LAS unsigned char* Qd = dir ? Qb : Qf; LAS unsigned char* Kd = dir ? Kb : Kf;
        const unsigned sb_ = lds_addr(dir ? Sb : Sf);
        bf16x8 qf[2];
#pragma unroll
        for (int kk = 0; kk < 2; ++kk) qf[kk] = *(const LAS bf16x8*)(Qd + (16 * wid + fr) * TS64 + (32 * kk + 8 * g) * 2);
#pragma unroll
        for (int kk = 0; kk < 2; ++kk) {
            const unsigned ro = sb_ + (unsigned)((32 * kk + 8 * g + q4) * TS + 8 * p4);
            bf16x8 bfr[8];
            tr_read4<4 * TS, 32>(ro, bfr[0], bfr[1], bfr[2], bfr[3]);
            tr_read4<4 * TS, 32>(ro + 128, bfr[4], bfr[5], bfr[6], bfr[7]);
#pragma unroll
            for (int n = 0; n < 8; ++n) acc[n] = MFMA16(qf[kk], bfr[n], acc[n]);
        }
        const int ilo = dir ? (wid >> 1) : 0, ihi = dir ? 3 : (wid >> 1);
#pragma unroll 1
        for (int i = ilo; i <= ihi; ++i) {
            unsigned pw[4];
#pragma unroll
            for (int half = 0; half < 2; ++half) {
                const int sb = 2 * i + half;
                f32x4 d = (f32x4){0.f, 0.f, 0.f, 0.f};
#pragma unroll
                for (int kk = 0; kk < 2; ++kk) { const bf16x8 kf = *(const LAS bf16x8*)(Kd + (16 * sb + fr) * TS64 + (32 * kk + 8 * g) * 2); d = MFMA16(kf, qf[kk], d); }
                float pv[4];
#pragma unroll
                for (int j = 0; j < 4; ++j) { const int s = 16 * sb + 4 * g + j; const bool valid = dir ? (s >= tq) : (s <= tq); pv[j] = valid ? d[j] : 0.f; }
                pw[half * 2 + 0] = pk2(pv[0], pv[1]); pw[half * 2 + 1] = pk2(pv[2], pv[3]);
            }
            u32x4 pu; pu.x = pw[0]; pu.y = pw[1]; pu.z = pw[2]; pu.w = pw[3];
            const bf16x8 pa = __builtin_bit_cast(bf16x8, pu);
            const unsigned ro = vtb + (unsigned)((32 * i + 4 * g + q4) * TS + 8 * p4);
            bf16x8 bfr[8];
            tr_read4<16 * TS, 32>(ro, bfr[0], bfr[1], bfr[2], bfr[3]);
            tr_read4<16 * TS, 32>(ro + 128, bfr[4], bfr[5], bfr[6], bfr[7]);
#pragma unroll
            for (int n = 0; n < 8; ++n) acc[n] = MFMA16(pa, bfr[n], acc[n]);
        }
    }
    const float* ggl = P.g_gla_norm + l * 512 + h * 128;
    __syncthreads();
#pragma unroll
    for (int j = 0; j < 4; ++j) {
        float ss = 0.f;
#pragma unroll
        for (int n = 0; n < 8; ++n) ss += acc[n][j] * acc[n][j];
        ss += __shfl_xor(ss, 1); ss += __shfl_xor(ss, 2); ss += __shfl_xor(ss, 4); ss += __shfl_xor(ss, 8);
        const float rstd = rsqrtf(ss * (1.f / 128.f) + EPS);
#pragma unroll
        for (int n = 0; n < 8; ++n) { const int v = 16 * n + fr; *(LAS bf16_t*)(Vt + (16 * wid + 4 * g + j) * TS + v * 2) = (bf16_t)(pk2(acc[n][j] * rstd * ggl[v], 0.f) & 0xffffu); }
    }
    __syncthreads();
#pragma unroll
    for (int i = 0; i < 4; ++i) {
        const int id = tid + 512 * i, t = id >> 4, c = id & 15;
        float a[8], rg[8];
        unpack8(*(const LAS u32x4*)(Vt + t * TS + c * 16), a);
        unpack8(*(const u32x4*)(P.p + (size_t)(row0 + t) * PN + P_GR + h * 128 + c * 8), rg);
#pragma unroll
        for (int e = 0; e < 8; ++e) a[e] *= siluf(rg[e]);
        *(u32x4*)(P.abuf + (size_t)(row0 + t) * 1024 + 512 + h * 128 + c * 8) = pack8(a);
    }
    __syncthreads();
}

__device__ __forceinline__ void phase_mix_c(const Params& P, LAS unsigned char* lds, int l, int pc0, int wg, int nwg) {
    const int npc = 66 - pc0, per = 8 * npc;
    for (int it = wg; it < 2 * per; it += nwg) {
        const int mixer = it / per, r = it % per, bh = r / npc, pc = pc0 + r % npc;
        if (mixer == 0) mc_mlstm(P, lds, l, bh >> 2, bh & 3, pc); else mc_gla(P, lds, l, bh >> 2, bh & 3, pc);
    }
}


#define XB_TMO      128
#define XB_XCNT(j)  (256  + 64 * (j))
#define XB_XSUB(j)  (1280 + 64 * (j))
#define XB_XGEN(j)  (2304 + 64 * (j))
#define XB_TOP      3328
#define XB_TOPGEN   3392
#define XCD_BAR_WORDS 3456
#define XB_SPIN_CAP (1u << 22)
__device__ __forceinline__ unsigned xb_ld(unsigned* p)              { return __hip_atomic_load(p, __ATOMIC_RELAXED, __HIP_MEMORY_SCOPE_AGENT); }
__device__ __forceinline__ unsigned xb_add(unsigned* p, unsigned v) { return __hip_atomic_fetch_add(p, v, __ATOMIC_RELAXED, __HIP_MEMORY_SCOPE_AGENT); }
__device__ __forceinline__ unsigned xb_xcc_id() { return (unsigned)__builtin_amdgcn_s_getreg((3 << 11) | 20) & 0xFu; }
#define XB_SPIN(cond, bar) do { unsigned _sp = 0; while (cond) { __builtin_amdgcn_s_sleep(1); \
    if ((++_sp & 255u) == 0u) { if (xb_ld(&(bar)[XB_TMO])) break; if (_sp > XB_SPIN_CAP) { atomicAdd(&(bar)[XB_TMO], 1u); break; } } } } while (0)
struct XcdBarrier { unsigned* bar; unsigned x; volatile LAS unsigned* st; };
__device__ __forceinline__ XcdBarrier xcd_barrier_post(unsigned* bar, volatile LAS unsigned* st) {
    XcdBarrier b; b.bar = bar; b.x = xb_xcc_id(); b.st = st;
    if (threadIdx.x == 0) (void)xb_add(&bar[XB_XCNT(b.x)], 1u);
    return b;
}
__device__ __forceinline__ void xcd_barrier_complete(unsigned* bar, unsigned x, unsigned& nloc, unsigned& nx) {
    const unsigned G = gridDim.x * gridDim.y * gridDim.z;
    unsigned sum, cnt, mine, sp = 0u;
    for (;;) {
        sum = 0u; cnt = 0u; mine = 0u;
#pragma unroll
        for (unsigned j = 0; j < 16; ++j) { const unsigned c = xb_ld(&bar[XB_XCNT(j)]); sum += c; cnt += (c > 0u) ? 1u : 0u; mine = (j == x) ? c : mine; }
        if (sum == G) break;
        __builtin_amdgcn_s_sleep(1);
        if ((++sp & 255u) == 0u) { if (xb_ld(&bar[XB_TMO])) break; if (sp > XB_SPIN_CAP) { atomicAdd(&bar[XB_TMO], 1u); break; } }
    }
    nloc = mine > 0u ? mine : 1u; nx = cnt > 0u ? cnt : 1u;
}
__device__ __forceinline__ void xcd_barrier(const XcdBarrier& b) {
    asm volatile("s_waitcnt vmcnt(0)" ::: "memory");
    __syncthreads();
    if (threadIdx.x == 0) {
        unsigned* bar = b.bar;
        unsigned bx = b.x; asm volatile("" : "+v"(bx));
        __builtin_amdgcn_s_waitcnt(0);
        unsigned nloc = b.st[0], nx = b.st[1];
        if (nloc == 0u) { xcd_barrier_complete(bar, bx, nloc, nx); b.st[0] = nloc; b.st[1] = nx; }
        const unsigned old = xb_add(&bar[XB_XSUB(bx)], 1u);
        const unsigned gen = old / nloc;
        if (old + 1u == (gen + 1u) * nloc) {
            __builtin_amdgcn_fence(__ATOMIC_RELEASE, "agent");
            asm volatile("s_waitcnt vmcnt(0)" ::: "memory");
            const unsigned og = xb_add(&bar[XB_TOP], 1u);
            const unsigned tg = og / nx;
            if (og + 1u == (tg + 1u) * nx) xb_add(&bar[XB_TOPGEN], 1u);
            else XB_SPIN(xb_ld(&bar[XB_TOPGEN]) == tg, bar);
            __builtin_amdgcn_fence(__ATOMIC_ACQUIRE, "agent");
            xb_add(&bar[XB_XGEN(bx)], 1u);
            asm volatile("s_waitcnt vmcnt(0)" ::: "memory");
        } else {
            XB_SPIN(xb_ld(&bar[XB_XGEN(bx)]) == gen, bar);
            __builtin_amdgcn_fence(__ATOMIC_ACQUIRE, "agent");
            asm volatile("s_waitcnt vmcnt(0)" ::: "memory");
        }
    }
    __syncthreads();
}

__device__ __forceinline__ void topk_list(const Params& P, LAS unsigned char* lds, int list) {
    LAS unsigned* keys = (LAS unsigned*)lds;
    LAS unsigned* hist = keys + 8192;
    LAS unsigned* ctl = hist + 256;
    LAS unsigned* wsum = ctl + 4;
    const int tid = ltid(), lane = tid & 63, wid = tid >> 6;
    const int isctx = list >= 32, b = (list & 31) >> 4, e = list & 15;
    const int n = isctx ? CTX : SEQ, cap = n / 8;
    const int row0 = isctx ? NLAT + b * CTX : b * SEQ;
    const int segoff = isctx ? 2048 + b * 32 : b * 1024;
    for (int i = tid; i < n; i += NTHR) keys[i] = __float_as_uint(P.aff[(size_t)(row0 + i) * 16 + e]);
    unsigned prefix = 0u, mask = 0u; unsigned kth = (unsigned)cap;
    for (int pass = 0; pass < 4; ++pass) {
        const int shift = 24 - 8 * pass;
        if (tid < 256) hist[tid] = 0u;
        __syncthreads();
        for (int i = tid; i < n; i += NTHR) { const unsigned key = keys[i]; if ((key & mask) == prefix) __hip_atomic_fetch_add(&hist[(key >> shift) & 255u], 1u, __ATOMIC_RELAXED, __HIP_MEMORY_SCOPE_WORKGROUP); }
        __syncthreads();
        if (wid == 0) {
            const unsigned h0 = hist[4 * lane], h1 = hist[4 * lane + 1], h2 = hist[4 * lane + 2], h3 = hist[4 * lane + 3];
            const unsigned s = h0 + h1 + h2 + h3;
            unsigned suf = s;
#pragma unroll
            for (int o = 1; o < 64; o <<= 1) { const unsigned y = __shfl_down(suf, o); if (lane + o < 64) suf += y; }
            unsigned above = suf - s;
            if (above < kth && kth <= above + h3) { ctl[0] = 4 * lane + 3; ctl[1] = kth - above; }
            above += h3;
            if (above < kth && kth <= above + h2) { ctl[0] = 4 * lane + 2; ctl[1] = kth - above; }
            above += h2;
            if (above < kth && kth <= above + h1) { ctl[0] = 4 * lane + 1; ctl[1] = kth - above; }
            above += h1;
            if (above < kth && kth <= above + h0) { ctl[0] = 4 * lane + 0; ctl[1] = kth - above; }
        }
        __syncthreads();
        prefix |= ctl[0] << shift; mask |= 255u << shift; kth = ctl[1];
        __syncthreads();
    }
    const unsigned T = prefix, need_eq = kth;
    const int per = n / NTHR > 0 ? n / NTHR : 1;
    const int i0 = tid * per; const bool act = i0 < n;
    unsigned cgt = 0u, ceq = 0u;
    if (act) for (int i = 0; i < per; ++i) { const unsigned key = keys[i0 + i]; cgt += key > T; ceq += key == T; }
    const unsigned pk = (cgt << 16) | ceq; unsigned inc = pk;
#pragma unroll
    for (int o = 1; o < 64; o <<= 1) { const unsigned y = __shfl_up(inc, o); if (lane >= o) inc += y; }
    if (lane == 63) wsum[wid] = inc;
    __syncthreads();
    unsigned base = 0u;
    for (int w = 0; w < wid; ++w) base += wsum[w];
    const unsigned excl = base + inc - pk;
    unsigned gtb = excl >> 16, eqb = excl & 0xffffu;
    if (act) for (int i = 0; i < per; ++i) {
        const unsigned key = keys[i0 + i];
        int pr = -1;
        if (key > T) { pr = e * MZ + segoff + (int)(gtb + (eqb < need_eq ? eqb : need_eq)); ++gtb; }
        else if (key == T) { if (eqb < need_eq) pr = e * MZ + segoff + (int)(gtb + eqb); ++eqb; }
        if (pr >= 0) { P.glist[pr] = row0 + i0 + i; P.gval[pr] = __uint_as_float(key); }
        P.inv[(size_t)(row0 + i0 + i) * 16 + e] = pr;
    }
    __syncthreads();
}
__device__ __forceinline__ void phase_topk_prep(const Params& P, LAS unsigned char* lds, int l, int nlists, int wg, int nwg) {
    if (wg < nlists) topk_list(P, lds, wg);
    phase_prep_experts(P, lds, l, wg, nwg);
}

__device__ __forceinline__ void phase_rowop_post_pre(const Params& P, int l, int nrows, int wg, int nwg, int dry = 0) {
    const int tid_ = ltid(), lane = tid_ & 63, gw = wg * 8 + (tid_ >> 6), ngw = nwg * 8;
    const float* g_post = P.g_ffn_post + l * 1024;
    const bf16_t* yp = P.r1;
    const int nl = l + 1;
    for (int row = gw; row < nrows; row += ngw) {
        float* xr = xrow_ptr(P, row);
        const float* m = P.mod + ((size_t)l * 3 + modrow(row)) * 6144;
        float f[16];
#pragma unroll
        for (int i = 0; i < 16; ++i) f[i] = 0;
        const int myinv = P.inv[(size_t)row * 16 + (lane & 15)];
#pragma unroll 1
        for (int e = 0; e < 16; ++e) {
            const int pr = __shfl(myinv, e);
            if (pr >= 0) {
#pragma unroll
                for (int j = 0; j < 4; ++j) { const u32x2 u = *(const u32x2*)(yp + (size_t)pr * 1024 + j * 256 + lane * 4); f[j * 4 + 0] += bflo(u.x); f[j * 4 + 1] += bfhi(u.x); f[j * 4 + 2] += bflo(u.y); f[j * 4 + 3] += bfhi(u.y); }
            }
        }
        float ss = 0;
#pragma unroll
        for (int i = 0; i < 16; ++i) ss += f[i] * f[i];
        float rstd = rsqrtf(wave_sum(ss) * (1.f / 1024.f) + EPS);
        float xv[16]; ss = 0;
#pragma unroll
        for (int j = 0; j < 4; ++j) {
            const int col = j * 256 + lane * 4;
            const float4 xo = *(const float4*)(xr + col), gp = *(const float4*)(g_post + col), ga = *(const float4*)(m + 5120 + col);
            float4 xn; xn.x = xo.x + ga.x * (f[j * 4 + 0] * rstd * gp.x); xn.y = xo.y + ga.y * (f[j * 4 + 1] * rstd * gp.y); xn.z = xo.z + ga.z * (f[j * 4 + 2] * rstd * gp.z); xn.w = xo.w + ga.w * (f[j * 4 + 3] * rstd * gp.w);
            *(float4*)((dry ? (float*)P.p + (size_t)row * 1024 : xr) + col) = xn;
            xv[j * 4 + 0] = xn.x; xv[j * 4 + 1] = xn.y; xv[j * 4 + 2] = xn.z; xv[j * 4 + 3] = xn.w;
            ss += xn.x * xn.x + xn.y * xn.y + xn.z * xn.z + xn.w * xn.w;
        }
        if (nl < DEPTH) {
            rstd = rsqrtf(wave_sum(ss) * (1.f / 1024.f) + EPS);
            const float* g = P.g_mix_pre + nl * 1024;
            const float* m2 = P.mod + ((size_t)nl * 3 + modrow(row)) * 6144;
#pragma unroll
            for (int j = 0; j < 4; ++j) {
                const int col = j * 256 + lane * 4;
                const float4 gg = *(const float4*)(g + col), sh = *(const float4*)(m2 + col), sc = *(const float4*)(m2 + 1024 + col);
                store_bf16x4(P.abuf + (size_t)row * 1024 + col, xv[j * 4 + 0] * rstd * gg.x * (1.f + sc.x) + sh.x, xv[j * 4 + 1] * rstd * gg.y * (1.f + sc.y) + sh.y,
                             xv[j * 4 + 2] * rstd * gg.z * (1.f + sc.z) + sh.z, xv[j * 4 + 3] * rstd * gg.w * (1.f + sc.w) + sh.w);
            }
        }
    }
}

extern __shared__ __attribute__((aligned(16))) unsigned char smem_dyn[];
#define PH_COMMON LAS unsigned char* lds = (LAS unsigned char*)smem_dyn; const int wg = blockIdx.x, nwg = gridDim.x;

__global__ void __launch_bounds__(512, 2) k_mega(Params P) {
    PH_COMMON
    cg::grid_group grid = cg::this_grid();
    volatile LAS unsigned* xbw = (volatile LAS unsigned*)(lds + LDS_BYTES - 16);
    if (threadIdx.x == 0) { xbw[0] = 0u; xbw[1] = 0u; }
    __syncthreads();
    const XcdBarrier xb = xcd_barrier_post(P.bar, xbw);
#ifndef PROBE_DUP
#define PROBE_DUP 0
#endif
#define GBAR() do { xcd_barrier(xb); if (PROBE_DUP & 16) xcd_barrier(xb); } while (0)
#define REP(bit) for (int rep_ = 0, nrep_ = opaque_reps((PROBE_DUP & (bit)) ? 2 : 1); rep_ < nrep_; ++rep_)
    REP(4) { phase_prep_small(P, lds, wg, nwg); phase_ada(P, lds, wg, nwg); phase_resid_init(P, wg, nwg); }
    grid.sync();
    REP(1024) phase_rowop_pre(P, 0, wg, nwg);
    GBAR();
#pragma unroll 1
    for (int l = 0; l < DEPTH; ++l) {
        const bool last = (l == DEPTH - 1);
        const int nrows = last ? NLAT : NROW;
        REP(1) {
            SchedDense S; S.nM = NROW / 256; S.nN = PN / 256; S.nwg = S.nM * S.nN; S.G = nwg; S.c = wg; S.Bt = (const char*)(P.WinT + (size_t)l * PN * 1024);
            EpiStoreBf16 E; E.O = P.p; E.ldo = PN;
            gemm_phase(lds, (const char*)P.abuf, S, E);
            phase_gates(P, l, wg, nwg);
        }
        GBAR();
        REP(2) phase_mix_a(P, lds, l, wg, nwg);
        GBAR();
        REP(2048) phase_mix_b(P, wg, nwg);
        GBAR();
        REP(4096) phase_mix_c(P, lds, l, last ? 2 : 0, wg, nwg);
        GBAR();
        REP(8) {
            SchedDense S; S.nM = nrows / 256; S.nN = 4; S.nwg = S.nM * S.nN; S.G = nwg; S.c = wg; S.Bt = (const char*)(P.WoutT + (size_t)l * 1024 * 1024);
            EpiStoreBf16 E; E.O = P.r1; E.ldo = 1024;
            gemm_phase(lds, (const char*)P.abuf, S, E);
        }
        GBAR();
        REP(256) phase_rowop_mid(P, lds, l, nrows, wg, nwg, rep_ + 1 < nrep_);
        GBAR();
        REP(128) phase_topk_prep(P, lds, l, last ? 32 : 64, wg, nwg);
        GBAR();
        const int mtn = last ? 8 : 9;
        REP(32) {
            SchedGateUp S; S.G = nwg; S.c = wg; S.mtn = mtn; S.glist = P.glist; S.Wg = (const char*)P.WegT; S.Wu = (const char*)P.WeuT;
            EpiGateUp E; E.hid = P.p;
            gemm_phase(lds, (const char*)P.abuf, S, E);
        }
        GBAR();
        REP(64) {
            SchedDown S; S.G = nwg; S.c = wg; S.mtn = mtn; S.Wd = (const char*)P.WedT;
            EpiDown E; E.yp = P.r1; E.gval = P.gval;
            gemm_phase(lds, (const char*)P.p, S, E);
        }
        GBAR();
        REP(512) phase_rowop_post_pre(P, l, nrows, wg, nwg, rep_ + 1 < nrep_);
        if (!last) GBAR();
    }
#undef GBAR
#undef REP
}
}

extern "C" void kernel_launch(void* const* d_in, const int* in_sizes, int n_in, void* d_out, int out_size, void* d_ws, size_t ws_size, hipStream_t stream) {
    Params P{};
    P.x = (const float*)d_in[0]; P.c = (const float*)d_in[1]; P.ctx = (const float*)d_in[2]; P.c_ctx = (const float*)d_in[3];
    P.w_ada = (const float*)d_in[4]; P.b_ada = (const float*)d_in[5];
    P.g_mix_pre = (const float*)d_in[6]; P.g_mix_post = (const float*)d_in[7]; P.g_ffn_pre = (const float*)d_in[8]; P.g_ffn_post = (const float*)d_in[9];
    P.w_in = (const float*)d_in[10]; P.conv_qk = (const float*)d_in[11]; P.b_ml_gates = (const float*)d_in[12];
    P.w_gla_a2 = (const float*)d_in[13]; P.b_gla_a = (const float*)d_in[14]; P.g_ml_norm = (const float*)d_in[15]; P.g_gla_norm = (const float*)d_in[16];
    P.w_out = (const float*)d_in[17]; P.w_router = (const float*)d_in[18];
    P.w_e_gate = (const float*)d_in[19]; P.w_e_up = (const float*)d_in[20]; P.w_e_down = (const float*)d_in[21];
    P.out = (float*)d_out;

    char* ws = (char*)d_ws; size_t off = 0;
    auto carve = [&](size_t bytes) { void* r = ws + off; off += (bytes + 255) & ~(size_t)255; return r; };
    P.bar = (unsigned*)carve(65536);
    P.xc = (float*)carve((size_t)NCTX * 1024 * 4);
    P.WinT = (bf16_t*)carve((size_t)DEPTH * PN * 1024 * 2);
    P.WgaT = (bf16_t*)carve((size_t)DEPTH * 64 * 1024 * 2);
    P.WoutT = (bf16_t*)carve((size_t)DEPTH * 1024 * 1024 * 2);
    P.WegT = (bf16_t*)carve((size_t)NE * 1024 * 1024 * 2);
    P.WeuT = (bf16_t*)carve((size_t)NE * 1024 * 1024 * 2);
    P.WedT = (bf16_t*)carve((size_t)NE * 1024 * 1024 * 2);
    P.abuf = (bf16_t*)carve((size_t)NROW * 1024 * 2);
    P.p = (bf16_t*)carve((size_t)NROW * PN * 2);
    P.pga = (float*)carve((size_t)NROW * GA * 4);
    P.r1 = (bf16_t*)carve((size_t)2 * NROW * 1024 * 2);
    P.qk = P.r1 + (size_t)NROW * 1024;
    P.ml_ck = (bf16_t*)carve((size_t)16 * 66 * ML_IMG);
    P.ml_pre = (bf16_t*)carve((size_t)16 * 66 * ML_IMG);
    P.gl_ck = (bf16_t*)carve((size_t)16 * 66 * GL_IMG);
    P.gl_pre = (bf16_t*)carve((size_t)16 * 66 * GL_IMG);
    P.mstat = (float*)carve((size_t)16 * 66 * 2 * 4);
    P.mprev = (float*)carve((size_t)16 * 66 * 4);
    P.gbend = (float*)carve((size_t)16 * 66 * 64 * 4);
    P.mod = (float*)carve((size_t)DEPTH * 3 * 6144 * 4);
    P.aff = (float*)carve((size_t)NROW * 16 * 4);
    P.glist = (int*)carve((size_t)NE * MZ * 4);
    P.gval = (float*)carve((size_t)NE * MZ * 4);
    P.inv = (int*)carve((size_t)NROW * 16 * 4);

    static int grid_blocks = 0;
    if (!grid_blocks) {
        int dev = 0, cus = 0, per_cu = 0;
        (void)hipGetDevice(&dev);
        (void)hipDeviceGetAttribute(&cus, hipDeviceAttributeMultiprocessorCount, dev);
        (void)hipFuncSetAttribute((const void*)k_mega, hipFuncAttributeMaxDynamicSharedMemorySize, LDS_BYTES);
        (void)hipOccupancyMaxActiveBlocksPerMultiprocessor(&per_cu, (const void*)k_mega, NTHR, LDS_BYTES);
        if (cus < 1) cus = NWG;
        grid_blocks = cus;
        if (per_cu < 1) grid_blocks = cus;
        if (grid_blocks > NWG) grid_blocks = NWG;
    }
    (void)hipMemsetAsync(P.bar, 0, 65536, stream);
    void* args[] = {&P};
    (void)hipLaunchCooperativeKernel((const void*)k_mega, dim3(grid_blocks), dim3(NTHR), args, LDS_BYTES, stream);
}
```

```cpp
#include <hip/hip_runtime.h>
#include <hip/hip_cooperative_groups.h>
#include <math.h>
namespace cg = cooperative_groups;

namespace {
#define LAS __attribute__((address_space(3)))
typedef unsigned short bf16_t;
typedef short bf16x8 __attribute__((ext_vector_type(8)));
typedef float f32x4 __attribute__((ext_vector_type(4)));
typedef unsigned u32x4 __attribute__((ext_vector_type(4)));
typedef unsigned u32x2 __attribute__((ext_vector_type(2)));

constexpr int D = 1024, NB = 2, SEQ = 8192, CTX = 256, DEPTH = 2;
constexpr int NLAT = NB * SEQ;
constexpr int NCTX = NB * CTX;
constexpr int NROW = NLAT + NCTX;
constexpr int PW = 3632;
constexpr int PN = 3584;
constexpr int P_MLQ = 0, P_MLK = 512, P_MLV = 1024, P_MLO = 1536, P_GQ = 2048, P_GK = 2304, P_GV = 2560, P_GR = 3072;
constexpr int GA = 64;
constexpr int NE = 16;
constexpr int MZ = 2112;
constexpr float EPS = 1e-6f;
constexpr int NWG = 256, NTHR = 512;
constexpr int LDS_BYTES = 152 * 1024;
constexpr int ML_IMG = 128 * 272, GL_IMG = 64 * 272;

__device__ __forceinline__ float wave_sum(float v) {
#pragma unroll
    for (int o = 32; o > 0; o >>= 1) v += __shfl_xor(v, o);
    return v;
}
__device__ __forceinline__ int ltid() { int t = threadIdx.x; asm volatile("" : "+v"(t)); return t; }
__device__ __forceinline__ int opaque_reps(int n) { asm volatile("" : "+s"(n)); return n; }
__device__ __forceinline__ float siluf(float x) { return x * __frcp_rn(1.f + __expf(-x)); }
__device__ __forceinline__ float sigmoidf(float x) { return __frcp_rn(1.f + __expf(-x)); }
__device__ __forceinline__ float logsigmoidf(float x) { return fminf(x, 0.f) - __logf(1.f + __expf(-fabsf(x))); }
__device__ __forceinline__ int modrow(int row) { return row < NLAT ? row / SEQ : 2; }
__device__ __forceinline__ unsigned pk2(float lo, float hi) { unsigned r; asm("v_cvt_pk_bf16_f32 %0, %1, %2" : "=v"(r) : "v"(lo), "v"(hi)); return r; }
__device__ __forceinline__ float bf2f(bf16_t b) { return __uint_as_float(((unsigned)b) << 16); }
__device__ __forceinline__ float bflo(unsigned u) { return __uint_as_float(u << 16); }
__device__ __forceinline__ float bfhi(unsigned u) { return __uint_as_float(u & 0xffff0000u); }

struct Params {
    const float *x, *c, *ctx, *c_ctx, *w_ada, *b_ada, *g_mix_pre, *g_mix_post, *g_ffn_pre, *g_ffn_post, *w_in, *conv_qk, *b_ml_gates, *w_gla_a2, *b_gla_a, *g_ml_norm, *g_gla_norm,
        *w_out, *w_router, *w_e_gate, *w_e_up, *w_e_down;
    float* out;
    float* xc;
    bf16_t *WinT, *WgaT, *WoutT, *WegT, *WeuT, *WedT;
    bf16_t *abuf;
    bf16_t *p;
    float* pga;
    bf16_t *r1;
    bf16_t* qk;
    bf16_t *ml_ck, *ml_pre;
    bf16_t *gl_ck, *gl_pre;
    float *mstat;
    float *mprev;
    float *gbend;
    float* mod;
    float* pos;
    float* aff;
    int* glist; float* gval; int* inv;
    unsigned* bar;
    int pad_;
};

__device__ __forceinline__ float* xrow_ptr(const Params& P, int row) { return row < NLAT ? P.out + (size_t)row * 1024 : P.xc + (size_t)(row - NLAT) * 1024; }

__device__ __forceinline__ void transpose_item(const float* W, int ldw, int k0, int srccol0, int special, bf16_t* WT, int dstrow0, LAS float* scr  , int lane) {
    {
        const int kq = lane >> 4, n = (lane & 15) * 4;
        int sc;
        if (special) { if (n < 16) sc = 2048 + n; else if (n < 48) sc = 3600 + (n - 16); else sc = -1; }
        else sc = srccol0 + n;
        f32x4 v[16];
#pragma unroll
        for (int i = 0; i < 16; ++i) v[i] = sc >= 0 ? *(const f32x4*)(W + (size_t)(k0 + 4 * i + kq) * ldw + sc) : (f32x4){0.f, 0.f, 0.f, 0.f};
#pragma unroll
        for (int i = 0; i < 16; ++i) { LAS float* d = scr + (4 * i + kq) * 65 + n; d[0] = v[i][0]; d[1] = v[i][1]; d[2] = v[i][2]; d[3] = v[i][3]; }
    }
    asm volatile("s_waitcnt lgkmcnt(0)" ::: "memory"); __builtin_amdgcn_wave_barrier();
    {
        const int nq = lane >> 3, kc = (lane & 7) * 8;
#pragma unroll
        for (int i = 0; i < 8; ++i) {
            const int n = 8 * i + nq; const LAS float* s = scr + kc * 65 + n;
            u32x4 o; o.x = pk2(s[0], s[65]); o.y = pk2(s[130], s[195]); o.z = pk2(s[260], s[325]); o.w = pk2(s[390], s[455]);
            *(u32x4*)(WT + (size_t)(dstrow0 + n) * 1024 + k0 + kc) = o;
        }
    }
    asm volatile("s_waitcnt lgkmcnt(0)" ::: "memory"); __builtin_amdgcn_wave_barrier();
}

constexpr int IT_IN = 16 * 56, IT_GA = 16, IT_OUT = 256, IT_EX = 3 * 16 * 256, IT_LAYER_SMALL = IT_IN + IT_GA + IT_OUT;
__device__ __forceinline__ void phase_prep_small(const Params& P, LAS unsigned char* lds, int wg, int nwg) {
    const int tid = ltid(), lane = tid & 63, gw = wg * 8 + (tid >> 6), ngw = nwg * 8;
    LAS float* scr = (LAS float*)lds + (tid >> 6) * 4160;
    for (int it = gw; it < DEPTH * IT_LAYER_SMALL; it += ngw) {
        const int l = it / IT_LAYER_SMALL; int r = it % IT_LAYER_SMALL;
        if (r < IT_IN) { const int kb = r / 56, nb = r % 56, n0 = nb * 64; transpose_item(P.w_in + (size_t)l * 1024 * PW, PW, kb * 64, n0 + (n0 >= 2048 ? 16 : 0), 0, P.WinT + (size_t)l * PN * 1024, n0, scr, lane); continue; }
        r -= IT_IN;
        if (r < IT_GA) { transpose_item(P.w_in + (size_t)l * 1024 * PW, PW, r * 64, 0, 1, P.WgaT + (size_t)l * 64 * 1024, 0, scr, lane); continue; }
        r -= IT_GA;
        { const int kb = r / 16, nb = r % 16; transpose_item(P.w_out + (size_t)l * 1024 * 1024, 1024, kb * 64, nb * 64, 0, P.WoutT + (size_t)l * 1024 * 1024, nb * 64, scr, lane); }
    }
    __syncthreads();
}
__device__ __forceinline__ void phase_prep_experts(const Params& P, LAS unsigned char* lds, int l, int wg, int nwg) {
    const int tid = ltid(), lane = tid & 63, gw = wg * 8 + (tid >> 6), ngw = nwg * 8;
    LAS float* scr = (LAS float*)lds + (tid >> 6) * 4160;
    for (int it = gw; it < IT_EX; it += ngw) {
        const int m = it / (16 * 256), e = (it / 256) % 16, r = it % 256, kb = r / 16, nb = r % 16;
        const float* src = (m == 0 ? P.w_e_gate : (m == 1 ? P.w_e_up : P.w_e_down)) + ((size_t)l * NE + e) * 1024 * 1024;
        bf16_t* dst = (m == 0 ? P.WegT : (m == 1 ? P.WeuT : P.WedT)) + (size_t)e * 1024 * 1024;
        transpose_item(src, 1024, kb * 64, nb * 64, 0, dst, nb * 64, scr, lane);
    }
    __syncthreads();
}

__device__ __forceinline__ void phase_ada(const Params& P, LAS unsigned char* lds, int wg, int nwg) {
    LAS float* s = (LAS float*)lds;
    const int tid = ltid();
    for (int i = tid; i < 1024; i += NTHR) { s[i] = siluf(P.c[i]); s[1024 + i] = siluf(P.c[1024 + i]); s[2048 + i] = siluf(P.c_ctx[i]); }
    __syncthreads();
    LAS float* red = s + 3072;
    for (int it = wg; it < DEPTH * 96; it += nwg) {
        const int l = it / 96, n = (it % 96) * 64 + (tid & 63), ks = tid >> 6;
        const float* w = P.w_ada + (size_t)l * 1024 * 6144 + n;
        float a0 = 0, a1 = 0, a2 = 0;
#pragma unroll 8
        for (int k = ks * 128; k < ks * 128 + 128; ++k) { const float wv = w[(size_t)k * 6144]; a0 += s[k] * wv; a1 += s[1024 + k] * wv; a2 += s[2048 + k] * wv; }
        red[(ks * 3 + 0) * 64 + (tid & 63)] = a0; red[(ks * 3 + 1) * 64 + (tid & 63)] = a1; red[(ks * 3 + 2) * 64 + (tid & 63)] = a2;
        __syncthreads();
        if (tid < 192) {
            const int r = tid / 64, cidx = tid & 63; float a = 0;
#pragma unroll
            for (int q = 0; q < 8; ++q) a += red[(q * 3 + r) * 64 + cidx];
            const int nn = (it % 96) * 64 + cidx;
            P.mod[((size_t)l * 3 + r) * 6144 + nn] = a + P.b_ada[l * 6144 + nn];
        }
        __syncthreads();
    }
}

__device__ __forceinline__ void phase_pos_table(const Params& P, int wg, int nwg) {
    const int gt = wg * NTHR + ltid(), ngt = nwg * NTHR;
    for (int i = gt; i < 192 * 256; i += ngt) {
        const int rc = i >> 8, j = i & 255;
        const float freq = powf(10000.f, -(float)j / 256.f);
        const float arg = (float)(rc < 128 ? rc : rc - 128) * freq;
        P.pos[(size_t)rc * 512 + j] = sinf(arg); P.pos[(size_t)rc * 512 + 256 + j] = cosf(arg);
    }
}

__device__ __forceinline__ void store_bf16x4(bf16_t* p, float a, float b, float c, float d) { u32x2 o; o.x = pk2(a, b); o.y = pk2(c, d); *(u32x2*)p = o; }

__device__ __forceinline__ void phase_rowop_pre(const Params& P, int l, int wg, int nwg) {
    const int tid_ = ltid(), lane = tid_ & 63, gw = wg * 8 + (tid_ >> 6), ngw = nwg * 8;
    const float* g = P.g_mix_pre + l * 1024;
    for (int row = gw; row < NROW; row += ngw) {
        float* xr = xrow_ptr(P, row);
        const float* m = P.mod + ((size_t)l * 3 + modrow(row)) * 6144;
        float4 v[4]; float ss = 0;
        if (row < NLAT) {
            const int t = row % SEQ, r = t / 64, cc = t % 64;
#pragma unroll
            for (int j = 0; j < 4; ++j) {
                const int col = j * 256 + lane * 4;
                v[j] = *(const float4*)(P.x + (size_t)row * 1024 + col);
                const float4 e = *(const float4*)(P.pos + (size_t)(j < 2 ? r : 128 + cc) * 512 + (j & 1) * 256 + lane * 4);
                v[j].x += e.x; v[j].y += e.y; v[j].z += e.z; v[j].w += e.w;
            }
        } else {
#pragma unroll
            for (int j = 0; j < 4; ++j) v[j] = *(const float4*)(P.ctx + (size_t)(row - NLAT) * 1024 + j * 256 + lane * 4);
        }
#pragma unroll
        for (int j = 0; j < 4; ++j) { *(float4*)(xr + j * 256 + lane * 4) = v[j]; ss += v[j].x * v[j].x + v[j].y * v[j].y + v[j].z * v[j].z + v[j].w * v[j].w; }
        const float rstd = rsqrtf(wave_sum(ss) * (1.f / 1024.f) + EPS);
#pragma unroll
        for (int j = 0; j < 4; ++j) {
            const int col = j * 256 + lane * 4;
            const float4 gg = *(const float4*)(g + col), sh = *(const float4*)(m + col), sc = *(const float4*)(m + 1024 + col);
            store_bf16x4(P.abuf + (size_t)row * 1024 + col, v[j].x * rstd * gg.x * (1.f + sc.x) + sh.x, v[j].y * rstd * gg.y * (1.f + sc.y) + sh.y,
                         v[j].z * rstd * gg.z * (1.f + sc.z) + sh.z, v[j].w * rstd * gg.w * (1.f + sc.w) + sh.w);
        }
    }
}

__device__ __forceinline__ void phase_rowop_mid(const Params& P, LAS unsigned char* lds, int l, int nrows, int wg, int nwg, int dry = 0) {
    const int tid_ = ltid(), lane = tid_ & 63, gw = wg * 8 + (tid_ >> 6), ngw = nwg * 8;
    LAS float* wl = (LAS float*)lds;
    {
        const float* wsrc = P.w_router + (size_t)l * 1024 * 16;
        for (int i = tid_; i < 4096; i += NTHR) { const float4 w = *(const float4*)(wsrc + (size_t)i * 4); const int col = i >> 2, e0 = (i & 3) * 4;
            wl[(e0 + 0) * 1024 + col] = w.x; wl[(e0 + 1) * 1024 + col] = w.y; wl[(e0 + 2) * 1024 + col] = w.z; wl[(e0 + 3) * 1024 + col] = w.w; }
        __syncthreads();
    }
    const float* g_post = P.g_mix_post + l * 1024; const float* g_pre2 = P.g_ffn_pre + l * 1024;
    const bf16_t* y = P.r1;
    for (int row = gw; row < nrows; row += ngw) {
        float* xr = xrow_ptr(P, row);
        const float* m = P.mod + ((size_t)l * 3 + modrow(row)) * 6144;
        float yv[16], xv[16]; float ss = 0;
#pragma unroll
        for (int j = 0; j < 4; ++j) { const u32x2 u = *(const u32x2*)(y + (size_t)row * 1024 + j * 256 + lane * 4); yv[j * 4 + 0] = bflo(u.x); yv[j * 4 + 1] = bfhi(u.x); yv[j * 4 + 2] = bflo(u.y); yv[j * 4 + 3] = bfhi(u.y); }
#pragma unroll
        for (int i = 0; i < 16; ++i) ss += yv[i] * yv[i];
        float rstd = rsqrtf(wave_sum(ss) * (1.f / 1024.f) + EPS);
        ss = 0;
#pragma unroll
        for (int j = 0; j < 4; ++j) {
            const int col = j * 256 + lane * 4;
            const float4 xo = *(const float4*)(xr + col), gp = *(const float4*)(g_post + col), ga = *(const float4*)(m + 2048 + col);
            float4 xn; xn.x = xo.x + ga.x * (yv[j * 4 + 0] * rstd * gp.x); xn.y = xo.y + ga.y * (yv[j * 4 + 1] * rstd * gp.y); xn.z = xo.z + ga.z * (yv[j * 4 + 2] * rstd * gp.z); xn.w = xo.w + ga.w * (yv[j * 4 + 3] * rstd * gp.w);
            *(float4*)((dry ? (float*)P.p + (size_t)row * 1024 : xr) + col) = xn;
            xv[j * 4 + 0] = xn.x; xv[j * 4 + 1] = xn.y; xv[j * 4 + 2] = xn.z; xv[j * 4 + 3] = xn.w;
            ss += xn.x * xn.x + xn.y * xn.y + xn.z * xn.z + xn.w * xn.w;
        }
        rstd = rsqrtf(wave_sum(ss) * (1.f / 1024.f) + EPS);
        float lg[16];
#pragma unroll
        for (int e = 0; e < 16; ++e) lg[e] = 0;
#pragma unroll
        for (int j = 0; j < 4; ++j) {
            const int col = j * 256 + lane * 4;
            const float4 gg = *(const float4*)(g_pre2 + col), sh = *(const float4*)(m + 3072 + col), sc = *(const float4*)(m + 4096 + col);
            float hv[4];
            hv[0] = xv[j * 4 + 0] * rstd * gg.x * (1.f + sc.x) + sh.x; hv[1] = xv[j * 4 + 1] * rstd * gg.y * (1.f + sc.y) + sh.y;
            hv[2] = xv[j * 4 + 2] * rstd * gg.z * (1.f + sc.z) + sh.z; hv[3] = xv[j * 4 + 3] * rstd * gg.w * (1.f + sc.w) + sh.w;
            store_bf16x4(P.abuf + (size_t)row * 1024 + col, hv[0], hv[1], hv[2], hv[3]);
#pragma unroll
            for (int e = 0; e < 16; ++e) { const f32x4 w = *(const LAS f32x4*)(wl + e * 1024 + col); lg[e] += hv[0] * w[0] + hv[1] * w[1] + hv[2] * w[2] + hv[3] * w[3]; }
        }
        float mx = -1e30f;
#pragma unroll
        for (int e = 0; e < 16; ++e) { lg[e] = wave_sum(lg[e]); mx = fmaxf(mx, lg[e]); }
        float se = 0;
#pragma unroll
        for (int e = 0; e < 16; ++e) { lg[e] = __expf(lg[e] - mx); se += lg[e]; }
        float val = 0;
#pragma unroll
        for (int e = 0; e < 16; ++e) val = (e == lane) ? lg[e] : val;
        if (lane < 16) P.aff[(size_t)row * 16 + lane] = val / se;
    }
}

__device__ __forceinline__ void phase_rowop_post(const Params& P, int l, int nrows, int wg, int nwg) {
    const int tid_ = ltid(), lane = tid_ & 63, gw = wg * 8 + (tid_ >> 6), ngw = nwg * 8;
    const float* g_post = P.g_ffn_post + l * 1024;
    const bf16_t* yp = P.r1;
    for (int row = gw; row < nrows; row += ngw) {
        float* xr = xrow_ptr(P, row);
        const float* m = P.mod + ((size_t)l * 3 + modrow(row)) * 6144;
        float f[16];
#pragma unroll
        for (int i = 0; i < 16; ++i) f[i] = 0;
        const int myinv = P.inv[(size_t)row * 16 + (lane & 15)];
#pragma unroll 1
        for (int e = 0; e < 16; ++e) {
            const int pr = __shfl(myinv, e);
            if (pr >= 0) {
#pragma unroll
                for (int j = 0; j < 4; ++j) { const u32x2 u = *(const u32x2*)(yp + (size_t)pr * 1024 + j * 256 + lane * 4); f[j * 4 + 0] += bflo(u.x); f[j * 4 + 1] += bfhi(u.x); f[j * 4 + 2] += bflo(u.y); f[j * 4 + 3] += bfhi(u.y); }
            }
        }
        float ss = 0;
#pragma unroll
        for (int i = 0; i < 16; ++i) ss += f[i] * f[i];
        const float rstd = rsqrtf(wave_sum(ss) * (1.f / 1024.f) + EPS);
#pragma unroll
        for (int j = 0; j < 4; ++j) {
            const int col = j * 256 + lane * 4;
            const float4 xo = *(const float4*)(xr + col), gp = *(const float4*)(g_post + col), ga = *(const float4*)(m + 5120 + col);
            float4 xn; xn.x = xo.x + ga.x * (f[j * 4 + 0] * rstd * gp.x); xn.y = xo.y + ga.y * (f[j * 4 + 1] * rstd * gp.y); xn.z = xo.z + ga.z * (f[j * 4 + 2] * rstd * gp.z); xn.w = xo.w + ga.w * (f[j * 4 + 3] * rstd * gp.w);
            *(float4*)(xr + col) = xn;
        }
    }
}

constexpr int BK = 64, HALF = 128, HTB = HALF * BK * 2, GK = 1024;
__device__ __forceinline__ int lds_byte(int r, int c) { const int st = (r >> 4) * 2 + (c >> 5), rr = r & 15, cc = c & 31, ob = rr * 64 + cc * 2; return st * 1024 + (ob ^ (((ob >> 9) & 1) << 5)); }
__device__ __forceinline__ void stage_rc(int b, int& R, int& C) { const int st = b / 1024, sb = b % 1024, swz = sb ^ (((sb >> 9) & 1) << 5); R = (st >> 1) * 16 + swz / 64; C = (st & 1) * 32 + (swz % 64) / 2; }
__device__ __forceinline__ int perm32(int rho) { const int n = rho >> 4, i = rho & 15; return 8 * (i >> 2) + 4 * n + (i & 3); }

struct GUnit { int pm, pn, e, rows; };

template <class Sched, class Epi>
__device__ __forceinline__ void gemm_phase(LAS unsigned char* lds, const char* Abase, const Sched& S, const Epi& E) {
    const int tid = ltid(), wid = __builtin_amdgcn_readfirstlane(tid >> 6), lane = tid & 63, wr = wid >> 2, wc = wid & 3, fr = lane & 15, fq = lane >> 4;
    constexpr int nt = GK / BK;
    int R0, C0, R1, C1; stage_rc(tid * 16, R0, C0); stage_rc(tid * 16 + 8192, R1, C1);
    const unsigned voffB0 = (unsigned)(((R0 & ~31) + perm32(R0 & 31)) * GK + C0) * 2u, voffB1 = (unsigned)(((R1 & ~31) + perm32(R1 & 31)) * GK + C1) * 2u;
    constexpr size_t kstep = (size_t)(BK * 2);
    const unsigned ldsw = (unsigned)wid * 1024u;
    const int aoff = lds_byte(wr * 64 + fr, fq * 8), boff = lds_byte(wc * 32 + fr, fq * 8);
#define G_SA(b, h) (((b) * 2 + (h)) * HTB)
#define G_SB(b, h) ((4 + (b) * 2 + (h)) * HTB)
#define G_GL(bufoff, p0, p1) do { __builtin_amdgcn_global_load_lds((const unsigned*)(p0), (LAS unsigned*)(lds + (bufoff) + ldsw), 16, 0, 0); \
        __builtin_amdgcn_global_load_lds((const unsigned*)(p1), (LAS unsigned*)(lds + (bufoff) + ldsw + 8192), 16, 0, 0); } while (0)
#define G_STA(bufoff, kptr, o0, o1) G_GL(bufoff, (kptr) + (o0), (kptr) + (o1))
#define G_STB(bufoff, bptr) G_GL(bufoff, (bptr) + voffB0, (bptr) + voffB1)
#define G_LDA(dst, b, h) do { _Pragma("unroll") for (int m = 0; m < 4; ++m) _Pragma("unroll") for (int k = 0; k < 2; ++k) dst[m][k] = *(const LAS bf16x8*)(lds + G_SA(b, h) + aoff + m * 2048 + k * 1024); } while (0)
#define G_LDB(dst, b, h) do { _Pragma("unroll") for (int n = 0; n < 2; ++n) _Pragma("unroll") for (int k = 0; k < 2; ++k) dst[n][k] = *(const LAS bf16x8*)(lds + G_SB(b, h) + boff + n * 2048 + k * 1024); } while (0)
#define G_MMA(ai, bj, At, Bt) do { __builtin_amdgcn_s_setprio(1); _Pragma("unroll") for (int m = 0; m < 4; ++m) _Pragma("unroll") for (int n = 0; n < 2; ++n) _Pragma("unroll") for (int k = 0; k < 2; ++k) \
        acc[ai][bj][m][n] = __builtin_amdgcn_mfma_f32_16x16x32_bf16(Bt[n][k], At[m][k], acc[ai][bj][m][n], 0, 0, 0); __builtin_amdgcn_s_setprio(0); } while (0)
#define G_WAIT_V(n) asm volatile("s_waitcnt vmcnt(" #n ")" ::: "memory")
#define G_WAIT_L(n) asm volatile("s_waitcnt lgkmcnt(" #n ")" ::: "memory")
#define G_BAR __builtin_amdgcn_s_barrier()
#define G_SCHED __builtin_amdgcn_sched_barrier(0)
    GUnit cur, nxt; int ui = 0;
    if (!S.next(0, cur)) return;
    f32x4 acc[2][2][4][2];
#pragma unroll
    for (int a = 0; a < 2; ++a)
#pragma unroll
        for (int b = 0; b < 2; ++b)
#pragma unroll
            for (int m = 0; m < 4; ++m)
#pragma unroll
                for (int n = 0; n < 2; ++n) acc[a][b][m][n] = (f32x4){0.f, 0.f, 0.f, 0.f};
    bf16x8 At[4][2], B0[2][2], B1[2][2];
    unsigned c00, c01, c10, c11, n00, n01, n10, n11;
    S.aoff(cur, 0, R0, C0, R1, C1, c00, c01); S.aoff(cur, 1, R0, C0, R1, C1, c10, c11);
    const char* cB0 = S.bptr(cur, 0); const char* cB1 = S.bptr(cur, 1);
    G_STB(G_SB(0, 0), cB0); G_STA(G_SA(0, 0), Abase, c00, c01); G_STB(G_SB(0, 1), cB1); G_STA(G_SA(0, 1), Abase, c10, c11);
    if (wr == 1) G_BAR;
    G_WAIT_V(4); G_BAR;
    G_STB(G_SB(1, 0), cB0 + kstep); G_STA(G_SA(1, 0), Abase + kstep, c00, c01); G_STB(G_SB(1, 1), cB1 + kstep);
    G_WAIT_V(6); G_BAR;
    for (;;) {
        const bool has_next = S.next(ui + 1, nxt);
        const char* nB0 = cB0; const char* nB1 = cB1;
        n00 = c00; n01 = c01; n10 = c10; n11 = c11;
        if (has_next) { S.aoff(nxt, 0, R0, C0, R1, C1, n00, n01); S.aoff(nxt, 1, R0, C0, R1, C1, n10, n11); nB0 = S.bptr(nxt, 0); nB1 = S.bptr(nxt, 1); }
        for (int t = 0; t < nt; t += 2) {
            const bool last = (t == nt - 2);
            const char* a1 = Abase + (size_t)(t + 1) * kstep;
            const char* a2 = last ? Abase : Abase + (size_t)(t + 2) * kstep;
            const char* b20 = last ? nB0 : cB0 + (size_t)(t + 2) * kstep; const char* b21 = last ? nB1 : cB1 + (size_t)(t + 2) * kstep;
            const char* a3 = a2 + kstep; const char* b30 = b20 + kstep; const char* b31 = b21 + kstep;
            const unsigned s00 = last ? n00 : c00, s01 = last ? n01 : c01, s10 = last ? n10 : c10, s11 = last ? n11 : c11;
            G_LDB(B0, 0, 0); G_SCHED; G_LDA(At, 0, 0); G_STA(G_SA(1, 1), a1, c10, c11);
            G_WAIT_L(8); G_BAR; G_WAIT_L(0); G_MMA(0, 0, At, B0); G_BAR; G_SCHED;
            G_LDB(B1, 0, 1); G_STB(G_SB(0, 0), b20);
            G_BAR; G_WAIT_L(0); G_MMA(0, 1, At, B1); G_BAR;
            G_LDA(At, 0, 1); G_STA(G_SA(0, 0), a2, s00, s01);
            G_BAR; G_WAIT_L(0); G_MMA(1, 0, At, B0); G_BAR; G_SCHED;
            G_STB(G_SB(0, 1), b21);
            G_WAIT_V(6); G_BAR; G_MMA(1, 1, At, B1); G_BAR;
            G_LDB(B0, 1, 0); G_SCHED; G_LDA(At, 1, 0); G_STA(G_SA(0, 1), a2, s10, s11);
            G_WAIT_L(8); G_BAR; G_WAIT_L(0); G_MMA(0, 0, At, B0); G_BAR; G_SCHED;
            G_LDB(B1, 1, 1); G_STB(G_SB(1, 0), b30);
            G_BAR; G_WAIT_L(0); G_MMA(0, 1, At, B1); G_BAR;
            G_LDA(At, 1, 1); G_STA(G_SA(1, 0), a3, s00, s01);
            G_BAR; G_WAIT_L(0); G_MMA(1, 0, At, B0); G_BAR; G_SCHED;
            G_STB(G_SB(1, 1), b31);
            G_WAIT_V(6); G_BAR; G_MMA(1, 1, At, B1); G_BAR;
        }
        E(acc, cur, wr, wc, fr, fq);
        if (!has_next) break;
#pragma unroll
        for (int a = 0; a < 2; ++a)
#pragma unroll
            for (int b = 0; b < 2; ++b)
#pragma unroll
                for (int m = 0; m < 4; ++m)
#pragma unroll
                    for (int n = 0; n < 2; ++n) acc[a][b][m][n] = (f32x4){0.f, 0.f, 0.f, 0.f};
        cur = nxt; cB0 = nB0; cB1 = nB1; c00 = n00; c01 = n01; c10 = n10; c11 = n11; ++ui;
    }
    G_WAIT_V(0);
    if (wr == 0) G_BAR;
    G_BAR;
#undef G_SA
#undef G_SB
#undef G_GL
#undef G_STA
#undef G_STB
#undef G_LDA
#undef G_LDB
#undef G_MMA
#undef G_WAIT_V
#undef G_WAIT_L
#undef G_BAR
#undef G_SCHED
}

struct SchedDense {
    int nM, nN, nwg, G, c; const char* Bt;
    __device__ __forceinline__ bool next(int i, GUnit& u) const {
        const long L = (long)i * G + c; if (L >= nwg) return false;
        int wgid = (int)L; { const int q = nwg / 8, r = nwg % 8, xcd = wgid % 8, off = wgid / 8; wgid = (xcd < r ? xcd * (q + 1) : r * (q + 1) + (xcd - r) * q) + off; }
        const int nig = 8 * nN, gid = wgid / nig, fm = gid * 8, gsz = (nM - fm) < 8 ? (nM - fm) : 8;
        u.pm = fm + ((wgid % nig) % gsz); u.pn = (wgid % nig) / gsz; u.e = 0; u.rows = 256; return true;
    }
    __device__ __forceinline__ void aoff(const GUnit& u, int h, int R0, int C0, int R1, int C1, unsigned& o0, unsigned& o1) const {
        const unsigned base = (unsigned)(u.pm * 256 + h * 128);
        o0 = ((base + R0) * GK + C0) * 2u; o1 = ((base + R1) * GK + C1) * 2u;
    }
    __device__ __forceinline__ const char* bptr(const GUnit& u, int h) const { return Bt + (size_t)(u.pn * 256 + h * 128) * GK * 2; }
};
struct SchedGateUp {
    int G, c, mtn; const int* glist; const char* Wg; const char* Wu;
    __device__ __forceinline__ bool next(int i, GUnit& u) const {
        const int x = c & 7, j = c >> 3, per = G >> 3, L = i * per + j, tot = 2 * mtn * 8;
        if (L >= tot) return false;
        const int es = L / (mtn * 8), rem = L % (mtn * 8);
        u.e = x + 8 * es; u.pm = rem >> 3; u.pn = rem & 7; u.rows = (u.pm == 8) ? 64 : 256; return true;
    }
    __device__ __forceinline__ void aoff(const GUnit& u, int h, int R0, int C0, int R1, int C1, unsigned& o0, unsigned& o1) const {
        int r0 = h * 128 + R0, r1 = h * 128 + R1;
        r0 = r0 < u.rows ? r0 : 0; r1 = r1 < u.rows ? r1 : 0;
        const int g0 = glist[u.e * MZ + u.pm * 256 + r0], g1 = glist[u.e * MZ + u.pm * 256 + r1];
        o0 = ((unsigned)g0 * GK + C0) * 2u; o1 = ((unsigned)g1 * GK + C1) * 2u;
    }
    __device__ __forceinline__ const char* bptr(const GUnit& u, int h) const { return (h ? Wu : Wg) + ((size_t)u.e * 1024 + u.pn * 128) * GK * 2; }
};
struct SchedDown {
    int G, c, mtn; const char* Wd;
    __device__ __forceinline__ bool next(int i, GUnit& u) const {
        const int x = c & 7, j = c >> 3, per = G >> 3, L = i * per + j, tot = 2 * mtn * 4;
        if (L >= tot) return false;
        const int es = L / (mtn * 4), rem = L % (mtn * 4);
        u.e = x + 8 * es; u.pm = rem >> 2; u.pn = rem & 3; u.rows = (u.pm == 8) ? 64 : 256; return true;
    }
    __device__ __forceinline__ void aoff(const GUnit& u, int h, int R0, int C0, int R1, int C1, unsigned& o0, unsigned& o1) const {
        const unsigned base = (unsigned)(u.e * MZ + u.pm * 256 + h * 128);
        o0 = ((base + R0) * GK + C0) * 2u; o1 = ((base + R1) * GK + C1) * 2u;
    }
    __device__ __forceinline__ const char* bptr(const GUnit& u, int h) const { return Wd + ((size_t)u.e * 1024 + u.pn * 256 + h * 128) * GK * 2; }
};

struct EpiStoreBf16 {
    bf16_t* O; int ldo;
    __device__ __forceinline__ void operator()(const f32x4 (&acc)[2][2][4][2], const GUnit& u, int wr, int wc, int fr, int fq) const {
#pragma unroll
        for (int ai = 0; ai < 2; ++ai)
#pragma unroll
            for (int m = 0; m < 4; ++m) {
                bf16_t* rowp = O + (size_t)(u.pm * 256 + ai * 128 + wr * 64 + m * 16 + fr) * ldo + u.pn * 256 + wc * 32 + 8 * fq;
#pragma unroll
                for (int bj = 0; bj < 2; ++bj) { const f32x4 v0 = acc[ai][bj][m][0], v1 = acc[ai][bj][m][1]; u32x4 o; o.x = pk2(v0[0], v0[1]); o.y = pk2(v0[2], v0[3]); o.z = pk2(v1[0], v1[1]); o.w = pk2(v1[2], v1[3]); *(u32x4*)(rowp + bj * 128) = o; }
            }
    }
};
struct EpiGateUp {
    bf16_t* hid;
    __device__ __forceinline__ void operator()(const f32x4 (&acc)[2][2][4][2], const GUnit& u, int wr, int wc, int fr, int fq) const {
#pragma unroll
        for (int ai = 0; ai < 2; ++ai)
#pragma unroll
            for (int m = 0; m < 4; ++m) {
                const int r = ai * 128 + wr * 64 + m * 16 + fr;
                if (r < u.rows) {
                    float h[8];
#pragma unroll
                    for (int n = 0; n < 2; ++n)
#pragma unroll
                        for (int j = 0; j < 4; ++j) { const float g = acc[ai][0][m][n][j], up = acc[ai][1][m][n][j]; h[n * 4 + j] = g * __frcp_rn(1.f + __expf(-g)) * up; }
                    u32x4 o; o.x = pk2(h[0], h[1]); o.y = pk2(h[2], h[3]); o.z = pk2(h[4], h[5]); o.w = pk2(h[6], h[7]);
                    *(u32x4*)(hid + (size_t)(u.e * MZ + u.pm * 256 + r) * 1024 + u.pn * 128 + wc * 32 + 8 * fq) = o;
                }
            }
    }
};
struct EpiDown {
    bf16_t* yp; const float* gval;
    __device__ __forceinline__ void operator()(const f32x4 (&acc)[2][2][4][2], const GUnit& u, int wr, int wc, int fr, int fq) const {
#pragma unroll
        for (int ai = 0; ai < 2; ++ai)
#pragma unroll
            for (int m = 0; m < 4; ++m) {
                const int r = ai * 128 + wr * 64 + m * 16 + fr;
                if (r < u.rows) {
                    const int pr = u.e * MZ + u.pm * 256 + r; const float g = gval[pr];
                    bf16_t* rowp = yp + (size_t)pr * 1024 + u.pn * 256 + wc * 32 + 8 * fq;
#pragma unroll
                    for (int bj = 0; bj < 2; ++bj) { const f32x4 v0 = acc[ai][bj][m][0] * g, v1 = acc[ai][bj][m][1] * g; u32x4 o; o.x = pk2(v0[0], v0[1]); o.y = pk2(v0[2], v0[3]); o.z = pk2(v1[0], v1[1]); o.w = pk2(v1[2], v1[3]); *(u32x4*)(rowp + bj * 128) = o; }
                }
            }
    }
};

__device__ __forceinline__ void phase_gates(const Params& P, int l, int wg, int nwg) {
    const int tid_ = ltid(), lane = tid_ & 63, gw = wg * 8 + (tid_ >> 6), ngw = nwg * 8;
    const int fr = lane & 15, fq = lane >> 4;
    const bf16_t* W = P.WgaT + (size_t)l * 64 * 1024;
    for (int rb = gw; rb < NROW / 16; rb += ngw) {
        f32x4 acc[4];
#pragma unroll
        for (int n = 0; n < 4; ++n) acc[n] = (f32x4){0.f, 0.f, 0.f, 0.f};
        const bf16_t* arow = P.abuf + (size_t)(rb * 16 + fr) * 1024 + fq * 8;
#pragma unroll 4
        for (int k0 = 0; k0 < 1024; k0 += 32) {
            const bf16x8 a = *(const bf16x8*)(arow + k0);
#pragma unroll
            for (int n = 0; n < 4; ++n) { const bf16x8 b = *(const bf16x8*)(W + (size_t)(n * 16 + fr) * 1024 + k0 + fq * 8); acc[n] = __builtin_amdgcn_mfma_f32_16x16x32_bf16(a, b, acc[n], 0, 0, 0); }
        }
#pragma unroll
        for (int n = 0; n < 4; ++n)
#pragma unroll
            for (int j = 0; j < 4; ++j) P.pga[(size_t)(rb * 16 + fq * 4 + j) * GA + n * 16 + fr] = acc[n][j];
    }
}

constexpr int TS = 272;
constexpr int TS64 = 144;
constexpr int VS = 304;

__device__ __forceinline__ int chunk_row0(int b, int pc) { return pc < 2 ? NLAT + b * CTX + pc * 128 : b * SEQ + (pc - 2) * 128; }
__device__ __forceinline__ int virt_pc(int dir, int j) { return dir == 0 ? j : (j == 0 ? 1 : (j == 1 ? 0 : 67 - j)); }
__device__ __forceinline__ float wave_incl_sum(float s, int lane) {
#pragma unroll
    for (int o = 1; o < 64; o <<= 1) { const float y = __shfl_up(s, o); if (lane >= o) s += y; }
    return s;
}
__device__ __forceinline__ float wave_incl_max(float s, int lane) {
#pragma unroll
    for (int o = 1; o < 64; o <<= 1) { const float y = __shfl_up(s, o); if (lane >= o) s = fmaxf(s, y); }
    return s;
}
__device__ __forceinline__ float wave_max(float v) {
#pragma unroll
    for (int o = 32; o > 0; o >>= 1) v = fmaxf(v, __shfl_xor(v, o));
    return v;
}
__device__ __forceinline__ bf16x8 mk_frag(u32x2 lo, u32x2 hi) { u32x4 v; v.x = lo.x; v.y = lo.y; v.z = hi.x; v.w = hi.y; return __builtin_bit_cast(bf16x8, v); }
template <int HI>
__device__ __forceinline__ bf16x8 tr_read1(unsigned addr) {
    u32x2 lo, hi;
    asm volatile("ds_read_b64_tr_b16 %0, %2\n\tds_read_b64_tr_b16 %1, %2 offset:%3\n\ts_waitcnt lgkmcnt(0)" : "=&v"(lo), "=&v"(hi) : "v"(addr), "i"(HI) : "memory");
    return mk_frag(lo, hi);
}
template <int HI, int FS>
__device__ __forceinline__ void tr_read4(unsigned addr, bf16x8& f0, bf16x8& f1, bf16x8& f2, bf16x8& f3) {
    u32x2 a0, a1, b0, b1, c0, c1, d0, d1;
    asm volatile("ds_read_b64_tr_b16 %0, %8\n\t"
                 "ds_read_b64_tr_b16 %1, %8 offset:%9\n\t"
                 "ds_read_b64_tr_b16 %2, %8 offset:%10\n\t"
                 "ds_read_b64_tr_b16 %3, %8 offset:%11\n\t"
                 "ds_read_b64_tr_b16 %4, %8 offset:%12\n\t"
                 "ds_read_b64_tr_b16 %5, %8 offset:%13\n\t"
                 "ds_read_b64_tr_b16 %6, %8 offset:%14\n\t"
                 "ds_read_b64_tr_b16 %7, %8 offset:%15\n\t"
                 "s_waitcnt lgkmcnt(0)"
                 : "=&v"(a0), "=&v"(a1), "=&v"(b0), "=&v"(b1), "=&v"(c0), "=&v"(c1), "=&v"(d0), "=&v"(d1)
                 : "v"(addr), "i"(HI), "i"(FS), "i"(FS + HI), "i"(2 * FS), "i"(2 * FS + HI), "i"(3 * FS), "i"(3 * FS + HI)
                 : "memory");
    f0 = mk_frag(a0, a1); f1 = mk_frag(b0, b1); f2 = mk_frag(c0, c1); f3 = mk_frag(d0, d1);
}
__device__ __forceinline__ unsigned lds_addr(LAS unsigned char* p) { return (unsigned)(size_t)p; }
__device__ __forceinline__ void unpack8(const u32x4 u, float (&f)[8]) { f[0] = bflo(u.x); f[1] = bfhi(u.x); f[2] = bflo(u.y); f[3] = bfhi(u.y); f[4] = bflo(u.z); f[5] = bfhi(u.z); f[6] = bflo(u.w); f[7] = bfhi(u.w); }
__device__ __forceinline__ u32x4 pack8(const float (&f)[8]) { u32x4 o; o.x = pk2(f[0], f[1]); o.y = pk2(f[2], f[3]); o.z = pk2(f[4], f[5]); o.w = pk2(f[6], f[7]); return o; }
#define MFMA16(a, b, c) __builtin_amdgcn_mfma_f32_16x16x32_bf16(a, b, c, 0, 0, 0)

__device__ __forceinline__ void ma_mlstm(const Params& P, LAS unsigned char* lds, int l, int b, int h, int pc) {
    const int tid = ltid(), lane = tid & 63, wid = __builtin_amdgcn_readfirstlane(tid >> 6);
    LAS unsigned char* Kt = lds; LAS unsigned char* Vf = lds + 34816; LAS unsigned char* Vb = lds + 69632;
    LAS float* sc = (LAS float*)(lds + 104448);
    LAS float* red = sc + 6 * 128;
    const int row0 = chunk_row0(b, pc), sq0 = (b * 4 + h) * 2;
    if (tid < 128) {
        const float* ga = P.pga + (size_t)(row0 + tid) * GA; const float* bg = P.b_ml_gates + l * 16;
        sc[tid] = ga[h] + bg[h]; sc[128 + tid] = logsigmoidf(ga[4 + h] + bg[4 + h]); sc[256 + tid] = ga[8 + h] + bg[8 + h]; sc[384 + tid] = logsigmoidf(ga[12 + h] + bg[12 + h]);
    }
    __syncthreads();
    if (wid < 2) {
        const int dir = wid; LAS float* li = sc + dir * 256; LAS float* lf = li + 128; LAS float* e = sc + 512 + dir * 128;
        const int t0 = dir ? 127 - 2 * lane : 2 * lane, t1 = dir ? 126 - 2 * lane : 2 * lane + 1;
        const float x0 = lf[t0], x1 = lf[t1];
        const float incl = wave_incl_sum(x0 + x1, lane);
        const float b0 = incl - x1, b1 = incl;
        const float bend = __int_as_float(__builtin_amdgcn_readlane(__float_as_int(incl), 63));
        const float w0 = bend - b0 + li[t0], w1 = bend - b1 + li[t1];
        const float mk = wave_max(fmaxf(w0, w1));
        e[t0] = __expf(w0 - mk); e[t1] = __expf(w1 - mk);
        if (lane == 0) { float* ms = P.mstat + ((size_t)(sq0 + dir) * 66 + pc) * 2; ms[0] = bend; ms[1] = mk; }
    }
    __syncthreads();
    {
        const int c8 = tid & 15, tb = tid >> 4, qc = h * 128 + c8 * 8;
        const float* cw = P.conv_qk + (size_t)l * 3 * 1024;
        const bool segstart = (pc == 0 || pc == 2), segend = (pc == 1 || pc == 65);
        float wq[3][8], wk[3][8];
#pragma unroll
        for (int j = 0; j < 3; ++j)
#pragma unroll
            for (int e4 = 0; e4 < 2; ++e4) {
                const float4 a = *(const float4*)(cw + j * 1024 + qc + e4 * 4), c = *(const float4*)(cw + j * 1024 + 512 + qc + e4 * 4);
                wq[j][e4 * 4 + 0] = a.x; wq[j][e4 * 4 + 1] = a.y; wq[j][e4 * 4 + 2] = a.z; wq[j][e4 * 4 + 3] = a.w;
                wk[j][e4 * 4 + 0] = c.x; wk[j][e4 * 4 + 1] = c.y; wk[j][e4 * 4 + 2] = c.z; wk[j][e4 * 4 + 3] = c.w;
            }
#pragma unroll 1
        for (int i = 0; i < 4; ++i) {
            const int t = tb + 32 * i, row = row0 + t;
            const bf16_t* pr = P.p + (size_t)row * PN;
            const bool hasL = !(t == 0 && segstart), hasR = !(t == 127 && segend);
            unsigned zz = 0u; asm volatile("" : "+v"(zz)); u32x4 z; z.x = zz; z.y = zz; z.z = zz; z.w = zz;
            const u32x4 q0 = hasL ? *(const u32x4*)(pr - PN + P_MLQ + qc) : z, q1 = *(const u32x4*)(pr + P_MLQ + qc), q2 = hasR ? *(const u32x4*)(pr + PN + P_MLQ + qc) : z;
            const u32x4 k0 = hasL ? *(const u32x4*)(pr - PN + P_MLK + qc) : z, k1 = *(const u32x4*)(pr + P_MLK + qc), k2 = hasR ? *(const u32x4*)(pr + PN + P_MLK + qc) : z;
            const u32x4 vv = *(const u32x4*)(pr + P_MLV + qc);
            float a0[8], a1[8], a2[8], r[8];
            unpack8(q0, a0); unpack8(q1, a1); unpack8(q2, a2);
#pragma unroll
            for (int e = 0; e < 8; ++e) r[e] = siluf(wq[0][e] * a0[e] + wq[1][e] * a1[e] + wq[2][e] * a2[e]);
            *(u32x4*)(P.qk + (size_t)row * 1024 + qc) = pack8(r);
            unpack8(k0, a0); unpack8(k1, a1); unpack8(k2, a2);
#pragma unroll
            for (int e = 0; e < 8; ++e) r[e] = siluf(wk[0][e] * a0[e] + wk[1][e] * a1[e] + wk[2][e] * a2[e]);
            const u32x4 kp = pack8(r);
            *(u32x4*)(P.qk + (size_t)row * 1024 + 512 + qc) = kp;
            *(LAS u32x4*)(Kt + t * TS + c8 * 16) = kp;
            unpack8(vv, a0);
            const float ef = sc[512 + t], eb = sc[640 + t];
#pragma unroll
            for (int e = 0; e < 8; ++e) { a1[e] = a0[e] * ef; a2[e] = a0[e] * eb; }
            *(LAS u32x4*)(Vf + t * TS + c8 * 16) = pack8(a1);
            *(LAS u32x4*)(Vb + t * TS + c8 * 16) = pack8(a2);
        }
    }
    __syncthreads();
    unsigned char* imgf = (unsigned char*)P.ml_ck + ((size_t)(sq0 + 0) * 66 + pc) * ML_IMG;
    unsigned char* imgb = (unsigned char*)P.ml_ck + ((size_t)(sq0 + 1) * 66 + pc) * ML_IMG;
    {
        const int g = lane >> 4, fr = lane & 15, q4 = fr >> 2, p4 = lane & 3;
        f32x4 accf[8], accb[8];
#pragma unroll
        for (int n = 0; n < 8; ++n) { accf[n] = (f32x4){0.f, 0.f, 0.f, 0.f}; accb[n] = (f32x4){0.f, 0.f, 0.f, 0.f}; }
        const unsigned kb = lds_addr(Kt), vfb = lds_addr(Vf), vbb = lds_addr(Vb);
#pragma unroll 1
        for (int ks = 0; ks < 4; ++ks) {
            const unsigned ro = (unsigned)((32 * ks + 8 * g + q4) * TS + 8 * p4);
            const bf16x8 af = tr_read1<4 * TS>(vfb + ro + wid * 32), ab = tr_read1<4 * TS>(vbb + ro + wid * 32);
            bf16x8 bfr[8];
            tr_read4<4 * TS, 32>(kb + ro, bfr[0], bfr[1], bfr[2], bfr[3]);
            tr_read4<4 * TS, 32>(kb + ro + 128, bfr[4], bfr[5], bfr[6], bfr[7]);
#pragma unroll
            for (int n = 0; n < 8; ++n) { accf[n] = MFMA16(af, bfr[n], accf[n]); accb[n] = MFMA16(ab, bfr[n], accb[n]); }
        }
#pragma unroll
        for (int n = 0; n < 8; ++n) {
            const int k = 16 * n + fr, v0 = 16 * wid + 4 * g;
            u32x2 o; o.x = pk2(accf[n][0], accf[n][1]); o.y = pk2(accf[n][2], accf[n][3]); *(u32x2*)(imgf + k * TS + v0 * 2) = o;
            o.x = pk2(accb[n][0], accb[n][1]); o.y = pk2(accb[n][2], accb[n][3]); *(u32x2*)(imgb + k * TS + v0 * 2) = o;
        }
    }
    {
        const int k = tid & 127, part = tid >> 7; float nf = 0.f, nb = 0.f;
#pragma unroll 8
        for (int s = part * 32; s < part * 32 + 32; ++s) { const float kv = bf2f(*(LAS bf16_t*)(Kt + s * TS + k * 2)); nf += sc[512 + s] * kv; nb += sc[640 + s] * kv; }
        red[(part * 2 + 0) * 128 + k] = nf; red[(part * 2 + 1) * 128 + k] = nb;
    }
    __syncthreads();
    if (tid < 256) {
        const int dir = tid >> 7, k = tid & 127;
        const float n = red[(0 * 2 + dir) * 128 + k] + red[(1 * 2 + dir) * 128 + k] + red[(2 * 2 + dir) * 128 + k] + red[(3 * 2 + dir) * 128 + k];
        unsigned zz = 0u; asm volatile("" : "+v"(zz));
        u32x4 o; o.x = pk2(n, 0.f); o.y = zz; o.z = zz; o.w = zz;
        *(u32x4*)((dir ? imgb : imgf) + k * TS + 256) = o;
    }
    __syncthreads();
}

__device__ __forceinline__ void gla_gates(const Params& P, LAS float* alr  , LAS float* segtot  , int l, int h, int tid, float (&bF)[16], float (&bB)[16], float& totF, float& totB) {
    const int k = tid & 63, seg = tid >> 6;
    const float* w2 = P.w_gla_a2 + (size_t)l * 2 * 16 * 256; const float* ba = P.b_gla_a + (size_t)l * 2 * 256;
    float wf[16], wb[16];
#pragma unroll
    for (int r = 0; r < 16; ++r) { wf[r] = w2[(0 * 16 + r) * 256 + h * 64 + k]; wb[r] = w2[(1 * 16 + r) * 256 + h * 64 + k]; }
    const float baf = ba[h * 64 + k], bab = ba[256 + h * 64 + k];
#pragma unroll
    for (int tt = 0; tt < 16; ++tt) {
        const LAS float* ar = alr + (seg * 16 + tt) * 32;
        float xf = baf, xb = bab;
#pragma unroll
        for (int r = 0; r < 16; ++r) { xf += ar[r] * wf[r]; xb += ar[16 + r] * wb[r]; }
        bF[tt] = logsigmoidf(xf) * (1.f / 16.f); bB[tt] = logsigmoidf(xb) * (1.f / 16.f);
    }
#pragma unroll
    for (int tt = 1; tt < 16; ++tt) bF[tt] += bF[tt - 1];
#pragma unroll
    for (int tt = 14; tt >= 0; --tt) bB[tt] += bB[tt + 1];
    segtot[(0 * 8 + seg) * 64 + k] = bF[15]; segtot[(1 * 8 + seg) * 64 + k] = bB[0];
    __syncthreads();
    float offF = 0.f, offB = 0.f; totF = 0.f; totB = 0.f;
#pragma unroll
    for (int s2 = 0; s2 < 8; ++s2) { const float a = segtot[(0 * 8 + s2) * 64 + k], c = segtot[(1 * 8 + s2) * 64 + k]; totF += a; totB += c; offF += (s2 < seg) ? a : 0.f; offB += (s2 > seg) ? c : 0.f; }
#pragma unroll
    for (int tt = 0; tt < 16; ++tt) { bF[tt] += offF; bB[tt] += offB; }
}
__device__ __forceinline__ void gla_stage_alr(const Params& P, LAS float* alr, int row0, int tid) {
    const int t = tid >> 2, part = tid & 3;
    const float* src = P.pga + (size_t)(row0 + t) * GA + 16 + part * 8;
    const f32x4 a = *(const f32x4*)src, c = *(const f32x4*)(src + 4);
    *(LAS f32x4*)(alr + t * 32 + part * 8) = a; *(LAS f32x4*)(alr + t * 32 + part * 8 + 4) = c;
}

__device__ __forceinline__ void ma_gla(const Params& P, LAS unsigned char* lds, int l, int b, int h, int pc) {
    const int tid = ltid(), lane = tid & 63, wid = __builtin_amdgcn_readfirstlane(tid >> 6);
    LAS unsigned char* Vt = lds; LAS unsigned char* Kdf = lds + 34816; LAS unsigned char* Kdb = lds + 53248;
    LAS float* alr = (LAS float*)(lds + 71680); LAS float* segtot = (LAS float*)(lds + 88064);
    const int row0 = chunk_row0(b, pc), sq0 = (b * 4 + h) * 2;
    gla_stage_alr(P, alr, row0, tid);
#pragma unroll
    for (int i = 0; i < 4; ++i) { const int id = tid + 512 * i, t = id >> 4, c = id & 15; *(LAS u32x4*)(Vt + t * TS + c * 16) = *(const u32x4*)(P.p + (size_t)(row0 + t) * PN + P_GV + h * 128 + c * 8); }
    __syncthreads();
    {
        float bF[16], bB[16], totF, totB;
        gla_gates(P, alr, segtot, l, h, tid, bF, bB, totF, totB);
        const int k = tid & 63, seg = tid >> 6;
#pragma unroll
        for (int tt = 0; tt < 16; ++tt) {
            const int t = seg * 16 + tt;
            const float kr = bf2f(P.p[(size_t)(row0 + t) * PN + P_GK + h * 64 + k]);
            const unsigned pf = pk2(kr * __expf(totF - bF[tt]), kr * __expf(totB - bB[tt]));
            *(LAS bf16_t*)(Kdf + t * TS64 + k * 2) = (bf16_t)(pf & 0xffffu); *(LAS bf16_t*)(Kdb + t * TS64 + k * 2) = (bf16_t)(pf >> 16);
        }
        if (seg == 0) { P.gbend[((size_t)(sq0 + 0) * 66 + pc) * 64 + k] = totF; P.gbend[((size_t)(sq0 + 1) * 66 + pc) * 64 + k] = totB; }
    }
    __syncthreads();
    unsigned char* imgf = (unsigned char*)P.gl_ck + ((size_t)(sq0 + 0) * 66 + pc) * GL_IMG;
    unsigned char* imgb = (unsigned char*)P.gl_ck + ((size_t)(sq0 + 1) * 66 + pc) * GL_IMG;
    {
        const int g = lane >> 4, fr = lane & 15, q4 = fr >> 2, p4 = lane & 3;
        f32x4 accf[4], accb[4];
#pragma unroll
        for (int n = 0; n < 4; ++n) { accf[n] = (f32x4){0.f, 0.f, 0.f, 0.f}; accb[n] = (f32x4){0.f, 0.f, 0.f, 0.f}; }
        const unsigned vb = lds_addr(Vt), kfb = lds_addr(Kdf), kbb = lds_addr(Kdb);
#pragma unroll 1
        for (int ks = 0; ks < 4; ++ks) {
            const int rr = 32 * ks + 8 * g + q4;
            const bf16x8 a = tr_read1<4 * TS>(vb + (unsigned)(rr * TS + 8 * p4) + wid * 32);
            bf16x8 bf[4], bb[4];
            tr_read4<4 * TS64, 32>(kfb + (unsigned)(rr * TS64 + 8 * p4), bf[0], bf[1], bf[2], bf[3]);
            tr_read4<4 * TS64, 32>(kbb + (unsigned)(rr * TS64 + 8 * p4), bb[0], bb[1], bb[2], bb[3]);
#pragma unroll
            for (int n = 0; n < 4; ++n) { accf[n] = MFMA16(a, bf[n], accf[n]); accb[n] = MFMA16(a, bb[n], accb[n]); }
        }
#pragma unroll
        for (int n = 0; n < 4; ++n) {
            const int k = 16 * n + fr, v0 = 16 * wid + 4 * g;
            u32x2 o; o.x = pk2(accf[n][0], accf[n][1]); o.y = pk2(accf[n][2], accf[n][3]); *(u32x2*)(imgf + k * TS + v0 * 2) = o;
            o.x = pk2(accb[n][0], accb[n][1]); o.y = pk2(accb[n][2], accb[n][3]); *(u32x2*)(imgb + k * TS + v0 * 2) = o;
        }
    }
    if (tid < 128) { const int dir = tid >> 6, k = tid & 63; unsigned zz = 0u; asm volatile("" : "+v"(zz)); u32x4 o; o.x = zz; o.y = zz; o.z = zz; o.w = zz; *(u32x4*)((dir ? imgb : imgf) + k * TS + 256) = o; }
    __syncthreads();
}

__device__ __forceinline__ void phase_mix_a(const Params& P, LAS unsigned char* lds, int l, int wg, int nwg) {
    for (int it = wg; it < 2 * 8 * 66; it += nwg) {
        const int mixer = it / 528, r = it % 528, bh = r / 66, pc = r % 66;
        if (mixer == 0) ma_mlstm(P, lds, l, bh >> 2, bh & 3, pc); else ma_gla(P, lds, l, bh >> 2, bh & 3, pc);
    }
}

__device__ __forceinline__ void phase_mix_b(const Params& P, int wg, int nwg) {
    constexpr int MLC = ML_IMG / 16, GLC = GL_IMG / 16;
    const int gt = wg * NTHR + ltid(), ngt = nwg * NTHR;
    for (int task = gt; task < 16 * (MLC + GLC); task += ngt) {
        float st[8];
#pragma unroll
        for (int e = 0; e < 8; ++e) st[e] = 0.f;
        if (task < 16 * MLC) {
            const int sq = task / MLC, ci = task % MLC, dir = sq & 1;
            const unsigned char* src = (const unsigned char*)P.ml_ck + (size_t)sq * 66 * ML_IMG + ci * 16;
            unsigned char* dst = (unsigned char*)P.ml_pre + (size_t)sq * 66 * ML_IMG + ci * 16;
            const float* ms = P.mstat + (size_t)sq * 66 * 2;
            float m = 0.f;
#pragma unroll 1
            for (int j0 = 0; j0 < 66; j0 += 11) {
                u32x4 cv[11]; float be[11], mk[11];
#pragma unroll
                for (int u = 0; u < 11; ++u) { const int pc = virt_pc(dir, j0 + u); cv[u] = *(const u32x4*)(src + (size_t)pc * ML_IMG); be[u] = ms[pc * 2]; mk[u] = ms[pc * 2 + 1]; }
#pragma unroll
                for (int u = 0; u < 11; ++u) {
                    const int pc = virt_pc(dir, j0 + u);
                    *(u32x4*)(dst + (size_t)pc * ML_IMG) = pack8(st);
                    if (ci == 0) P.mprev[sq * 66 + pc] = m;
                    const float mn = fmaxf(be[u] + m, mk[u]), ao = __expf(be[u] + m - mn), an = __expf(mk[u] - mn);
                    float c[8]; unpack8(cv[u], c);
#pragma unroll
                    for (int e = 0; e < 8; ++e) st[e] = ao * st[e] + an * c[e];
                    m = mn;
                }
            }
        } else {
            const int t2 = task - 16 * MLC, sq = t2 / GLC, ci = t2 % GLC, dir = sq & 1, k = (ci * 16) / TS;
            const unsigned char* src = (const unsigned char*)P.gl_ck + (size_t)sq * 66 * GL_IMG + ci * 16;
            unsigned char* dst = (unsigned char*)P.gl_pre + (size_t)sq * 66 * GL_IMG + ci * 16;
            const float* gb = P.gbend + (size_t)sq * 66 * 64 + k;
#pragma unroll 1
            for (int j0 = 0; j0 < 66; j0 += 11) {
                u32x4 cv[11]; float be[11];
#pragma unroll
                for (int u = 0; u < 11; ++u) { const int pc = virt_pc(dir, j0 + u); cv[u] = *(const u32x4*)(src + (size_t)pc * GL_IMG); be[u] = gb[pc * 64]; }
#pragma unroll
                for (int u = 0; u < 11; ++u) {
                    const int pc = virt_pc(dir, j0 + u);
                    *(u32x4*)(dst + (size_t)pc * GL_IMG) = pack8(st);
                    const float dc = __expf(be[u]);
                    float c[8]; unpack8(cv[u], c);
#pragma unroll
                    for (int e = 0; e < 8; ++e) st[e] = dc * st[e] + c[e];
                }
            }
        }
    }
}

__device__ __forceinline__ void mc_mlstm(const Params& P, LAS unsigned char* lds, int l, int b, int h, int pc) {
    const int tid = ltid(), lane = tid & 63, wid = __builtin_amdgcn_readfirstlane(tid >> 6);
    const int g = lane >> 4, fr = lane & 15, q4 = fr >> 2, p4 = lane & 3;
    LAS unsigned char* Qt = lds; LAS unsigned char* Kt = lds + 34816; LAS unsigned char* V1 = lds + 69632; LAS unsigned char* CT = lds + 108544;
    LAS float* sc = (LAS float*)(lds + 143488);
    const int row0 = chunk_row0(b, pc), sq0 = (b * 4 + h) * 2;
    const float scale = 0.08838834764831845f;
    if (tid < 128) {
        const float* ga = P.pga + (size_t)(row0 + tid) * GA; const float* bg = P.b_ml_gates + l * 16;
        sc[tid] = ga[h] + bg[h]; sc[128 + tid] = logsigmoidf(ga[4 + h] + bg[4 + h]); sc[256 + tid] = ga[8 + h] + bg[8 + h]; sc[384 + tid] = logsigmoidf(ga[12 + h] + bg[12 + h]);
        unsigned zz = 0u; asm volatile("" : "+v"(zz));
        u32x4 o; o.x = zz | 0x00003F80u; o.y = zz; o.z = zz; o.w = zz;
        *(LAS u32x4*)(V1 + tid * VS + 256) = o; o.x = zz; *(LAS u32x4*)(V1 + tid * VS + 272) = o; *(LAS u32x4*)(V1 + tid * VS + 288) = o;
    }
#pragma unroll
    for (int i = 0; i < 4; ++i) {
        const int id = tid + 512 * i, t = id >> 4, c = id & 15;
        *(LAS u32x4*)(Qt + t * TS + c * 16) = *(const u32x4*)(P.qk + (size_t)(row0 + t) * 1024 + h * 128 + c * 8);
        *(LAS u32x4*)(Kt + t * TS + c * 16) = *(const u32x4*)(P.qk + (size_t)(row0 + t) * 1024 + 512 + h * 128 + c * 8);
        *(LAS u32x4*)(V1 + t * VS + c * 16) = *(const u32x4*)(P.p + (size_t)(row0 + t) * PN + P_MLV + h * 128 + c * 8);
    }
    {
        const unsigned char* img = (const unsigned char*)P.ml_pre + ((size_t)(sq0 + 0) * 66 + pc) * ML_IMG;
        for (int id = tid; id < ML_IMG / 16; id += NTHR) *(LAS u32x4*)(CT + id * 16) = *(const u32x4*)(img + id * 16);
    }
    __syncthreads();
    if (wid < 2) {
        const int dir = wid; LAS float* li = sc + dir * 256; LAS float* lf = li + 128; LAS float* o = sc + (4 + 4 * dir) * 128;
        const int t0 = dir ? 127 - 2 * lane : 2 * lane, t1 = dir ? 126 - 2 * lane : 2 * lane + 1;
        const float x0 = lf[t0], x1 = lf[t1];
        const float incl = wave_incl_sum(x0 + x1, lane);
        const float b0 = incl - x1, b1 = incl;
        const float g0 = li[t0] - b0, g1 = li[t1] - b1;
        const float pmx = wave_incl_max(fmaxf(g0, g1), lane);
        float pex = __shfl_up(pmx, 1); if (lane == 0) pex = -3.0e38f;
        const float pm0 = fmaxf(pex, g0), pm1 = pmx;
        const float mp = P.mprev[(sq0 + dir) * 66 + pc];
        const float m0 = fmaxf(b0 + mp, b0 + pm0), m1 = fmaxf(b1 + mp, b1 + pm1);
        o[t0] = b0 - m0; o[128 + t0] = g0; o[256 + t0] = __expf(b0 + mp - m0); o[384 + t0] = __expf(-m0);
        o[t1] = b1 - m1; o[128 + t1] = g1; o[256 + t1] = __expf(b1 + mp - m1); o[384 + t1] = __expf(-m1);
    }
    __syncthreads();
    bf16x8 qf[4];
#pragma unroll
    for (int kk = 0; kk < 4; ++kk) qf[kk] = *(const LAS bf16x8*)(Qt + (16 * wid + fr) * TS + (32 * kk + 8 * g) * 2);
    f32x4 hsum[8];
#pragma unroll
    for (int n = 0; n < 8; ++n) hsum[n] = (f32x4){0.f, 0.f, 0.f, 0.f};
    const unsigned ctb = lds_addr(CT), v1b = lds_addr(V1);
    const int tq = 16 * wid + fr;
#pragma unroll 1
    for (int dir = 0; dir < 2; ++dir) {
        if (dir == 1) {
            __syncthreads();
            const unsigned char* img = (const unsigned char*)P.ml_pre + ((size_t)(sq0 + 1) * 66 + pc) * ML_IMG;
            for (int id = tid; id < ML_IMG / 16; id += NTHR) *(LAS u32x4*)(CT + id * 16) = *(const u32x4*)(img + id * 16);
            __syncthreads();
        }
        LAS float* so = sc + (4 + 4 * dir) * 128;
        f32x4 acc[9];
#pragma unroll
        for (int n = 0; n < 9; ++n) acc[n] = (f32x4){0.f, 0.f, 0.f, 0.f};
#pragma unroll
        for (int kk = 0; kk < 4; ++kk) {
            const unsigned ro = ctb + (unsigned)((32 * kk + 8 * g + q4) * TS + 8 * p4);
            bf16x8 bfr[9];
            tr_read4<4 * TS, 32>(ro, bfr[0], bfr[1], bfr[2], bfr[3]);
            tr_read4<4 * TS, 32>(ro + 128, bfr[4], bfr[5], bfr[6], bfr[7]);
            bfr[8] = tr_read1<4 * TS>(ro + 256);
#pragma unroll
            for (int n = 0; n < 9; ++n) acc[n] = MFMA16(qf[kk], bfr[n], acc[n]);
        }
#pragma unroll
        for (int j = 0; j < 4; ++j) { const float as = so[256 + 16 * wid + 4 * g + j] * scale;
#pragma unroll
            for (int n = 0; n < 9; ++n) acc[n][j] *= as; }
        const float ut = so[tq];
        const int ilo = dir ? (wid >> 1) : 0, ihi = dir ? 3 : (wid >> 1);
#pragma unroll 1
        for (int i = ilo; i <= ihi; ++i) {
            unsigned pw[4];
#pragma unroll
            for (int half = 0; half < 2; ++half) {
                const int sb = 2 * i + half;
                f32x4 d = (f32x4){0.f, 0.f, 0.f, 0.f};
#pragma unroll
                for (int kk = 0; kk < 4; ++kk) { const bf16x8 kf = *(const LAS bf16x8*)(Kt + (16 * sb + fr) * TS + (32 * kk + 8 * g) * 2); d = MFMA16(kf, qf[kk], d); }
                float pv[4];
#pragma unroll
                for (int j = 0; j < 4; ++j) {
                    const int s = 16 * sb + 4 * g + j;
                    const bool valid = dir ? (s >= tq) : (s <= tq);
                    const float arg = ut + so[128 + s];
                    pv[j] = valid ? d[j] * scale * __expf(arg) : 0.f;
                }
                pw[half * 2 + 0] = pk2(pv[0], pv[1]); pw[half * 2 + 1] = pk2(pv[2], pv[3]);
            }
            u32x4 pu; pu.x = pw[0]; pu.y = pw[1]; pu.z = pw[2]; pu.w = pw[3];
            const bf16x8 pa = __builtin_bit_cast(bf16x8, pu);
            const unsigned ro = v1b + (unsigned)((32 * i + 4 * g + q4) * VS + 8 * p4);
            bf16x8 bfr[9];
            tr_read4<16 * VS, 32>(ro, bfr[0], bfr[1], bfr[2], bfr[3]);
            tr_read4<16 * VS, 32>(ro + 128, bfr[4], bfr[5], bfr[6], bfr[7]);
            bfr[8] = tr_read1<16 * VS>(ro + 256);
#pragma unroll
            for (int n = 0; n < 9; ++n) acc[n] = MFMA16(pa, bfr[n], acc[n]);
        }
#pragma unroll
        for (int j = 0; j < 4; ++j) {
            const float den = __shfl(acc[8][j], lane & 48);
            const float dn = fmaxf(fabsf(den), so[384 + 16 * wid + 4 * g + j]);
            const float inv = 1.f / dn;
#pragma unroll
            for (int n = 0; n < 8; ++n) hsum[n][j] += acc[n][j] * inv;
        }
    }
    const float* gml = P.g_ml_norm + l * 512 + h * 128;
    __syncthreads();
#pragma unroll
    for (int j = 0; j < 4; ++j) {
        float ss = 0.f;
#pragma unroll
        for (int n = 0; n < 8; ++n) ss += hsum[n][j] * hsum[n][j];
        ss += __shfl_xor(ss, 1); ss += __shfl_xor(ss, 2); ss += __shfl_xor(ss, 4); ss += __shfl_xor(ss, 8);
        const float rstd = rsqrtf(ss * (1.f / 128.f) + EPS);
#pragma unroll
        for (int n = 0; n < 8; ++n) { const int v = 16 * n + fr; *(LAS bf16_t*)(Qt + (16 * wid + 4 * g + j) * TS + v * 2) = (bf16_t)(pk2(hsum[n][j] * rstd * gml[v], 0.f) & 0xffffu); }
    }
    __syncthreads();
#pragma unroll
    for (int i = 0; i < 4; ++i) {
        const int id = tid + 512 * i, t = id >> 4, c = id & 15;
        float a[8], og[8];
        unpack8(*(const LAS u32x4*)(Qt + t * TS + c * 16), a);
        unpack8(*(const u32x4*)(P.p + (size_t)(row0 + t) * PN + P_MLO + h * 128 + c * 8), og);
#pragma unroll
        for (int e = 0; e < 8; ++e) a[e] *= sigmoidf(og[e]);
        *(u32x4*)(P.abuf + (size_t)(row0 + t) * 1024 + h * 128 + c * 8) = pack8(a);
    }
    __syncthreads();
}

__device__ __forceinline__ void mc_gla(const Params& P, LAS unsigned char* lds, int l, int b, int h, int pc) {
    const int tid = ltid(), lane = tid & 63, wid = __builtin_amdgcn_readfirstlane(tid >> 6);
    const int g = lane >> 4, fr = lane & 15, q4 = fr >> 2, p4 = lane & 3;
    LAS unsigned char* Qf = lds; LAS unsigned char* Kf = lds + 18432; LAS unsigned char* Qb = lds + 36864; LAS unsigned char* Kb = lds + 55296;
    LAS unsigned char* Vt = lds + 73728; LAS unsigned char* Sf = lds + 108544; LAS unsigned char* Sb = lds + 126080;
    LAS float* segtot = (LAS float*)(lds + 143616);
    LAS float* alr = (LAS float*)Sf;
    const int row0 = chunk_row0(b, pc), sq0 = (b * 4 + h) * 2;
    gla_stage_alr(P, alr, row0, tid);
    __syncthreads();
    {
        float bF[16], bB[16], totF, totB;
        gla_gates(P, alr, segtot, l, h, tid, bF, bB, totF, totB);
        const int k = tid & 63, seg = tid >> 6;
#pragma unroll
        for (int tt = 0; tt < 16; ++tt) {
            const int t = seg * 16 + tt;
            const float qr = bf2f(P.p[(size_t)(row0 + t) * PN + P_GQ + h * 64 + k]) * 0.125f, kr = bf2f(P.p[(size_t)(row0 + t) * PN + P_GK + h * 64 + k]);
            const unsigned a = pk2(qr * __expf(bF[tt]), kr * __expf(-bF[tt])), c = pk2(qr * __expf(bB[tt]), kr * __expf(-bB[tt]));
            *(LAS bf16_t*)(Qf + t * TS64 + k * 2) = (bf16_t)(a & 0xffffu); *(LAS bf16_t*)(Kf + t * TS64 + k * 2) = (bf16_t)(a >> 16);
            *(LAS bf16_t*)(Qb + t * TS64 + k * 2) = (bf16_t)(c & 0xffffu); *(LAS bf16_t*)(Kb + t * TS64 + k * 2) = (bf16_t)(c >> 16);
        }
    }
    __syncthreads();
#pragma unroll
    for (int i = 0; i < 4; ++i) { const int id = tid + 512 * i, t = id >> 4, c = id & 15; *(LAS u32x4*)(Vt + t * TS + c * 16) = *(const u32x4*)(P.p + (size_t)(row0 + t) * PN + P_GV + h * 128 + c * 8); }
    {
        const unsigned char* i0 = (const unsigned char*)P.gl_pre + ((size_t)(sq0 + 0) * 66 + pc) * GL_IMG;
        const unsigned char* i1 = (const unsigned char*)P.gl_pre + ((size_t)(sq0 + 1) * 66 + pc) * GL_IMG;
        for (int id = tid; id < GL_IMG / 16; id += NTHR) { *(LAS u32x4*)(Sf + id * 16) = *(const u32x4*)(i0 + id * 16); *(LAS u32x4*)(Sb + id * 16) = *(const u32x4*)(i1 + id * 16); }
    }
    __syncthreads();
    f32x4 acc[8];
#pragma unroll
    for (int n = 0; n < 8; ++n) acc[n] = (f32x4){0.f, 0.f, 0.f, 0.f};
    const unsigned vtb = lds_addr(Vt);
    const int tq = 16 * wid + fr;
#pragma unroll 1
    for (int dir = 0; dir < 2; ++dir) {
        LAS unsigned char* Qd = dir ? Qb : Qf; LAS unsigned char* Kd = dir ? Kb : Kf;
        const unsigned sb_ = lds_addr(dir ? Sb : Sf);
        bf16x8 qf[2];
#pragma unroll
        for (int kk = 0; kk < 2; ++kk) qf[kk] = *(const LAS bf16x8*)(Qd + (16 * wid + fr) * TS64 + (32 * kk + 8 * g) * 2);
#pragma unroll
        for (int kk = 0; kk < 2; ++kk) {
            const unsigned ro = sb_ + (unsigned)((32 * kk + 8 * g + q4) * TS + 8 * p4);
            bf16x8 bfr[8];
            tr_read4<4 * TS, 32>(ro, bfr[0], bfr[1], bfr[2], bfr[3]);
            tr_read4<4 * TS, 32>(ro + 128, bfr[4], bfr[5], bfr[6], bfr[7]);
#pragma unroll
            for (int n = 0; n < 8; ++n) acc[n] = MFMA16(qf[kk], bfr[n], acc[n]);
        }
        const int ilo = dir ? (wid >> 1) : 0, ihi = dir ? 3 : (wid >> 1);
#pragma unroll 1
        for (int i = ilo; i <= ihi; ++i) {
            unsigned pw[4];
#pragma unroll
            for (int half = 0; half < 2; ++half) {
                const int sb = 2 * i + half;
                f32x4 d = (f32x4){0.f, 0.f, 0.f, 0.f};
#pragma unroll
                for (int kk = 0; kk < 2; ++kk) { const bf16x8 kf = *(const LAS bf16x8*)(Kd + (16 * sb + fr) * TS64 + (32 * kk + 8 * g) * 2); d = MFMA16(kf, qf[kk], d); }
                float pv[4];
#pragma unroll
                for (int j = 0; j < 4; ++j) { const int s = 16 * sb + 4 * g + j; const bool valid = dir ? (s >= tq) : (s <= tq); pv[j] = valid ? d[j] : 0.f; }
                pw[half * 2 + 0] = pk2(pv[0], pv[1]); pw[half * 2 + 1] = pk2(pv[2], pv[3]);
            }
            u32x4 pu; pu.x = pw[0]; pu.y = pw[1]; pu.z = pw[2]; pu.w = pw[3];
            const bf16x8 pa = __builtin_bit_cast(bf16x8, pu);
            const unsigned ro = vtb + (unsigned)((32 * i + 4 * g + q4) * TS + 8 * p4);
            bf16x8 bfr[8];
            tr_read4<16 * TS, 32>(ro, bfr[0], bfr[1], bfr[2], bfr[3]);
            tr_read4<16 * TS, 32>(ro + 128, bfr[4], bfr[5], bfr[6], bfr[7]);
#pragma unroll
            for (int n = 0; n < 8; ++n) acc[n] = MFMA16(pa, bfr[n], acc[n]);
        }
    }
    const float* ggl = P.g_gla_norm + l * 512 + h * 128;
    __syncthreads();
#pragma unroll
    for (int j = 0; j < 4; ++j) {
        float ss = 0.f;
#pragma unroll
        for (int n = 0; n < 8; ++n) ss += acc[n][j] * acc[n][j];
        ss += __shfl_xor(ss, 1); ss += __shfl_xor(ss, 2); ss += __shfl_xor(ss, 4); ss += __shfl_xor(ss, 8);
        const float rstd = rsqrtf(ss * (1.f / 128.f) + EPS);
#pragma unroll
        for (int n = 0; n < 8; ++n) { const int v = 16 * n + fr; *(LAS bf16_t*)(Vt + (16 * wid + 4 * g + j) * TS + v * 2) = (bf16_t)(pk2(acc[n][j] * rstd * ggl[v], 0.f) & 0xffffu); }
    }
    __syncthreads();
#pragma unroll
    for (int i = 0; i < 4; ++i) {
        const int id = tid + 512 * i, t = id >> 4, c = id & 15;
        float a[8], rg[8];
        unpack8(*(const LAS u32x4*)(Vt + t * TS + c * 16), a);
        unpack8(*(const u32x4*)(P.p + (size_t)(row0 + t) * PN + P_GR + h * 128 + c * 8), rg);
#pragma unroll
        for (int e = 0; e < 8; ++e) a[e] *= siluf(rg[e]);
        *(u32x4*)(P.abuf + (size_t)(row0 + t) * 1024 + 512 + h * 128 + c * 8) = pack8(a);
    }
    __syncthreads();
}

__device__ __forceinline__ void phase_mix_c(const Params& P, LAS unsigned char* lds, int l, int pc0, int wg, int nwg) {
    const int npc = 66 - pc0, per = 8 * npc;
    for (int it = wg; it < 2 * per; it += nwg) {
        const int mixer = it / per, r = it % per, bh = r / npc, pc = pc0 + r % npc;
        if (mixer == 0) mc_mlstm(P, lds, l, bh >> 2, bh & 3, pc); else mc_gla(P, lds, l, bh >> 2, bh & 3, pc);
    }
}


#define XB_TMO      128
#define XB_XCNT(j)  (256  + 64 * (j))
#define XB_XSUB(j)  (1280 + 64 * (j))
#define XB_XGEN(j)  (2304 + 64 * (j))
#define XB_TOP      3328
#define XB_TOPGEN   3392
#define XCD_BAR_WORDS 3456
#define XB_SPIN_CAP (1u << 22)
__device__ __forceinline__ unsigned xb_ld(unsigned* p)              { return __hip_atomic_load(p, __ATOMIC_RELAXED, __HIP_MEMORY_SCOPE_AGENT); }
__device__ __forceinline__ unsigned xb_add(unsigned* p, unsigned v) { return __hip_atomic_fetch_add(p, v, __ATOMIC_RELAXED, __HIP_MEMORY_SCOPE_AGENT); }
__device__ __forceinline__ unsigned xb_xcc_id() { return (unsigned)__builtin_amdgcn_s_getreg((3 << 11) | 20) & 0xFu; }
#define XB_SPIN(cond, bar) do { unsigned _sp = 0; while (cond) { __builtin_amdgcn_s_sleep(1); \
    if ((++_sp & 255u) == 0u) { if (xb_ld(&(bar)[XB_TMO])) break; if (_sp > XB_SPIN_CAP) { atomicAdd(&(bar)[XB_TMO], 1u); break; } } } } while (0)
struct XcdBarrier { unsigned* bar; unsigned x; volatile LAS unsigned* st; };
__device__ __forceinline__ XcdBarrier xcd_barrier_post(unsigned* bar, volatile LAS unsigned* st) {
    XcdBarrier b; b.bar = bar; b.x = xb_xcc_id(); b.st = st;
    if (threadIdx.x == 0) (void)xb_add(&bar[XB_XCNT(b.x)], 1u);
    return b;
}
__device__ __forceinline__ void xcd_barrier_complete(unsigned* bar, unsigned x, unsigned& nloc, unsigned& nx) {
    const unsigned G = gridDim.x * gridDim.y * gridDim.z;
    unsigned sum, cnt, mine, sp = 0u;
    for (;;) {
        sum = 0u; cnt = 0u; mine = 0u;
#pragma unroll
        for (unsigned j = 0; j < 16; ++j) { const unsigned c = xb_ld(&bar[XB_XCNT(j)]); sum += c; cnt += (c > 0u) ? 1u : 0u; mine = (j == x) ? c : mine; }
        if (sum == G) break;
        __builtin_amdgcn_s_sleep(1);
        if ((++sp & 255u) == 0u) { if (xb_ld(&bar[XB_TMO])) break; if (sp > XB_SPIN_CAP) { atomicAdd(&bar[XB_TMO], 1u); break; } }
    }
    nloc = mine > 0u ? mine : 1u; nx = cnt > 0u ? cnt : 1u;
}
__device__ __forceinline__ void xcd_barrier(const XcdBarrier& b) {
    asm volatile("s_waitcnt vmcnt(0)" ::: "memory");
    __syncthreads();
    if (threadIdx.x == 0) {
        unsigned* bar = b.bar;
        unsigned bx = b.x; asm volatile("" : "+v"(bx));
        __builtin_amdgcn_s_waitcnt(0);
        unsigned nloc = b.st[0], nx = b.st[1];
        if (nloc == 0u) { xcd_barrier_complete(bar, bx, nloc, nx); b.st[0] = nloc; b.st[1] = nx; }
        const unsigned old = xb_add(&bar[XB_XSUB(bx)], 1u);
        const unsigned gen = old / nloc;
        if (old + 1u == (gen + 1u) * nloc) {
            __builtin_amdgcn_fence(__ATOMIC_RELEASE, "agent");
            asm volatile("s_waitcnt vmcnt(0)" ::: "memory");
            const unsigned og = xb_add(&bar[XB_TOP], 1u);
            const unsigned tg = og / nx;
            if (og + 1u == (tg + 1u) * nx) xb_add(&bar[XB_TOPGEN], 1u);
            else XB_SPIN(xb_ld(&bar[XB_TOPGEN]) == tg, bar);
            __builtin_amdgcn_fence(__ATOMIC_ACQUIRE, "agent");
            xb_add(&bar[XB_XGEN(bx)], 1u);
            asm volatile("s_waitcnt vmcnt(0)" ::: "memory");
        } else {
            XB_SPIN(xb_ld(&bar[XB_XGEN(bx)]) == gen, bar);
            __builtin_amdgcn_fence(__ATOMIC_ACQUIRE, "agent");
            asm volatile("s_waitcnt vmcnt(0)" ::: "memory");
        }
    }
    __syncthreads();
}

__device__ __forceinline__ void topk_list(const Params& P, LAS unsigned char* lds, int list) {
    LAS unsigned* keys = (LAS unsigned*)lds;
    LAS unsigned* hist = keys + 8192;
    LAS unsigned* ctl = hist + 256;
    LAS unsigned* wsum = ctl + 4;
    const int tid = ltid(), lane = tid & 63, wid = tid >> 6;
    const int isctx = list >= 32, b = (list & 31) >> 4, e = list & 15;
    const int n = isctx ? CTX : SEQ, cap = n / 8;
    const int row0 = isctx ? NLAT + b * CTX : b * SEQ;
    const int segoff = isctx ? 2048 + b * 32 : b * 1024;
    for (int i = tid; i < n; i += NTHR) keys[i] = __float_as_uint(P.aff[(size_t)(row0 + i) * 16 + e]);
    unsigned prefix = 0u, mask = 0u; unsigned kth = (unsigned)cap;
    for (int pass = 0; pass < 4; ++pass) {
        const int shift = 24 - 8 * pass;
        if (tid < 256) hist[tid] = 0u;
        __syncthreads();
        for (int i = tid; i < n; i += NTHR) { const unsigned key = keys[i]; if ((key & mask) == prefix) __hip_atomic_fetch_add(&hist[(key >> shift) & 255u], 1u, __ATOMIC_RELAXED, __HIP_MEMORY_SCOPE_WORKGROUP); }
        __syncthreads();
        if (wid == 0) {
            const unsigned h0 = hist[4 * lane], h1 = hist[4 * lane + 1], h2 = hist[4 * lane + 2], h3 = hist[4 * lane + 3];
            const unsigned s = h0 + h1 + h2 + h3;
            unsigned suf = s;
#pragma unroll
            for (int o = 1; o < 64; o <<= 1) { const unsigned y = __shfl_down(suf, o); if (lane + o < 64) suf += y; }
            unsigned above = suf - s;
            if (above < kth && kth <= above + h3) { ctl[0] = 4 * lane + 3; ctl[1] = kth - above; }
            above += h3;
            if (above < kth && kth <= above + h2) { ctl[0] = 4 * lane + 2; ctl[1] = kth - above; }
            above += h2;
            if (above < kth && kth <= above + h1) { ctl[0] = 4 * lane + 1; ctl[1] = kth - above; }
            above += h1;
            if (above < kth && kth <= above + h0) { ctl[0] = 4 * lane + 0; ctl[1] = kth - above; }
        }
        __syncthreads();
        prefix |= ctl[0] << shift; mask |= 255u << shift; kth = ctl[1];
        __syncthreads();
    }
    const unsigned T = prefix, need_eq = kth;
    const int per = n / NTHR > 0 ? n / NTHR : 1;
    const int i0 = tid * per; const bool act = i0 < n;
    unsigned cgt = 0u, ceq = 0u;
    if (act) for (int i = 0; i < per; ++i) { const unsigned key = keys[i0 + i]; cgt += key > T; ceq += key == T; }
    const unsigned pk = (cgt << 16) | ceq; unsigned inc = pk;
#pragma unroll
    for (int o = 1; o < 64; o <<= 1) { const unsigned y = __shfl_up(inc, o); if (lane >= o) inc += y; }
    if (lane == 63) wsum[wid] = inc;
    __syncthreads();
    unsigned base = 0u;
    for (int w = 0; w < wid; ++w) base += wsum[w];
    const unsigned excl = base + inc - pk;
    unsigned gtb = excl >> 16, eqb = excl & 0xffffu;
    if (act) for (int i = 0; i < per; ++i) {
        const unsigned key = keys[i0 + i];
        int pr = -1;
        if (key > T) { pr = e * MZ + segoff + (int)(gtb + (eqb < need_eq ? eqb : need_eq)); ++gtb; }
        else if (key == T) { if (eqb < need_eq) pr = e * MZ + segoff + (int)(gtb + eqb); ++eqb; }
        if (pr >= 0) { P.glist[pr] = row0 + i0 + i; P.gval[pr] = __uint_as_float(key); }
        P.inv[(size_t)(row0 + i0 + i) * 16 + e] = pr;
    }
    __syncthreads();
}
__device__ __forceinline__ void phase_topk_prep(const Params& P, LAS unsigned char* lds, int l, int nlists, int wg, int nwg) {
    if (wg < nlists) topk_list(P, lds, wg);
    phase_prep_experts(P, lds, l, wg, nwg);
}

__device__ __forceinline__ void phase_rowop_post_pre(const Params& P, int l, int nrows, int wg, int nwg, int dry = 0) {
    const int tid_ = ltid(), lane = tid_ & 63, gw = wg * 8 + (tid_ >> 6), ngw = nwg * 8;
    const float* g_post = P.g_ffn_post + l * 1024;
    const bf16_t* yp = P.r1;
    const int nl = l + 1;
    for (int row = gw; row < nrows; row += ngw) {
        float* xr = xrow_ptr(P, row);
        const float* m = P.mod + ((size_t)l * 3 + modrow(row)) * 6144;
        float f[16];
#pragma unroll
        for (int i = 0; i < 16; ++i) f[i] = 0;
        const int myinv = P.inv[(size_t)row * 16 + (lane & 15)];
#pragma unroll 1
        for (int e = 0; e < 16; ++e) {
            const int pr = __shfl(myinv, e);
            if (pr >= 0) {
#pragma unroll
                for (int j = 0; j < 4; ++j) { const u32x2 u = *(const u32x2*)(yp + (size_t)pr * 1024 + j * 256 + lane * 4); f[j * 4 + 0] += bflo(u.x); f[j * 4 + 1] += bfhi(u.x); f[j * 4 + 2] += bflo(u.y); f[j * 4 + 3] += bfhi(u.y); }
            }
        }
        float ss = 0;
#pragma unroll
        for (int i = 0; i < 16; ++i) ss += f[i] * f[i];
        float rstd = rsqrtf(wave_sum(ss) * (1.f / 1024.f) + EPS);
        float xv[16]; ss = 0;
#pragma unroll
        for (int j = 0; j < 4; ++j) {
            const int col = j * 256 + lane * 4;
            const float4 xo = *(const float4*)(xr + col), gp = *(const float4*)(g_post + col), ga = *(const float4*)(m + 5120 + col);
            float4 xn; xn.x = xo.x + ga.x * (f[j * 4 + 0] * rstd * gp.x); xn.y = xo.y + ga.y * (f[j * 4 + 1] * rstd * gp.y); xn.z = xo.z + ga.z * (f[j * 4 + 2] * rstd * gp.z); xn.w = xo.w + ga.w * (f[j * 4 + 3] * rstd * gp.w);
            *(float4*)((dry ? (float*)P.p + (size_t)row * 1024 : xr) + col) = xn;
            xv[j * 4 + 0] = xn.x; xv[j * 4 + 1] = xn.y; xv[j * 4 + 2] = xn.z; xv[j * 4 + 3] = xn.w;
            ss += xn.x * xn.x + xn.y * xn.y + xn.z * xn.z + xn.w * xn.w;
        }
        if (nl < DEPTH) {
            rstd = rsqrtf(wave_sum(ss) * (1.f / 1024.f) + EPS);
            const float* g = P.g_mix_pre + nl * 1024;
            const float* m2 = P.mod + ((size_t)nl * 3 + modrow(row)) * 6144;
#pragma unroll
            for (int j = 0; j < 4; ++j) {
                const int col = j * 256 + lane * 4;
                const float4 gg = *(const float4*)(g + col), sh = *(const float4*)(m2 + col), sc = *(const float4*)(m2 + 1024 + col);
                store_bf16x4(P.abuf + (size_t)row * 1024 + col, xv[j * 4 + 0] * rstd * gg.x * (1.f + sc.x) + sh.x, xv[j * 4 + 1] * rstd * gg.y * (1.f + sc.y) + sh.y,
                             xv[j * 4 + 2] * rstd * gg.z * (1.f + sc.z) + sh.z, xv[j * 4 + 3] * rstd * gg.w * (1.f + sc.w) + sh.w);
            }
        }
    }
}

extern __shared__ __attribute__((aligned(16))) unsigned char smem_dyn[];
#define PH_COMMON LAS unsigned char* lds = (LAS unsigned char*)smem_dyn; const int wg = blockIdx.x, nwg = gridDim.x;

__global__ void __launch_bounds__(512, 2) k_mega(Params P) {
    PH_COMMON
    cg::grid_group grid = cg::this_grid();
    volatile LAS unsigned* xbw = (volatile LAS unsigned*)(lds + LDS_BYTES - 16);
    if (threadIdx.x == 0) { xbw[0] = 0u; xbw[1] = 0u; }
    __syncthreads();
    const XcdBarrier xb = xcd_barrier_post(P.bar, xbw);
#ifndef PROBE_DUP
#define PROBE_DUP 0
#endif
#define GBAR() do { xcd_barrier(xb); if (PROBE_DUP & 16) xcd_barrier(xb); } while (0)
#define REP(bit) for (int rep_ = 0, nrep_ = opaque_reps((PROBE_DUP & (bit)) ? 2 : 1); rep_ < nrep_; ++rep_)
    REP(4) { phase_prep_small(P, lds, wg, nwg); phase_ada(P, lds, wg, nwg); phase_pos_table(P, wg, nwg); }
    grid.sync();
    REP(1024) phase_rowop_pre(P, 0, wg, nwg);
    GBAR();
#pragma unroll 1
    for (int l = 0; l < DEPTH; ++l) {
        const bool last = (l == DEPTH - 1);
        const int nrows = last ? NLAT : NROW;
        REP(1) {
            SchedDense S; S.nM = NROW / 256; S.nN = PN / 256; S.nwg = S.nM * S.nN; S.G = nwg; S.c = wg; S.Bt = (const char*)(P.WinT + (size_t)l * PN * 1024);
            EpiStoreBf16 E; E.O = P.p; E.ldo = PN;
            gemm_phase(lds, (const char*)P.abuf, S, E);
            phase_gates(P, l, wg, nwg);
        }
        GBAR();
        REP(2) phase_mix_a(P, lds, l, wg, nwg);
        GBAR();
        REP(2048) phase_mix_b(P, wg, nwg);
        GBAR();
        REP(4096) phase_mix_c(P, lds, l, last ? 2 : 0, wg, nwg);
        GBAR();
        REP(8) {
            SchedDense S; S.nM = nrows / 256; S.nN = 4; S.nwg = S.nM * S.nN; S.G = nwg; S.c = wg; S.Bt = (const char*)(P.WoutT + (size_t)l * 1024 * 1024);
            EpiStoreBf16 E; E.O = P.r1; E.ldo = 1024;
            gemm_phase(lds, (const char*)P.abuf, S, E);
        }
        GBAR();
        REP(256) phase_rowop_mid(P, lds, l, nrows, wg, nwg, rep_ + 1 < nrep_);
        GBAR();
        REP(128) phase_topk_prep(P, lds, l, last ? 32 : 64, wg, nwg);
        GBAR();
        const int mtn = last ? 8 : 9;
        REP(32) {
            SchedGateUp S; S.G = nwg; S.c = wg; S.mtn = mtn; S.glist = P.glist; S.Wg = (const char*)P.WegT; S.Wu = (const char*)P.WeuT;
            EpiGateUp E; E.hid = P.p;
            gemm_phase(lds, (const char*)P.abuf, S, E);
        }
        GBAR();
        REP(64) {
            SchedDown S; S.G = nwg; S.c = wg; S.mtn = mtn; S.Wd = (const char*)P.WedT;
            EpiDown E; E.yp = P.r1; E.gval = P.gval;
            gemm_phase(lds, (const char*)P.p, S, E);
        }
        GBAR();
        REP(512) phase_rowop_post_pre(P, l, nrows, wg, nwg, rep_ + 1 < nrep_);
        if (!last) GBAR();
    }
#undef GBAR
#undef REP
}
}

extern "C" void kernel_launch(void* const* d_in, const int* in_sizes, int n_in, void* d_out, int out_size, void* d_ws, size_t ws_size, hipStream_t stream) {
    Params P{};
    P.x = (const float*)d_in[0]; P.c = (const float*)d_in[1]; P.ctx = (const float*)d_in[2]; P.c_ctx = (const float*)d_in[3];
    P.w_ada = (const float*)d_in[4]; P.b_ada = (const float*)d_in[5];
    P.g_mix_pre = (const float*)d_in[6]; P.g_mix_post = (const float*)d_in[7]; P.g_ffn_pre = (const float*)d_in[8]; P.g_ffn_post = (const float*)d_in[9];
    P.w_in = (const float*)d_in[10]; P.conv_qk = (const float*)d_in[11]; P.b_ml_gates = (const float*)d_in[12];
    P.w_gla_a2 = (const float*)d_in[13]; P.b_gla_a = (const float*)d_in[14]; P.g_ml_norm = (const float*)d_in[15]; P.g_gla_norm = (const float*)d_in[16];
    P.w_out = (const float*)d_in[17]; P.w_router = (const float*)d_in[18];
    P.w_e_gate = (const float*)d_in[19]; P.w_e_up = (const float*)d_in[20]; P.w_e_down = (const float*)d_in[21];
    P.out = (float*)d_out;

    char* ws = (char*)d_ws; size_t off = 0;
    auto carve = [&](size_t bytes) { void* r = ws + off; off += (bytes + 255) & ~(size_t)255; return r; };
    P.bar = (unsigned*)carve(65536);
    P.xc = (float*)carve((size_t)NCTX * 1024 * 4);
    P.WinT = (bf16_t*)carve((size_t)DEPTH * PN * 1024 * 2);
    P.WgaT = (bf16_t*)carve((size_t)DEPTH * 64 * 1024 * 2);
    P.WoutT = (bf16_t*)carve((size_t)DEPTH * 1024 * 1024 * 2);
    P.WegT = (bf16_t*)carve((size_t)NE * 1024 * 1024 * 2);
    P.WeuT = (bf16_t*)carve((size_t)NE * 1024 * 1024 * 2);
    P.WedT = (bf16_t*)carve((size_t)NE * 1024 * 1024 * 2);
    P.abuf = (bf16_t*)carve((size_t)NROW * 1024 * 2);
    P.p = (bf16_t*)carve((size_t)NROW * PN * 2);
    P.pga = (float*)carve((size_t)NROW * GA * 4);
    P.r1 = (bf16_t*)carve((size_t)2 * NROW * 1024 * 2);
    P.qk = P.r1 + (size_t)NROW * 1024;
    P.ml_ck = (bf16_t*)carve((size_t)16 * 66 * ML_IMG);
    P.ml_pre = (bf16_t*)carve((size_t)16 * 66 * ML_IMG);
    P.gl_ck = (bf16_t*)carve((size_t)16 * 66 * GL_IMG);
    P.gl_pre = (bf16_t*)carve((size_t)16 * 66 * GL_IMG);
    P.mstat = (float*)carve((size_t)16 * 66 * 2 * 4);
    P.mprev = (float*)carve((size_t)16 * 66 * 4);
    P.gbend = (float*)carve((size_t)16 * 66 * 64 * 4);
    P.mod = (float*)carve((size_t)DEPTH * 3 * 6144 * 4);
    P.pos = (float*)carve((size_t)192 * 512 * 4);
    P.aff = (float*)carve((size_t)NROW * 16 * 4);
    P.glist = (int*)carve((size_t)NE * MZ * 4);
    P.gval = (float*)carve((size_t)NE * MZ * 4);
    P.inv = (int*)carve((size_t)NROW * 16 * 4);

    static int grid_blocks = 0;
    if (!grid_blocks) {
        int dev = 0, cus = 0, per_cu = 0;
        (void)hipGetDevice(&dev);
        (void)hipDeviceGetAttribute(&cus, hipDeviceAttributeMultiprocessorCount, dev);
        (void)hipFuncSetAttribute((const void*)k_mega, hipFuncAttributeMaxDynamicSharedMemorySize, LDS_BYTES);
        (void)hipOccupancyMaxActiveBlocksPerMultiprocessor(&per_cu, (const void*)k_mega, NTHR, LDS_BYTES);
        if (cus < 1) cus = NWG;
        grid_blocks = cus;
        if (per_cu < 1) grid_blocks = cus;
        if (grid_blocks > NWG) grid_blocks = NWG;
    }
    (void)hipMemsetAsync(P.bar, 0, 65536, stream);
    void* args[] = {&P};
    (void)hipLaunchCooperativeKernel((const void*)k_mega, dim3(grid_blocks), dim3(NTHR), args, LDS_BYTES, stream);
}
```
